# Optimizing an MI355X kernel written in HIP

```python
import math
import jax, jax.numpy as jnp
from jax import lax
import numpy as np

D_MODEL = 2048
BATCH = 8
SEQ = 2048
DEPTH = 2

LRU_WIDTH = 1024
LRU_BLOCKS = 8
LRU_BLOCK = LRU_WIDTH // LRU_BLOCKS
LRU_CONV = 4
LRU_C = 8.0
SC_WIDTH = 1024
SC_GROUPS = 8
SC_CONV = 3
N_HEADS = 16
QK_NOPE = 128
QK_ROPE = 64
V_HEAD = 128
KV_RANK = 512
ROPE_THETA = 10000.0
Q_BLOCK = 128
N_BRANCH = 3
D_FF = 5632
N_MOD = 9
EPS = 1e-6
IN_WIDTH = 2 * LRU_WIDTH + 3 * SC_WIDTH + N_HEADS * (QK_NOPE + QK_ROPE) + KV_RANK + QK_ROPE + N_BRANCH * D_MODEL

kernel_name = "hybrid_rglru_shortconv_mla_macaron_adaln"


def _in_sizes():
    return (LRU_WIDTH, LRU_WIDTH, SC_WIDTH, SC_WIDTH, SC_WIDTH,
            N_HEADS * (QK_NOPE + QK_ROPE), KV_RANK, QK_ROPE, N_BRANCH * D_MODEL)


def _split_last(x, sizes):
    idx, acc = [], 0
    for s in sizes[:-1]:
        acc += s
        idx.append(acc)
    return jnp.split(x, idx, axis=-1)


def rmsnorm(x, g):
    xf = x.astype(jnp.float32)
    y = xf * lax.rsqrt(jnp.mean(xf * xf, axis=-1, keepdims=True) + EPS)
    return (y * g.astype(jnp.float32)).astype(x.dtype)


def modulate(h, shift, scale):
    return h * (1 + scale[:, None, :]) + shift[:, None, :]


def causal_depthwise_conv(x, w):
    K, C = w.shape
    return lax.conv_general_dilated(
        x, w[:, None, :].astype(x.dtype), window_strides=(1,), padding=[(K - 1, 0)],
        dimension_numbers=('NWC', 'WIO', 'NWC'), feature_group_count=C)


def swiglu(h, w13, w2):
    g, u = jnp.split(h @ w13, 2, axis=-1)
    return (jax.nn.silu(g) * u) @ w2


def rope_angles(positions):
    half = QK_ROPE // 2
    inv = ROPE_THETA ** (-jnp.arange(half, dtype=jnp.float32) / half)
    ang = positions.astype(jnp.float32)[..., None] * inv
    return jnp.cos(ang), jnp.sin(ang)


def apply_rope(x, cos, sin):
    x1, x2 = jnp.split(x.astype(jnp.float32), 2, axis=-1)
    return jnp.concatenate([x1 * cos - x2 * sin, x2 * cos + x1 * sin], axis=-1).astype(x.dtype)


def rg_lru(x, wa, ba, wx, bx, lam):
    B, S, _ = x.shape
    xb = x.reshape(B, S, LRU_BLOCKS, LRU_BLOCK)
    r = jax.nn.sigmoid(jnp.einsum('bsgi,gij->bsgj', xb, wa).reshape(B, S, LRU_WIDTH) + ba)
    i = jax.nn.sigmoid(jnp.einsum('bsgi,gij->bsgj', xb, wx).reshape(B, S, LRU_WIDTH) + bx)
    log_a = (-LRU_C * jax.nn.softplus(-lam.astype(jnp.float32))) * r.astype(jnp.float32)
    a = jnp.exp(log_a)
    b = jnp.sqrt(-jnp.expm1(2.0 * log_a)) * (i * x).astype(jnp.float32)

    def combine(left, right):
        a1, b1 = left
        a2, b2 = right
        return a1 * a2, a2 * b1 + b2

    _, h = lax.associative_scan(combine, (a, b), axis=1)
    return h.astype(x.dtype)


def mla_attention(q, kv_lat, k_pe, positions, kv_norm_g, w_ukv):
    B, S, _ = q.shape
    q = q.reshape(B, S, N_HEADS, QK_NOPE + QK_ROPE)
    q_nope, q_pe = q[..., :QK_NOPE], q[..., QK_NOPE:]
    cos, sin = rope_angles(positions)
    q_pe = apply_rope(q_pe, cos[:, :, None, :], sin[:, :, None, :])
    k_pe = apply_rope(k_pe, cos, sin)
    kv = (rmsnorm(kv_lat, kv_norm_g) @ w_ukv).reshape(B, S, N_HEADS, QK_NOPE + V_HEAD)
    k_nope, v = kv[..., :QK_NOPE], kv[..., QK_NOPE:]
    scale = (QK_NOPE + QK_ROPE) ** -0.5
    outs = []
    for blk in range(S // Q_BLOCK):
        q0 = blk * Q_BLOCK
        kend = q0 + Q_BLOCK
        s = (jnp.einsum('bqhd,bkhd->bhqk', q_nope[:, q0:kend], k_nope[:, :kend])
             + jnp.einsum('bqhr,bkr->bhqk', q_pe[:, q0:kend], k_pe[:, :kend]))
        s = s.astype(jnp.float32) * scale
        mask = jnp.arange(kend)[None, :] <= (q0 + jnp.arange(Q_BLOCK))[:, None]
        s = jnp.where(mask, s, -jnp.inf)
        p = jax.nn.softmax(s, axis=-1).astype(v.dtype)
        outs.append(jnp.einsum('bhqk,bkhd->bqhd', p, v[:, :kend]))
    return jnp.concatenate(outs, axis=1).reshape(B, S, N_HEADS * V_HEAD)


def hybrid_layer(x, mod, positions, norm_g, ffn_w13, ffn_w2, w_in, lru_conv_w, lru_conv_b,
                 lru_wa, lru_ba, lru_wx, lru_bx, lru_lambda, lru_out, sc_conv_w, sc_out,
                 mla_kv_norm_g, mla_w_ukv, mla_out, w_o):
    sh1, sc1, g1, shm, scm, gm, sh2, sc2, g2 = jnp.split(mod, N_MOD, axis=-1)
    B, S, _ = x.shape

    h = modulate(rmsnorm(x, norm_g[0]), sh1, sc1)
    x = x + 0.5 * g1[:, None, :] * swiglu(h, ffn_w13[0], ffn_w2[0])

    h = modulate(rmsnorm(x, norm_g[1]), shm, scm)
    (lru_x, lru_gate, sc_b, sc_c, sc_x, q, kv_lat, k_pe, gate_logits) = _split_last(h @ w_in, _in_sizes())

    xr = causal_depthwise_conv(lru_x, lru_conv_w) + lru_conv_b
    y_lru = (rg_lru(xr, lru_wa, lru_ba, lru_wx, lru_bx, lru_lambda) * jax.nn.gelu(lru_gate)) @ lru_out

    y_sc = (sc_b * causal_depthwise_conv(sc_c * sc_x, sc_conv_w)) @ sc_out

    y_mla = mla_attention(q, kv_lat, k_pe, positions, mla_kv_norm_g, mla_w_ukv) @ mla_out

    gates = jax.nn.sigmoid(gate_logits.reshape(B, S, N_BRANCH, D_MODEL))
    merged = gates[:, :, 0] * y_lru + gates[:, :, 1] * y_sc + gates[:, :, 2] * y_mla
    x = x + gm[:, None, :] * (merged @ w_o)

    h = modulate(rmsnorm(x, norm_g[2]), sh2, sc2)
    x = x + 0.5 * g2[:, None, :] * swiglu(h, ffn_w13[1], ffn_w2[1])
    return x


def _dense(key, shape, fan_in, gain=1.0):
    return jax.random.normal(key, shape, jnp.float32) * (gain * fan_in ** -0.5)


def setup_inputs(seed: int = 0) -> dict:
    key = jax.random.key(seed)
    ks = jax.random.split(key, 24)
    L = DEPTH
    x = jax.random.normal(ks[0], (BATCH, SEQ, D_MODEL), jnp.float32)
    c = jax.random.normal(ks[1], (BATCH, D_MODEL), jnp.float32)
    positions = jnp.broadcast_to(jnp.arange(SEQ, dtype=jnp.int32)[None, :], (BATCH, SEQ))
    ada_w = _dense(ks[2], (L, D_MODEL, N_MOD * D_MODEL), D_MODEL, 0.5)
    ada_b = 0.02 * jax.random.normal(ks[3], (L, N_MOD * D_MODEL), jnp.float32)
    norm_g = 1.0 + 0.1 * jax.random.normal(ks[4], (L, 3, D_MODEL), jnp.float32)
    ffn_w13 = _dense(ks[5], (L, 2, D_MODEL, 2 * D_FF), D_MODEL)
    ffn_w2 = _dense(ks[6], (L, 2, D_FF, D_MODEL), D_FF)
    w_in = _dense(ks[7], (L, D_MODEL, IN_WIDTH), D_MODEL)
    lru_conv_w = _dense(ks[8], (L, LRU_CONV, LRU_WIDTH), LRU_CONV)
    lru_conv_b = 0.02 * jax.random.normal(ks[9], (L, LRU_WIDTH), jnp.float32)
    lru_wa = _dense(ks[10], (L, LRU_BLOCKS, LRU_BLOCK, LRU_BLOCK), LRU_BLOCK)
    lru_ba = 0.02 * jax.random.normal(ks[11], (L, LRU_WIDTH), jnp.float32)
    lru_wx = _dense(ks[12], (L, LRU_BLOCKS, LRU_BLOCK, LRU_BLOCK), LRU_BLOCK)
    lru_bx = 0.02 * jax.random.normal(ks[13], (L, LRU_WIDTH), jnp.float32)
    u = jax.random.uniform(ks[14], (L, LRU_WIDTH), jnp.float32, 0.9, 0.999)
    a0 = u ** (1.0 / LRU_C)
    lru_lambda = jnp.log(a0) - jnp.log1p(-a0)
    lru_out = _dense(ks[15], (L, LRU_WIDTH, D_MODEL), LRU_WIDTH)
    sc_conv_w = _dense(ks[16], (L, SC_CONV, SC_WIDTH), SC_CONV)
    sc_out = _dense(ks[17], (L, SC_WIDTH, D_MODEL), SC_WIDTH)
    mla_kv_norm_g = 1.0 + 0.1 * jax.random.normal(ks[18], (L, KV_RANK), jnp.float32)
    mla_w_ukv = _dense(ks[19], (L, KV_RANK, N_HEADS * (QK_NOPE + V_HEAD)), KV_RANK)
    mla_out = _dense(ks[20], (L, N_HEADS * V_HEAD, D_MODEL), N_HEADS * V_HEAD)
    w_o = _dense(ks[21], (L, D_MODEL, D_MODEL), D_MODEL)
    final_norm_g = 1.0 + 0.1 * jax.random.normal(ks[22], (D_MODEL,), jnp.float32)
    return {"x": x, "c": c, "positions": positions, "ada_w": ada_w, "ada_b": ada_b,
            "norm_g": norm_g, "ffn_w13": ffn_w13, "ffn_w2": ffn_w2, "w_in": w_in,
            "lru_conv_w": lru_conv_w, "lru_conv_b": lru_conv_b, "lru_wa": lru_wa,
            "lru_ba": lru_ba, "lru_wx": lru_wx, "lru_bx": lru_bx, "lru_lambda": lru_lambda,
            "lru_out": lru_out, "sc_conv_w": sc_conv_w, "sc_out": sc_out,
            "mla_kv_norm_g": mla_kv_norm_g, "mla_w_ukv": mla_w_ukv, "mla_out": mla_out,
            "w_o": w_o, "final_norm_g": final_norm_g}


def reference(x, c, positions, ada_w, ada_b, norm_g, ffn_w13, ffn_w2, w_in, lru_conv_w,
              lru_conv_b, lru_wa, lru_ba, lru_wx, lru_bx, lru_lambda, lru_out, sc_conv_w,
              sc_out, mla_kv_norm_g, mla_w_ukv, mla_out, w_o, final_norm_g):
    c_act = jax.nn.silu(c)
    for l in range(DEPTH):
        mod = c_act @ ada_w[l] + ada_b[l]
        x = hybrid_layer(x, mod, positions, norm_g[l], ffn_w13[l], ffn_w2[l], w_in[l],
                         lru_conv_w[l], lru_conv_b[l], lru_wa[l], lru_ba[l], lru_wx[l],
                         lru_bx[l], lru_lambda[l], lru_out[l], sc_conv_w[l], sc_out[l],
                         mla_kv_norm_g[l], mla_w_ukv[l], mla_out[l], w_o[l])
    return rmsnorm(x, final_norm_g)
```

```cpp
#include <hip/hip_runtime.h>
#include <cstdio>
#include <cstdint>
#define MK_N_LAUNCHES 1
#ifndef G1_BF16
#define G1_BF16 1
#endif
#ifndef GATES_U8
#define GATES_U8 1
#endif
namespace pg8 {
#define PG8_LAS __attribute__((address_space(3)))
typedef unsigned short bf16_t;
typedef short bf16x8 __attribute__((ext_vector_type(8)));
typedef float f32x4 __attribute__((ext_vector_type(4)));
typedef unsigned u32x4 __attribute__((ext_vector_type(4)));
typedef int v4i_t __attribute__((ext_vector_type(4)));
typedef int v8i_t __attribute__((ext_vector_type(8)));
constexpr int BM = 256, BK = 64, HALF = 128, HTB = HALF * BK * 2  , STAGE_BYTES = 8 * HTB, NXCD = 8, WGM = 8;

__host__ __device__ __forceinline__ int lds_byte(int r, int c) { const int st = (r >> 4) * 2 + (c >> 5), rr = r & 15, cc = c & 31, ob = rr * 64 + cc * 2; return st * 1024 + (ob ^ (((ob >> 9) & 1) << 5)); }
__host__ __device__ __forceinline__ void stage_rc(int b, int& R, int& C) { const int st = b / 1024, sb = b % 1024, swz = sb ^ (((sb >> 9) & 1) << 5); R = (st >> 1) * 16 + swz / 64; C = (st & 1) * 32 + (swz % 64) / 2; }
__host__ __device__ __forceinline__ int perm32(int rho) { const int n = rho >> 4, i = rho & 15; return 8 * (i >> 2) + 4 * n + (i & 3); }

template <class E> struct has_mid { static constexpr bool value = false; };
struct Unit { int pm, pn; };
struct Gemm { const bf16_t* A; const bf16_t* Bt; int M, N, K; int ld = 0; };

struct StaticOrder {
    int nM, nN, nwg, G, c;
    __host__ __device__ void init(int M, int N, int G_, int c_) { nM = M / BM; nN = N / BM; nwg = nM * nN; G = G_; c = c_; }
    __host__ __device__ bool next(int i, Unit& u) const {
        const long L = (long)i * G + c; if (L >= nwg) return false;
        int wgid = (int)L; { const int q = nwg / NXCD, r = nwg % NXCD, xcd = wgid % NXCD, off = wgid / NXCD; wgid = (xcd < r ? xcd * (q + 1) : r * (q + 1) + (xcd - r) * q) + off; }
        const int nig = WGM * nN, gid = wgid / nig, fm = gid * WGM, gsz = (nM - fm) < WGM ? (nM - fm) : WGM;
        u.pm = fm + ((wgid % nig) % gsz); u.pn = (wgid % nig) / gsz; return true;
    }
    __device__ __forceinline__ void a_ready(const Unit&) const {}
    __device__ __forceinline__ void done(const Unit&) const {}
};

__device__ __forceinline__ unsigned cvt_pk_bf16(float lo, float hi) { unsigned r; asm volatile("v_cvt_pk_bf16_f32 %0, %1, %2" : "=v"(r) : "v"(lo), "v"(hi)); return r; }
typedef float f32x2 __attribute__((ext_vector_type(2)));
struct PanelOrder {
    int G, c;
    __host__ __device__ void init(int G_, int c_) { G = G_; c = c_; }
    __host__ __device__ bool next(int i, Unit& u) const { const long L = (long)i * G + c; if (L >= 512) return false; const int x = (int)(L & 7), j = (int)(L >> 3); u.pm = 8 * x + (j >> 3); u.pn = j & 7; return true; }
    __device__ __forceinline__ void a_ready(const Unit&) const {}
    __device__ __forceinline__ void done(const Unit&) const {}
};
typedef unsigned u32x2 __attribute__((ext_vector_type(2)));
__device__ __forceinline__ float fast_sigmoid(float x) { return __builtin_amdgcn_rcpf(1.0f + __builtin_amdgcn_exp2f(-1.4426950408889634f * x)); }
__device__ __forceinline__ float gelu_tanh(float x) { return x * fast_sigmoid(1.5957691216057308f * (x + 0.044715f * x * x * x)); }
__device__ __forceinline__ u32x4 pack8_bf16(const f32x4 a, const f32x4 b) { u32x4 w; w.x = cvt_pk_bf16(a[0], a[1]); w.y = cvt_pk_bf16(a[2], a[3]); w.z = cvt_pk_bf16(b[0], b[1]); w.w = cvt_pk_bf16(b[2], b[3]); return w; }
__device__ __forceinline__ void unpack8_bf16(const u32x4 w, f32x4& a, f32x4& b) {
    a[0] = __uint_as_float(w.x << 16); a[1] = __uint_as_float(w.x & 0xffff0000u); a[2] = __uint_as_float(w.y << 16); a[3] = __uint_as_float(w.y & 0xffff0000u);
    b[0] = __uint_as_float(w.z << 16); b[1] = __uint_as_float(w.z & 0xffff0000u); b[2] = __uint_as_float(w.w << 16); b[3] = __uint_as_float(w.w & 0xffff0000u); }

struct EpiNull {
    static constexpr bool PERM = true, AFTER_DRAIN = false; float* sink;
    __device__ __forceinline__ void operator()(f32x4 (&acc)[2][2][4][2], const Unit& u, int wr, int wc, int fr, int fq) const {
        float t = 0.f;
#pragma unroll
        for (int ai = 0; ai < 2; ++ai)
#pragma unroll
            for (int bj = 0; bj < 2; ++bj)
#pragma unroll
                for (int m = 0; m < 4; ++m)
#pragma unroll
                    for (int n = 0; n < 2; ++n) t += acc[ai][bj][m][n][0] + acc[ai][bj][m][n][3];
        if (t == 123456.75f) sink[0] = t; }
};
typedef unsigned long long ssq_t;
typedef int i32x4 __attribute__((ext_vector_type(4)));
__device__ __forceinline__ ssq_t ssq_enc(float t) { return (ssq_t)(t * 16777216.0f); }
__device__ __forceinline__ float ssq_dec(ssq_t v) { return (float)(unsigned)(v >> 32) * 256.0f + (float)(unsigned)v * (1.0f / 16777216.0f); }
__device__ __forceinline__ void ssq_add(ssq_t* p, float t) { atomicAdd(p, ssq_enc(t)); }
constexpr float CB_ENC = 1048576.0f, CB_DEC = 1.0f / 1048576.0f;
__device__ __forceinline__ f32x4 cb_ld4(const int* p) { return __builtin_convertvector(*(const i32x4*)p, f32x4) * CB_DEC; }
__device__ __forceinline__ float sat8(float x) { return __builtin_amdgcn_fmed3f(x, -448.0f, 448.0f); }
__device__ __forceinline__ u32x2 pack8_fp8(const f32x4 a, const f32x4 b) {
    unsigned w0 = 0, w1 = 0; w0 = __builtin_amdgcn_cvt_pk_fp8_f32(sat8(a[0]), sat8(a[1]), w0, false); w0 = __builtin_amdgcn_cvt_pk_fp8_f32(sat8(a[2]), sat8(a[3]), w0, true);
    w1 = __builtin_amdgcn_cvt_pk_fp8_f32(sat8(b[0]), sat8(b[1]), w1, false); w1 = __builtin_amdgcn_cvt_pk_fp8_f32(sat8(b[2]), sat8(b[3]), w1, true); return (u32x2){w0, w1}; }
constexpr float ACT8_SC = 8.0f;
template <bool TILED, bool O8 = false> struct EpiSwiglu {
    static constexpr bool PERM = true, AFTER_DRAIN = false;
    bf16_t* O; int ldc; const ssq_t* ssq; const int* cb; int cbstride; float eps; float dsc;
    __device__ __forceinline__ void operator()(f32x4 (&acc)[2][2][4][2], const Unit& u, int wr, int wc, int fr, int fq) const {
        const int row0 = u.pm * BM + wr * 64 + fr, lc = wc * 32 + 8 * fq, col0 = u.pn * HALF + lc;
        const int* cbp = cb + (size_t)(u.pm >> 3) * cbstride + u.pn * BM + lc;
        f32x4 cv[2][2];
#pragma unroll
        for (int bj = 0; bj < 2; ++bj)
#pragma unroll
            for (int n = 0; n < 2; ++n) cv[bj][n] = cb_ld4(cbp + bj * HALF + 4 * n);
#pragma unroll
        for (int ai = 0; ai < 2; ++ai)
#pragma unroll
            for (int m = 0; m < 4; ++m) { const int row = row0 + ai * HALF + m * 16;
                bf16_t* rowp = TILED ? O + ((size_t)u.pm * (ldc / 64) + 2 * u.pn + (wc >> 1)) * (BM * 64) + (size_t)(row - u.pm * BM) * 64 + (wc & 1) * 32 + 8 * fq
                                    : O + (size_t)row * ldc + col0;
                const float ri = __builtin_amdgcn_rsqf(ssq_dec(ssq[row]) * (1.0f / 2048.0f) + eps) * dsc;
                f32x4 r0, r1;
#pragma unroll
                for (int e = 0; e < 4; ++e) { const float g0 = acc[ai][0][m][0][e] * ri + cv[0][0][e], g1 = acc[ai][0][m][1][e] * ri + cv[0][1][e];
                    r0[e] = g0 * fast_sigmoid(g0) * (acc[ai][1][m][0][e] * ri + cv[1][0][e]); r1[e] = g1 * fast_sigmoid(g1) * (acc[ai][1][m][1][e] * ri + cv[1][1][e]); }
                if constexpr (O8) *(u32x2*)((unsigned char*)O + (size_t)row * ldc + col0) = pack8_fp8(r0 * ACT8_SC, r1 * ACT8_SC);
                else *(u32x4*)rowp = pack8_bf16(r0, r1); }
    }
};
typedef _Float16 f16_t;
__device__ __forceinline__ float h_lo(unsigned w) { return (float)__builtin_bit_cast(_Float16, (unsigned short)(w & 0xffffu)); }
__device__ __forceinline__ float h_hi(unsigned w) { return (float)__builtin_bit_cast(_Float16, (unsigned short)(w >> 16)); }
__device__ __forceinline__ void unpack8_f16(const u32x4 w, f32x4& a, f32x4& b) {
    const unsigned w0 = w[0], w1 = w[1], w2 = w[2], w3 = w[3];
    a[0] = h_lo(w0); a[1] = h_hi(w0); a[2] = h_lo(w1); a[3] = h_hi(w1); b[0] = h_lo(w2); b[1] = h_hi(w2); b[2] = h_lo(w3); b[3] = h_hi(w3); }
__device__ __forceinline__ unsigned pk2_f16(float lo, float hi) {
    const unsigned short l = __builtin_bit_cast(unsigned short, (_Float16)__builtin_fminf(__builtin_fmaxf(lo, -65504.f), 65504.f)), h = __builtin_bit_cast(unsigned short, (_Float16)__builtin_fminf(__builtin_fmaxf(hi, -65504.f), 65504.f));
    return (unsigned)l | ((unsigned)h << 16); }
__device__ __forceinline__ u32x4 pack8_f16(const f32x4 a, const f32x4 b) { u32x4 w; w[0] = pk2_f16(a[0], a[1]); w[1] = pk2_f16(a[2], a[3]); w[2] = pk2_f16(b[0], b[1]); w[3] = pk2_f16(b[2], b[3]); return w; }
template <bool NEXT, bool F8 = false> struct EpiResid {
    static constexpr bool PERM = true, AFTER_DRAIN = false;
    bf16_t* X; const float* gate; bf16_t* An; const float* gn; const float* scn; ssq_t* ssqn; unsigned char* A8; int gstride; float s;
    __device__ __forceinline__ void operator()(f32x4 (&acc)[2][2][4][2], const Unit& u, int wr, int wc, int fr, int fq) const {
        const int row0 = u.pm * BM + wr * 64 + fr, col0 = u.pn * BM + wc * 32 + 8 * fq;
        const unsigned cofs = (unsigned)((u.pm >> 3) * gstride + col0);
        const unsigned e0 = (unsigned)row0 * 2048u + (unsigned)col0;
#pragma unroll
        for (int ah = 0; ah < 4; ++ah) { const int ai = ah >> 1, mb = (ah & 1) * 2; u32x4 xw[2][2];
#pragma unroll
            for (int mm = 0; mm < 2; ++mm)
#pragma unroll
                for (int bj = 0; bj < 2; ++bj) xw[mm][bj] = *(const u32x4*)(X + (size_t)(e0 + (unsigned)(ai * HALF + (mb + mm) * 16) * 2048u + bj * HALF));
            float ss[2] = {0.f, 0.f};
#pragma unroll
            for (int bj = 0; bj < 2; ++bj) { f32x4 gv[2], nv[2];
#pragma unroll
                for (int n = 0; n < 2; ++n) { gv[n] = *(const f32x4*)(gate + (size_t)(cofs + bj * HALF + 4 * n)) * s;
                    if (NEXT) nv[n] = *(const f32x4*)(gn + (size_t)(unsigned)(col0 + bj * HALF + 4 * n)) * (*(const f32x4*)(scn + (size_t)(cofs + bj * HALF + 4 * n)) + 1.0f); }
#pragma unroll
                for (int mm = 0; mm < 2; ++mm) { const int m = mb + mm; const unsigned off = e0 + (unsigned)(ai * HALF + m * 16) * 2048u + bj * HALF;
                    f32x4 a, b; unpack8_f16(xw[mm][bj], a, b); a += gv[0] * acc[ai][bj][m][0]; b += gv[1] * acc[ai][bj][m][1];
                    *(u32x4*)(X + (size_t)off) = pack8_f16(a, b);
                    if (NEXT) { ss[mm] += ((a[0] * a[0] + a[1] * a[1]) + (a[2] * a[2] + a[3] * a[3])) + ((b[0] * b[0] + b[1] * b[1]) + (b[2] * b[2] + b[3] * b[3]));
                        const f32x4 an = a * nv[0], bn = b * nv[1]; *(u32x4*)(An + (size_t)off) = pack8_bf16(an, bn);
                        if (F8) *(u32x2*)(A8 + (size_t)off) = pack8_fp8(an, bn); } } }
            if (NEXT) {
#pragma unroll
                for (int mm = 0; mm < 2; ++mm) { float t = ss[mm]; t += __shfl_xor(t, 16); t += __shfl_xor(t, 32); if (fq == 0) ssq_add(ssqn + row0 + ai * HALF + (mb + mm) * 16, t); } }
            asm volatile("" ::: "memory"); }
    }
};
template <int MODE, bool QF8> struct EpiWin {
    static constexpr bool PERM = true, AFTER_DRAIN = false;
    bf16_t *LRUX, *LRUG, *SCB, *SCC, *SCX, *Q, *KVLAT, *GATES, *KPE; ssq_t* ssq; const ssq_t* ssqn; const int* cb; int cbstride; float eps;
    __device__ __forceinline__ void operator()(f32x4 (&acc)[2][2][4][2], const Unit& u, int wr, int wc, int fr, int fq) const {
        const int t = u.pn; bf16_t* base; int pitch, cbs, act = 0;
        if (MODE == 0) { const int tq = QF8 ? 20 : 32;
            if (t < 4) { base = LRUX; pitch = 1024; cbs = 256 * t; }
            else if (t < 8) { base = LRUG; pitch = 1024; cbs = 256 * (t - 4); act = 1; }
            else if (t < 12) { base = SCB; pitch = 1024; cbs = 256 * (t - 8); }
            else if (t < 16) { base = SCC; pitch = 1024; cbs = 256 * (t - 12); }
            else if (t < 20) { base = SCX; pitch = 1024; cbs = 256 * (t - 16); }
            else if (t < tq) { base = Q; pitch = 3072; cbs = 256 * (t - 20); }
            else if (t < tq + 2) { base = KVLAT; pitch = 512; cbs = 256 * (t - tq); act = 3; }
            else if (!G1_BF16 || t == tq + 2) { base = KPE; pitch = 64; cbs = 0; act = 4; }
            else { base = GATES; pitch = 6144; cbs = 2048 + 256 * (t - (tq + 3)); act = 2; }
        } else if (MODE == 2) {
            if (t < 4) { base = LRUX; pitch = 1024; cbs = 256 * t; }
            else if (t < 8) { base = LRUG; pitch = 1024; cbs = 256 * (t - 4); act = 1; }
            else if (t < 12) { base = SCB; pitch = 1024; cbs = 256 * (t - 8); }
            else if (t < 16) { base = SCC; pitch = 1024; cbs = 256 * (t - 12); }
            else if (t < 20) { base = SCX; pitch = 1024; cbs = 256 * (t - 16); }
            else if (t < 32) { base = Q; pitch = 3072; cbs = 256 * (t - 20); }
            else if (t < 34) { base = KVLAT; pitch = 512; cbs = 256 * (t - 32); act = 3; }
            else if (t < 58) { base = GATES; pitch = 6144; cbs = 256 * (t - 34); act = 2; }
            else { base = KPE; pitch = 64; cbs = 0; act = 4; }
        } else { const int tg = QF8 ? 12 : 0;
            if (t < tg) { base = Q; pitch = 3072; cbs = 256 * t; }
            else { base = GATES; pitch = 6144; cbs = 256 * (t - tg) + ((G1_BF16 && t >= tg + 8) ? 2048 : 0); act = 2; }
        }
        const float dsc = MODE >= 1 ? (1.0f / 64.0f) : 1.0f;
        const int row0 = u.pm * BM + wr * 64 + fr;
        bf16_t* p0 = base + (size_t)row0 * pitch + cbs + wc * 32 + 8 * fq;
        const size_t rstep = (size_t)16 * pitch;
        const int* cbp = cb + (size_t)(u.pm >> 3) * cbstride + (MODE == 1 ? (QF8 ? (G1_BF16 ? 7936 : 5888) : 8960) : 0) + u.pn * BM + wc * 32 + 8 * fq;
        if (act == 4) {
            if (wc < 2) { f32x4 cv[1][2]; cv[0][0] = cb_ld4(cbp); cv[0][1] = cb_ld4(cbp + 4);
#pragma unroll
                for (int ai = 0; ai < 2; ++ai)
#pragma unroll
                    for (int m = 0; m < 4; ++m) { const float ri = __builtin_amdgcn_rsqf(ssq_dec(ssqn[row0 + ai * HALF + m * 16]) * (1.0f / 2048.0f) + eps) * dsc;
                        *(u32x4*)(p0 + (size_t)(ai * 8 + m) * rstep) = pack8_bf16(acc[ai][0][m][0] * ri + cv[0][0], acc[ai][0][m][1] * ri + cv[0][1]); }
            }
            return;
        }
        f32x4 cv[2][2];
#pragma unroll
        for (int bj = 0; bj < 2; ++bj)
#pragma unroll
            for (int n = 0; n < 2; ++n) cv[bj][n] = cb_ld4(cbp + bj * HALF + 4 * n);
#pragma unroll
        for (int ai = 0; ai < 2; ++ai)
#pragma unroll
            for (int m = 0; m < 4; ++m) { bf16_t* rowp = p0 + (size_t)(ai * 8 + m) * rstep;
                const float ri = __builtin_amdgcn_rsqf(ssq_dec(ssqn[row0 + ai * HALF + m * 16]) * (1.0f / 2048.0f) + eps) * dsc;
                f32x4 v[2][2];
#pragma unroll
                for (int bj = 0; bj < 2; ++bj)
#pragma unroll
                    for (int n = 0; n < 2; ++n) v[bj][n] = acc[ai][bj][m][n] * ri + cv[bj][n];
                if (act == 1) {
#pragma unroll
                    for (int bj = 0; bj < 2; ++bj)
#pragma unroll
                        for (int n = 0; n < 2; ++n)
#pragma unroll
                            for (int e = 0; e < 4; ++e) v[bj][n][e] = gelu_tanh(v[bj][n][e]);
                } else if (act == 2) {
#pragma unroll
                    for (int bj = 0; bj < 2; ++bj)
#pragma unroll
                        for (int n = 0; n < 2; ++n)
#pragma unroll
                            for (int e = 0; e < 4; ++e) v[bj][n][e] = fast_sigmoid(v[bj][n][e]);
                } else if (act == 3) { float s = 0.f;
#pragma unroll
                    for (int bj = 0; bj < 2; ++bj)
#pragma unroll
                        for (int n = 0; n < 2; ++n) { const f32x4 x = v[bj][n]; s += (x[0] * x[0] + x[1] * x[1]) + (x[2] * x[2] + x[3] * x[3]); }
                    s += __shfl_xor(s, 16); s += __shfl_xor(s, 32);
                    if (fq == 0) ssq_add(ssq + row0 + ai * HALF + m * 16, s); }
                if (GATES_U8 && act == 2) { unsigned char* r8 = (unsigned char*)base + (size_t)(row0 + ai * HALF + m * 16) * pitch + cbs + wc * 32 + 8 * fq;
#pragma unroll
                    for (int bj = 0; bj < 2; ++bj) { unsigned w0 = 0u, w1 = 0u;
#pragma unroll
                        for (int e = 0; e < 4; ++e) { w0 = __builtin_amdgcn_cvt_pk_u8_f32(v[bj][0][e] * 255.0f, e, w0); w1 = __builtin_amdgcn_cvt_pk_u8_f32(v[bj][1][e] * 255.0f, e, w1); }
                        *(u32x2*)(r8 + bj * HALF) = (u32x2){w0, w1}; } }
                else { *(u32x4*)rowp = pack8_bf16(v[0][0], v[0][1]); *(u32x4*)(rowp + HALF) = pack8_bf16(v[1][0], v[1][1]); }
                asm volatile("" ::: "memory"); }
    }
};
struct EpiKV {
    static constexpr bool PERM = true, AFTER_DRAIN = false;
    bf16_t *KN, *V; const ssq_t* ssq; float eps;
    __device__ __forceinline__ void operator()(f32x4 (&acc)[2][2][4][2], const Unit& u, int wr, int wc, int fr, int fq) const {
        const int row0 = u.pm * BM + wr * 64 + fr, col0 = u.pn * HALF + wc * 32 + 8 * fq;
#pragma unroll
        for (int ai = 0; ai < 2; ++ai)
#pragma unroll
            for (int m = 0; m < 4; ++m) { const int row = row0 + ai * HALF + m * 16; const float ri = __builtin_amdgcn_rsqf(ssq_dec(ssq[row]) * (1.0f / 512.0f) + eps);
                *(u32x4*)(KN + (size_t)row * 2048 + col0) = pack8_bf16(acc[ai][0][m][0] * ri, acc[ai][0][m][1] * ri);
                *(u32x4*)(V + (size_t)row * 2048 + col0) = pack8_bf16(acc[ai][1][m][0] * ri, acc[ai][1][m][1] * ri); }
    }
};
struct EpiMerge3 {
    static constexpr bool PERM = true, AFTER_DRAIN = false;
    bf16_t* Mg; const unsigned char* G; int gp;
    static __device__ __forceinline__ void un8(const u32x2 w, f32x4& a, f32x4& b) {
        a[0] = __builtin_fmaxf((float)(w[0] & 0xffu), 0.00390625f); a[1] = __builtin_fmaxf((float)((w[0] >> 8) & 0xffu), 0.00390625f); a[2] = __builtin_fmaxf((float)((w[0] >> 16) & 0xffu), 0.00390625f); a[3] = __builtin_fmaxf((float)(w[0] >> 24), 0.00390625f);
        b[0] = __builtin_fmaxf((float)(w[1] & 0xffu), 0.00390625f); b[1] = __builtin_fmaxf((float)((w[1] >> 8) & 0xffu), 0.00390625f); b[2] = __builtin_fmaxf((float)((w[1] >> 16) & 0xffu), 0.00390625f); b[3] = __builtin_fmaxf((float)(w[1] >> 24), 0.00390625f); }
    static __device__ __forceinline__ f32x4 rcp4(f32x4 g) { f32x4 r; r[0] = __builtin_amdgcn_rcpf(g[0]); r[1] = __builtin_amdgcn_rcpf(g[1]); r[2] = __builtin_amdgcn_rcpf(g[2]); r[3] = __builtin_amdgcn_rcpf(g[3]); return r; }
    __device__ __forceinline__ bool mid_at(int t) const { return t == 16 || t == 32; }
    __device__ __forceinline__ void mid(f32x4 (&acc)[2][2][4][2], const Unit& u, int wr, int wc, int fr, int fq, int t) const {
        const int row0 = u.pm * BM + wr * 64 + fr, col0 = u.pn * BM + wc * 32 + 8 * fq + (t == 16 ? 0 : 2048);
        const unsigned char* g0p = G + (size_t)row0 * gp + col0;
#pragma unroll
        for (int ai = 0; ai < 2; ++ai) { u32x2 nw[4][2], dw[4][2];
#pragma unroll
            for (int m = 0; m < 4; ++m)
#pragma unroll
                for (int bj = 0; bj < 2; ++bj) { const size_t ro = (size_t)(ai * HALF + m * 16);
                    nw[m][bj] = *(const u32x2*)(g0p + ro * gp + bj * HALF); dw[m][bj] = *(const u32x2*)(g0p + ro * gp + bj * HALF + 2048); }
#pragma unroll
            for (int m = 0; m < 4; ++m)
#pragma unroll
                for (int bj = 0; bj < 2; ++bj) { f32x4 n0, n1, d0, d1; un8(nw[m][bj], n0, n1); un8(dw[m][bj], d0, d1);
                    acc[ai][bj][m][0] *= n0 * rcp4(d0); acc[ai][bj][m][1] *= n1 * rcp4(d1); }
            asm volatile("" ::: "memory"); }
    }
    __device__ __forceinline__ void operator()(f32x4 (&acc)[2][2][4][2], const Unit& u, int wr, int wc, int fr, int fq) const {
        const int row0 = u.pm * BM + wr * 64 + fr, col0 = u.pn * BM + wc * 32 + 8 * fq;
        const unsigned char* g0p = G + (size_t)row0 * gp + col0 + 4096; bf16_t* m0p = Mg + (size_t)row0 * 2048 + col0;
#pragma unroll
        for (int ai = 0; ai < 2; ++ai) { u32x2 gw[4][2];
#pragma unroll
            for (int m = 0; m < 4; ++m)
#pragma unroll
                for (int bj = 0; bj < 2; ++bj) gw[m][bj] = *(const u32x2*)(g0p + (size_t)(ai * HALF + m * 16) * gp + bj * HALF);
#pragma unroll
            for (int m = 0; m < 4; ++m)
#pragma unroll
                for (int bj = 0; bj < 2; ++bj) { f32x4 g0, g1; un8(gw[m][bj], g0, g1);
                    *(u32x4*)(m0p + (size_t)(ai * HALF + m * 16) * 2048 + bj * HALF) = pack8_bf16(acc[ai][bj][m][0] * (g0 * (1.0f / 255.0f)), acc[ai][bj][m][1] * (g1 * (1.0f / 255.0f))); }
            asm volatile("" ::: "memory"); }
    }
};
template <> struct has_mid<EpiMerge3> { static constexpr bool value = true; };
template <bool FIRST> struct EpiMerge {
    static constexpr bool PERM = true, AFTER_DRAIN = false;
    bf16_t* Mg; const bf16_t* G; int gp;
    __device__ __forceinline__ void operator()(f32x4 (&acc)[2][2][4][2], const Unit& u, int wr, int wc, int fr, int fq) const {
        const int row0 = u.pm * BM + wr * 64 + fr, col0 = u.pn * BM + wc * 32 + 8 * fq;
        const bf16_t* g0p = G + (size_t)row0 * gp + col0; bf16_t* m0p = Mg + (size_t)row0 * 2048 + col0;
#pragma unroll
        for (int ai = 0; ai < 2; ++ai) { u32x4 gw[4][2], mw[4][2];
#pragma unroll
            for (int m = 0; m < 4; ++m)
#pragma unroll
                for (int bj = 0; bj < 2; ++bj) { const size_t ro = (size_t)(ai * HALF + m * 16);
                    gw[m][bj] = *(const u32x4*)(g0p + ro * gp + bj * HALF); if (!FIRST) mw[m][bj] = *(const u32x4*)(m0p + ro * 2048 + bj * HALF); }
#pragma unroll
            for (int m = 0; m < 4; ++m)
#pragma unroll
                for (int bj = 0; bj < 2; ++bj) { const size_t ro = (size_t)(ai * HALF + m * 16);
                    f32x4 g0, g1; unpack8_bf16(gw[m][bj], g0, g1); f32x4 v0 = acc[ai][bj][m][0] * g0, v1 = acc[ai][bj][m][1] * g1;
                    if (!FIRST) { f32x4 m0, m1; unpack8_bf16(mw[m][bj], m0, m1); v0 += m0; v1 += m1; }
                    *(u32x4*)(m0p + ro * 2048 + bj * HALF) = pack8_bf16(v0, v1); }
            asm volatile("" ::: "memory"); }
    }
};
template <bool F> struct FragA_ { bf16x8 v[4][2]; }; template <> struct FragA_<true> { v8i_t v[4]; };
template <bool F> struct FragB_ { bf16x8 v[2][2]; }; template <> struct FragB_<true> { v8i_t v[2]; };
template <class Epi, class Sched, bool ALIGN_EPI = false, bool SP2 = false, bool REVK = false, bool ATILED = false, bool BTILED = false, bool FP8 = false>
__device__ __forceinline__ void gemm_phase(PG8_LAS unsigned char* lds, const Gemm g, const Sched S, const Epi E, int wave_id) {
    unsigned m1_ = ~0u; asm volatile("" : "+s"(m1_)); int tid_ = wave_id * 64 + (int)__builtin_amdgcn_mbcnt_hi(m1_, __builtin_amdgcn_mbcnt_lo(m1_, 0u)); asm volatile("" : "+v"(tid_));
    const int tid = tid_, wid = __builtin_amdgcn_readfirstlane(tid >> 6), lane = tid & 63, wr = wid >> 2, wc = wid & 3, fr = lane & 15, fq = lane >> 4;
    const int K = g.K, nt = K / BK, LD = g.ld ? g.ld : K;
    unsigned voffA[2], voffB[2];
#pragma unroll
    for (int i = 0; i < 2; ++i) { int R, C; stage_rc(tid * 16 + i * 8192, R, C); const int Rb = Epi::PERM ? ((R & ~31) + perm32(R & 31)) : R;
        voffA[i] = ATILED ? (unsigned)(R * BK + C) * 2u : (unsigned)(R * LD + C) * 2u; voffB[i] = BTILED ? (unsigned)(Rb * BK + C) * 2u : (unsigned)(Rb * LD + C) * 2u; }
    const size_t kstep = REVK ? (size_t)0 - (size_t)(BK * 2) : (size_t)(BK * 2), kbase = REVK ? (size_t)(K - BK) * 2 : (size_t)0;
    const size_t hstep = (size_t)HALF * LD * 2;
    const size_t kstepB = BTILED ? (size_t)(BM * BK * 2) : kstep, hstepB = BTILED ? (size_t)(HALF * BK * 2) : hstep;
    const size_t kstepA = ATILED ? (size_t)(BM * BK * 2) : kstep, hstepA = ATILED ? (size_t)(HALF * BK * 2) : hstep;
    const size_t tstep = 2 * hstep;
    const unsigned ldsw = (unsigned)wid * 1024u;
    const int aoff = lds_byte(wr * 64 + fr, fq * 8), boff = lds_byte(wc * 32 + fr, fq * 8);
#define PG8_SA(b, h) (((b) * 2 + (h)) * HTB)
#define PG8_SB(b, h) ((4 + (b) * 2 + (h)) * HTB)
#define PG8_STAGE(bufoff, gbase, voff) do { _Pragma("unroll") for (int _i = 0; _i < 2; ++_i) \
        __builtin_amdgcn_global_load_lds((const unsigned*)((const char*)(gbase) + (voff)[_i]), (PG8_LAS unsigned*)(lds + (bufoff) + ldsw + _i * 8192), 16, 0, 0); } while (0)
#define PG8_LDA(dst, b, h) do { if constexpr (FP8) { _Pragma("unroll") for (int m = 0; m < 4; ++m) { const v4i_t lo_ = *(const PG8_LAS v4i_t*)(lds + PG8_SA(b, h) + aoff + m * 2048), hi_ = *(const PG8_LAS v4i_t*)(lds + PG8_SA(b, h) + aoff + m * 2048 + 1024); dst.v[m] = __builtin_shufflevector(lo_, hi_, 0, 1, 2, 3, 4, 5, 6, 7); } } \
        else { _Pragma("unroll") for (int m = 0; m < 4; ++m) _Pragma("unroll") for (int k = 0; k < 2; ++k) dst.v[m][k] = *(const PG8_LAS bf16x8*)(lds + PG8_SA(b, h) + aoff + m * 2048 + k * 1024); } } while (0)
#define PG8_LDB(dst, b, h) do { if constexpr (FP8) { _Pragma("unroll") for (int n = 0; n < 2; ++n) { const v4i_t lo_ = *(const PG8_LAS v4i_t*)(lds + PG8_SB(b, h) + boff + n * 2048), hi_ = *(const PG8_LAS v4i_t*)(lds + PG8_SB(b, h) + boff + n * 2048 + 1024); dst.v[n] = __builtin_shufflevector(lo_, hi_, 0, 1, 2, 3, 4, 5, 6, 7); } } \
        else { _Pragma("unroll") for (int n = 0; n < 2; ++n) _Pragma("unroll") for (int k = 0; k < 2; ++k) dst.v[n][k] = *(const PG8_LAS bf16x8*)(lds + PG8_SB(b, h) + boff + n * 2048 + k * 1024); } } while (0)
#define PG8_MMA(ai, bj, At, Bt) do { __builtin_amdgcn_s_setprio(1); \
        if constexpr (FP8) { _Pragma("unroll") for (int m = 0; m < 4; ++m) _Pragma("unroll") for (int n = 0; n < 2; ++n) \
            asm volatile("v_mfma_scale_f32_16x16x128_f8f6f4 %0, %1, %2, %0, %3, %3 op_sel_hi:[0,0,0]" : "+v"(acc[ai][bj][m][n]) : "v"(Bt.v[n]), "v"(At.v[m]), "v"(sc_one)); } \
        else { _Pragma("unroll") for (int m = 0; m < 4; ++m) _Pragma("unroll") for (int n = 0; n < 2; ++n) _Pragma("unroll") for (int k = 0; k < 2; ++k) \
            acc[ai][bj][m][n] = __builtin_amdgcn_mfma_f32_16x16x32_bf16(Bt.v[n][k], At.v[m][k], acc[ai][bj][m][n], 0, 0, 0); } \
        __builtin_amdgcn_s_setprio(0); } while (0)
#define PG8_WAIT_V(n) asm volatile("s_waitcnt vmcnt(" #n ")" ::: "memory")
#define PG8_WAIT_L(n) asm volatile("s_waitcnt lgkmcnt(" #n ")" ::: "memory")
#define PG8_BAR __builtin_amdgcn_s_barrier()
#define PG8_SCHED __builtin_amdgcn_sched_barrier(0)
    Unit cur, nxt; int ui = 0;
    if (!S.next(0, cur)) return;
    f32x4 acc[2][2][4][2];
#pragma unroll
    for (int a = 0; a < 2; ++a)
#pragma unroll
        for (int b = 0; b < 2; ++b)
#pragma unroll
            for (int m = 0; m < 4; ++m)
#pragma unroll
                for (int n = 0; n < 2; ++n) acc[a][b][m][n] = (f32x4){0.f, 0.f, 0.f, 0.f};
    int sc_one = 0x7f7f7f7f; asm volatile("" : "+v"(sc_one));
    FragA_<FP8> At; FragB_<FP8> B0, B1;
    const char* cA = (const char*)g.A + (size_t)cur.pm * tstep + kbase; const char* cB = (const char*)g.Bt + (size_t)cur.pn * tstep + kbase;
    S.a_ready(cur);
    if constexpr (SP2) {
        PG8_STAGE(PG8_SB(0, 0), cB, voffB); PG8_STAGE(PG8_SB(0, 1), cB + hstepB, voffB); PG8_STAGE(PG8_SA(0, 0), cA, voffA); PG8_STAGE(PG8_SA(0, 1), cA + hstepA, voffA);
        if (wr == 1) PG8_BAR;
        PG8_WAIT_V(2); PG8_BAR;
        PG8_STAGE(PG8_SB(1, 0), cB + kstepB, voffB); PG8_STAGE(PG8_SA(1, 0), cA + kstepA, voffA); PG8_STAGE(PG8_SB(1, 1), cB + hstepB + kstepB, voffB);
        PG8_WAIT_V(6); PG8_BAR;
    } else {
        PG8_STAGE(PG8_SB(0, 0), cB, voffB); PG8_STAGE(PG8_SA(0, 0), cA, voffA); PG8_STAGE(PG8_SB(0, 1), cB + hstepB, voffB); PG8_STAGE(PG8_SA(0, 1), cA + hstepA, voffA);
        if (wr == 1) PG8_BAR;
        PG8_WAIT_V(4); PG8_BAR;
        PG8_STAGE(PG8_SB(1, 0), cB + kstepB, voffB); PG8_STAGE(PG8_SA(1, 0), cA + kstepA, voffA); PG8_STAGE(PG8_SB(1, 1), cB + hstepB + kstepB, voffB);
        PG8_WAIT_V(6); PG8_BAR;
    }
    for (;;) {
        const bool has_next = S.next(ui + 1, nxt);
        const char* nA = has_next ? (const char*)g.A + (size_t)nxt.pm * tstep + kbase : cA; const char* nB = has_next ? (const char*)g.Bt + (size_t)nxt.pn * tstep + kbase : cB;
        for (int t = 0; t < nt; t += 2) {
            if constexpr (has_mid<Epi>::value) { if (E.mid_at(t)) { int fr_m = fr, fq_m = fq; asm volatile("" : "+v"(fr_m), "+v"(fq_m)); E.mid(acc, cur, wr, wc, fr_m, fq_m, t); } }
            const bool last = (t == nt - 2);
            const char* a1 = cA + (size_t)(t + 1) * kstepA;
            const char* a2 = last ? nA : cA + (size_t)(t + 2) * kstepA; const char* b2 = last ? nB : cB + (size_t)(t + 2) * kstepB;
            const char* a3 = a2 + kstepA; const char* b3 = b2 + kstepB;
            if (last && has_next) S.a_ready(nxt);
            if constexpr (SP2) {
            PG8_LDB(B0, 0, 0); PG8_LDB(B1, 0, 1); PG8_SCHED; PG8_LDA(At, 0, 0); PG8_STAGE(PG8_SA(1, 1), a1 + hstepA, voffA);
            PG8_WAIT_V(8); PG8_WAIT_L(0); PG8_BAR; PG8_MMA(0, 0, At, B0); PG8_MMA(0, 1, At, B1); PG8_BAR; PG8_SCHED;
            PG8_LDA(At, 0, 1); PG8_STAGE(PG8_SB(0, 0), b2, voffB); PG8_STAGE(PG8_SB(0, 1), b2 + hstepB, voffB); PG8_STAGE(PG8_SA(0, 0), a2, voffA);
            PG8_WAIT_V(8); PG8_WAIT_L(0); PG8_BAR; PG8_MMA(1, 0, At, B0); PG8_MMA(1, 1, At, B1); PG8_BAR; PG8_SCHED;
            PG8_LDB(B0, 1, 0); PG8_LDB(B1, 1, 1); PG8_SCHED; PG8_LDA(At, 1, 0); PG8_STAGE(PG8_SA(0, 1), a2 + hstepA, voffA);
            PG8_WAIT_V(8); PG8_WAIT_L(0); PG8_BAR; PG8_MMA(0, 0, At, B0); PG8_MMA(0, 1, At, B1); PG8_BAR; PG8_SCHED;
            PG8_LDA(At, 1, 1); PG8_STAGE(PG8_SB(1, 0), b3, voffB); PG8_STAGE(PG8_SB(1, 1), b3 + hstepB, voffB); PG8_STAGE(PG8_SA(1, 0), a3, voffA);
            PG8_WAIT_V(8); PG8_WAIT_L(0); PG8_BAR; PG8_MMA(1, 0, At, B0); PG8_MMA(1, 1, At, B1); PG8_BAR; PG8_SCHED;
            } else {
            PG8_LDB(B0, 0, 0); PG8_SCHED; PG8_LDA(At, 0, 0); PG8_STAGE(PG8_SA(1, 1), a1 + hstepA, voffA);
            PG8_WAIT_L(8); PG8_BAR; PG8_WAIT_L(0); PG8_MMA(0, 0, At, B0); PG8_BAR; PG8_SCHED;
            PG8_LDB(B1, 0, 1); PG8_STAGE(PG8_SB(0, 0), b2, voffB);
            PG8_BAR; PG8_WAIT_L(0); PG8_MMA(0, 1, At, B1); PG8_BAR;
            PG8_LDA(At, 0, 1); PG8_STAGE(PG8_SA(0, 0), a2, voffA);
            PG8_BAR; PG8_WAIT_L(0); PG8_MMA(1, 0, At, B0); PG8_BAR; PG8_SCHED;
            PG8_STAGE(PG8_SB(0, 1), b2 + hstepB, voffB);
            PG8_WAIT_V(6); PG8_BAR; PG8_MMA(1, 1, At, B1); PG8_BAR;
            PG8_LDB(B0, 1, 0); PG8_SCHED; PG8_LDA(At, 1, 0); PG8_STAGE(PG8_SA(0, 1), a2 + hstepA, voffA);
            PG8_WAIT_L(8); PG8_BAR; PG8_WAIT_L(0); PG8_MMA(0, 0, At, B0); PG8_BAR; PG8_SCHED;
            PG8_LDB(B1, 1, 1); PG8_STAGE(PG8_SB(1, 0), b3, voffB);
            PG8_BAR; PG8_WAIT_L(0); PG8_MMA(0, 1, At, B1); PG8_BAR;
            PG8_LDA(At, 1, 1); PG8_STAGE(PG8_SA(1, 0), a3, voffA);
            PG8_BAR; PG8_WAIT_L(0); PG8_MMA(1, 0, At, B0); PG8_BAR; PG8_SCHED;
            PG8_STAGE(PG8_SB(1, 1), b3 + hstepB, voffB);
            PG8_WAIT_V(6); PG8_BAR; PG8_MMA(1, 1, At, B1); PG8_BAR;
            }
        }
        if constexpr (FP8) { asm volatile("s_nop 15\n\ts_nop 15\n\ts_nop 15\n\ts_nop 15\n\ts_nop 15" ::: "memory"); }
        if constexpr (ALIGN_EPI) { if (wr == 0) PG8_BAR; }
        if constexpr (!Epi::AFTER_DRAIN) { int fr_e = fr, fq_e = fq; asm volatile("" : "+v"(fr_e), "+v"(fq_e));
            E(acc, cur, wr, wc, fr_e, fq_e); S.done(cur); }
        if (!has_next) break;
#pragma unroll
        for (int a = 0; a < 2; ++a)
#pragma unroll
            for (int b = 0; b < 2; ++b)
#pragma unroll
                for (int m = 0; m < 4; ++m)
#pragma unroll
                    for (int n = 0; n < 2; ++n) acc[a][b][m][n] = (f32x4){0.f, 0.f, 0.f, 0.f};
        cur = nxt; cA = nA; cB = nB; ++ui;
        if constexpr (ALIGN_EPI) { if (wr == 1) PG8_BAR; }
    }
    PG8_WAIT_V(0);
    if constexpr (!ALIGN_EPI) { if (wr == 0) PG8_BAR; }
    PG8_BAR;
    if constexpr (Epi::AFTER_DRAIN) { E.fused(acc, cur, wr, wc, fr, fq, lds, wid, lane); S.done(cur); }
#undef PG8_SA
#undef PG8_SB
#undef PG8_STAGE
#undef PG8_LDA
#undef PG8_LDB
#undef PG8_MMA
#undef PG8_WAIT_V
#undef PG8_WAIT_L
#undef PG8_BAR
#undef PG8_SCHED
}
}
namespace att {
#define ATT_LAS __attribute__((address_space(3)))
typedef unsigned short bf16;
typedef short bf16x8 __attribute__((ext_vector_type(8)));
typedef short s16x4 __attribute__((ext_vector_type(4)));
typedef float f32x16 __attribute__((ext_vector_type(16)));
typedef float f32x4 __attribute__((ext_vector_type(4)));
typedef unsigned u32x4 __attribute__((ext_vector_type(4)));
constexpr int NW = 8, QBLK = 32, KVBLK = 64, QB = NW * QBLK;
constexpr int SEQ = 2048, NH = 16, QPITCH = 3072, KPITCH = 2048, PEPITCH = 64, OPITCH = 4096  , QHEAD = 192;
constexpr float SCALE = 0.07216878364870322f;
constexpr float THR = 8.f;
constexpr int SHM_V = 16384, SHM_KN = 16384, SHM_KP = 8192;
constexpr int OFF_V = 0, OFF_KN = 3 * SHM_V, OFF_KP = OFF_KN + 2 * SHM_KN, OFF_WS = OFF_KP + 2 * SHM_KP, LDS_BYTES = OFF_WS + NW * 64 * 4;
#define ATT_KSWZ(row, colB) ((row) * 256 + ((colB) ^ (((row) & 7) << 4)))
#define ATT_KPSWZ(row, ch) ((row) * 128 + ((((ch) ^ (((row) >> 1) & 7))) << 4))
#define ATT_SBAR() __builtin_amdgcn_sched_barrier(0)
__device__ __forceinline__ int v_st(int k, int c) { const int kk = (k & ~0xC) | ((k & 4) << 1) | ((k & 8) >> 1); return ((kk >> 3) * 4 + (c >> 5)) * 512 + ((kk & 7) * 32 + (c & 31)) * 2; }
__device__ __forceinline__ int v_rd_base(int lane) { return ((lane & 3) << 3) | (((lane >> 2) & 3) << 6) | (((lane >> 4) & 1) << 5) | (((lane >> 5) & 1) << 8); }
constexpr int v_rd_off(int d0, int ks, int half) { return d0 * 512 + ks * 4096 + half * 2048; }
__device__ __forceinline__ int crow(int r, int hi) { return (r & 3) + 8 * (r >> 2) + 4 * hi; }
__device__ __forceinline__ unsigned cvtpk(float lo, float hi) { unsigned r; asm volatile("v_cvt_pk_bf16_f32 %0, %1, %2" : "=v"(r) : "v"(lo), "v"(hi)); return r; }
__device__ __forceinline__ void mask_tile(f32x16& p0, f32x16& p1, int dq) {
    const float NEG = -__builtin_inff();
#pragma unroll
    for (int r = 0; r < 16; ++r) { const int c = (r & 3) + 8 * (r >> 2); if (dq - c < 0) p0[r] = NEG; if (dq - c - 32 < 0) p1[r] = NEG; }
}
__device__ __forceinline__ void partialSM(f32x16& p0, f32x16& p1, float& m_reg, float& mn, float& alpha) {
    float pmax = p0[0];
#pragma unroll
    for (int r = 1; r < 16; ++r) pmax = fmaxf(pmax, p0[r]);
#pragma unroll
    for (int r = 0; r < 16; ++r) pmax = fmaxf(pmax, p1[r]);
    { auto rr = __builtin_amdgcn_permlane32_swap(__float_as_uint(pmax), __float_as_uint(pmax), false, false); pmax = fmaxf(__uint_as_float(rr[0]), __uint_as_float(rr[1])); }
    constexpr float C2 = 1.4426950408889634f * SCALE;
    if (__builtin_expect(__all((pmax - m_reg) * SCALE <= THR), 1)) { mn = m_reg; alpha = 1.f; }
    else { mn = fmaxf(m_reg, pmax); alpha = __builtin_amdgcn_exp2f((m_reg - mn) * C2); m_reg = mn; }
    const float mnL = -mn * C2;
#pragma unroll
    for (int r = 0; r < 16; ++r) p0[r] = fmaf(p0[r], C2, mnL);
#pragma unroll
    for (int r = 0; r < 16; ++r) p1[r] = fmaf(p1[r], C2, mnL);
#pragma unroll
    for (int r = 0; r < 16; ++r) p0[r] = __builtin_amdgcn_exp2f(p0[r]);
}
__device__ __forceinline__ void finishSM(f32x16& p0, f32x16& p1, float alpha, float& l_reg, bf16x8& pa0, bf16x8& pa1, bf16x8& pa2, bf16x8& pa3) {
#pragma unroll
    for (int r = 0; r < 16; ++r) p1[r] = __builtin_amdgcn_exp2f(p1[r]);
    float ps = 0;
#pragma unroll
    for (int r = 0; r < 16; ++r) ps += p0[r];
#pragma unroll
    for (int r = 0; r < 16; ++r) ps += p1[r];
    { auto rr = __builtin_amdgcn_permlane32_swap(__float_as_uint(ps), __float_as_uint(ps), false, false); ps = __uint_as_float(rr[0]) + __uint_as_float(rr[1]); }
    l_reg = l_reg * alpha + ps;
#define ATT_PK4(P, B_, OUT) do { unsigned a0 = cvtpk(P[B_+0], P[B_+1]), a1 = cvtpk(P[B_+2], P[B_+3]);                          \
        unsigned b0 = cvtpk(P[B_+4], P[B_+5]), b1 = cvtpk(P[B_+6], P[B_+7]);                                             \
        auto r0 = __builtin_amdgcn_permlane32_swap(a0, b0, false, false); auto r1 = __builtin_amdgcn_permlane32_swap(a1, b1, false, false); \
        u32x4 w = {r0[0], r1[0], r0[1], r1[1]}; OUT = __builtin_bit_cast(bf16x8, w); } while (0)
    ATT_PK4(p0, 0, pa0); ATT_PK4(p0, 8, pa1); ATT_PK4(p1, 0, pa2); ATT_PK4(p1, 8, pa3);
#undef ATT_PK4
}
__device__ __forceinline__ void qkt(f32x16& p0, f32x16& p1, ATT_LAS const char* lds, int kbuf, int r32, int hi, const bf16x8* qr) {
    p0 = f32x16{}; p1 = f32x16{};
    ATT_LAS const char* kb[4];
#pragma unroll
    for (int dd = 0; dd < 4; ++dd) kb[dd] = lds + OFF_KN + kbuf * SHM_KN + ATT_KSWZ(r32, (dd * 16 + hi * 8) * 2);
#pragma unroll
    for (int d0 = 0; d0 < 8; ++d0) { ATT_LAS const char* a = kb[d0 & 3] + (d0 >> 2) * 128;
        const bf16x8 b0 = *(ATT_LAS const bf16x8*)a;
        const bf16x8 b1 = *(ATT_LAS const bf16x8*)(a + 32 * 256);
        p0 = __builtin_amdgcn_mfma_f32_32x32x16_bf16(b0, qr[d0], p0, 0, 0, 0);
        p1 = __builtin_amdgcn_mfma_f32_32x32x16_bf16(b1, qr[d0], p1, 0, 0, 0); }
#pragma unroll
    for (int d1 = 0; d1 < 4; ++d1) { ATT_LAS const char* a = lds + OFF_KP + kbuf * SHM_KP + ATT_KPSWZ(r32, 2 * d1 + hi);
        const bf16x8 b0 = *(ATT_LAS const bf16x8*)a;
        const bf16x8 b1 = *(ATT_LAS const bf16x8*)(a + 32 * 128);
        p0 = __builtin_amdgcn_mfma_f32_32x32x16_bf16(b0, qr[8 + d1], p0, 0, 0, 0);
        p1 = __builtin_amdgcn_mfma_f32_32x32x16_bf16(b1, qr[8 + d1], p1, 0, 0, 0); }
}
__device__ __forceinline__ void pv_tile(f32x16* o, int vb0, bf16x8 pa0, bf16x8 pa1, bf16x8 pa2, bf16x8 pa3) {
#define ATT_TRRD(dst, off) asm volatile("ds_read_b64_tr_b16 %0, %1 offset:%2" : "=&v"(dst) : "v"(vb0), "i"(off) : "memory")
#define ATT_PV_RD(S, d0) do { constexpr int b_ = OFF_V + v_rd_off(d0, 0, 0); \
        ATT_TRRD(S##l0, b_); ATT_TRRD(S##h0, b_ + 2048); ATT_TRRD(S##l1, b_ + 4096); ATT_TRRD(S##h1, b_ + 6144); ATT_TRRD(S##l2, b_ + 8192); ATT_TRRD(S##h2, b_ + 10240); ATT_TRRD(S##l3, b_ + 12288); ATT_TRRD(S##h3, b_ + 14336); } while (0)
#define ATT_PV_MM(S, d0) do { \
        o[d0] = __builtin_amdgcn_mfma_f32_32x32x16_bf16(pa0, (bf16x8){S##l0[0], S##l0[1], S##l0[2], S##l0[3], S##h0[0], S##h0[1], S##h0[2], S##h0[3]}, o[d0], 0, 0, 0);   \
        o[d0] = __builtin_amdgcn_mfma_f32_32x32x16_bf16(pa1, (bf16x8){S##l1[0], S##l1[1], S##l1[2], S##l1[3], S##h1[0], S##h1[1], S##h1[2], S##h1[3]}, o[d0], 0, 0, 0);   \
        o[d0] = __builtin_amdgcn_mfma_f32_32x32x16_bf16(pa2, (bf16x8){S##l2[0], S##l2[1], S##l2[2], S##l2[3], S##h2[0], S##h2[1], S##h2[2], S##h2[3]}, o[d0], 0, 0, 0);   \
        o[d0] = __builtin_amdgcn_mfma_f32_32x32x16_bf16(pa3, (bf16x8){S##l3[0], S##l3[1], S##l3[2], S##l3[3], S##h3[0], S##h3[1], S##h3[2], S##h3[3]}, o[d0], 0, 0, 0); } while (0)
#define ATT_LGK(n) do { asm volatile("s_waitcnt lgkmcnt(" #n ")" ::: "memory"); ATT_SBAR(); } while (0)
    s16x4 Al0, Al1, Al2, Al3, Ah0, Ah1, Ah2, Ah3, Bl0, Bl1, Bl2, Bl3, Bh0, Bh1, Bh2, Bh3;
    ATT_PV_RD(A, 0);
    ATT_PV_RD(B, 1); ATT_LGK(8); ATT_PV_MM(A, 0); ATT_SBAR();
    ATT_PV_RD(A, 2); ATT_LGK(8); ATT_PV_MM(B, 1); ATT_SBAR();
    ATT_PV_RD(B, 3); ATT_LGK(8); ATT_PV_MM(A, 2); ATT_SBAR();
    ATT_LGK(0); ATT_PV_MM(B, 3);
#undef ATT_LGK
#undef ATT_PV_MM
#undef ATT_PV_RD
#undef ATT_TRRD
}
__device__ __forceinline__ void attn_unit(int b, int h, int qb, const bf16* __restrict__ Q, const bf16* __restrict__ KN, const bf16* __restrict__ KPE, const bf16* __restrict__ V, bf16* __restrict__ O, ATT_LAS char* lds, int wave_id) {
    unsigned m1_ = ~0u; asm volatile("" : "+s"(m1_)); int tid_ = wave_id * 64 + (int)__builtin_amdgcn_mbcnt_hi(m1_, __builtin_amdgcn_mbcnt_lo(m1_, 0u)); asm volatile("" : "+v"(tid_));
    const int tid = tid_, wid = __builtin_amdgcn_readfirstlane(tid >> 6), lane = tid & 63, r32 = lane & 31, hi = lane >> 5;
    const size_t rowbase = (size_t)b * SEQ; const int q0 = qb * QB, NT = (q0 + QB) / KVBLK;
    const int qlo = q0 + wid * QBLK, qm = qlo + r32 - 4 * hi;
    ATT_LAS float* ws = (ATT_LAS float*)(lds + OFF_WS) + wid * 64; ATT_LAS float* li_l = ws; ATT_LAS float* al_l = ws + 32;
    const int sr = tid >> 4, sc = (tid & 15) * 8, vst0 = v_st(sr, sc), vst1 = v_st(32 + sr, sc), kws = ATT_KSWZ(sr, sc * 2);
    const int pr = tid >> 3, pc = tid & 7, kpw = ATT_KPSWZ(pr, pc);
    const bf16* gK = KN + (rowbase + sr) * KPITCH + h * 128 + sc;
    const bf16* gV = V + (rowbase + sr) * KPITCH + h * 128 + sc;
    const bf16* gP = KPE + (rowbase + pr) * PEPITCH + pc * 8;
    const int vb0 = (int)(uintptr_t)lds + v_rd_base(lane);
    bf16x8 st_k0, st_k1, st_v0, st_v1, st_p;
#define ATT_SLOAD(t) do { const size_t ko_ = (size_t)(t) * KVBLK; st_v0 = *(const bf16x8*)(gV + ko_ * KPITCH); st_v1 = *(const bf16x8*)(gV + (ko_ + 32) * KPITCH); \
        st_k0 = *(const bf16x8*)(gK + ko_ * KPITCH); st_k1 = *(const bf16x8*)(gK + (ko_ + 32) * KPITCH); st_p = *(const bf16x8*)(gP + ko_ * PEPITCH); } while (0)
#define ATT_SWRITE(kbf, vbf) do { *(ATT_LAS bf16x8*)(lds + OFF_V + (vbf) * SHM_V + vst0) = st_v0; *(ATT_LAS bf16x8*)(lds + OFF_V + (vbf) * SHM_V + vst1) = st_v1; \
        *(ATT_LAS bf16x8*)(lds + OFF_KN + (kbf) * SHM_KN + kws) = st_k0; *(ATT_LAS bf16x8*)(lds + OFF_KN + (kbf) * SHM_KN + kws + 32 * 256) = st_k1; \
        *(ATT_LAS bf16x8*)(lds + OFF_KP + (kbf) * SHM_KP + kpw) = st_p; } while (0)
#define ATT_VMW() asm volatile("s_waitcnt vmcnt(0)" ::: "memory")
    bf16x8 qr[12];
    { const bf16* Qw = Q + (rowbase + qlo + r32) * QPITCH + h * QHEAD + hi * 8;
#pragma unroll
      for (int d0 = 0; d0 < 12; ++d0) qr[d0] = *(const bf16x8*)(Qw + d0 * 16); }
    ATT_SLOAD(0); ATT_VMW(); ATT_SWRITE(0, 0); __syncthreads();
    float m_reg = -1e30f, l_reg = 0.f; f32x16 o[4] = {};
#define ATT_RESC(a) do { if (__any((a) < 1.f)) { if (hi == 0) al_l[r32] = (a); asm volatile("s_waitcnt lgkmcnt(0)" ::: "memory");              \
        _Pragma("unroll") for (int d_ = 0; d_ < 4; ++d_) _Pragma("unroll") for (int r = 0; r < 16; ++r) o[d_][r] *= al_l[crow(r, hi)]; } } while (0)
    const bool grpB = wid >= 4;
    bf16x8 pa0 = {}, pa1 = {}, pa2 = {}, pa3 = {};
    bool act_prev = false; int kbuf = 0, vbuf = 0, vprev = 0;
    for (int t = 0; t < NT; ++t) {
        const int vnext = (vbuf == 2) ? 0 : vbuf + 1;
        if (t + 1 < NT) ATT_SLOAD(t + 1);
        ATT_SBAR();
        const int kb_ = t * KVBLK; const bool act = kb_ <= qlo + QBLK - 1;
        if (grpB && act_prev) { pv_tile(o, vb0 + vprev * SHM_V, pa0, pa1, pa2, pa3); ATT_SBAR(); }
        if (act) {
            f32x16 p0, p1; qkt(p0, p1, lds, kbuf, r32, hi, qr);
            if (kb_ + KVBLK - 1 > qlo) mask_tile(p0, p1, qm - kb_);
            float mn, alpha; partialSM(p0, p1, m_reg, mn, alpha);
            ATT_RESC(alpha);
            finishSM(p0, p1, alpha, l_reg, pa0, pa1, pa2, pa3); ATT_SBAR();
            if (!grpB) pv_tile(o, vb0 + vbuf * SHM_V, pa0, pa1, pa2, pa3); }
        ATT_SBAR();
        if (t + 1 < NT) { ATT_VMW(); ATT_SWRITE(kbuf ^ 1, vnext); }
        __syncthreads();
        act_prev = act; vprev = vbuf; vbuf = vnext; kbuf ^= 1;
    }
    if (grpB && act_prev) pv_tile(o, vb0 + vprev * SHM_V, pa0, pa1, pa2, pa3);
    if (hi == 0) li_l[r32] = l_reg; asm volatile("s_waitcnt lgkmcnt(0)" ::: "memory");
    float rli[16];
#pragma unroll
    for (int r = 0; r < 16; ++r) rli[r] = __builtin_amdgcn_rcpf(li_l[crow(r, hi)]);
    bf16* Ow = O + (rowbase + qlo) * OPITCH + h * 128;
#pragma unroll
    for (int r = 0; r < 16; ++r) { const int orow = crow(r, hi);
#pragma unroll
        for (int d0 = 0; d0 < 4; ++d0) { const float v = o[d0][r] * rli[r]; const float vn = __shfl_xor(v, 1);
            if ((r32 & 1) == 0) *(unsigned*)(Ow + (size_t)orow * OPITCH + d0 * 32 + r32) = cvtpk(v, vn); } }
    __syncthreads();
#undef ATT_SLOAD
#undef ATT_SWRITE
#undef ATT_VMW
#undef ATT_RESC
}
}
#ifndef MK_N_LAUNCHES
#define MK_N_LAUNCHES 1
#endif
constexpr int NWAVES = 8;
constexpr int NB = 8, SEQ = 2048, M = NB * SEQ, D = 2048, DFF = 5632, LW = 1024, NHD = 16, KVR = 512, INW = 14912, INWP = 15104, MODW = 9 * 2048, NL = 2;
constexpr float EPS = 1e-6f;
constexpr int PPL = 9, N_PHASES = 3 + PPL * NL;
constexpr int CBW = 15104;
constexpr size_t MiB = 1u << 20;
constexpr size_t WS_CTL = 0, CTL_ZERO_BYTES = 4 * MiB;
constexpr size_t WS_SSQ = 12 * MiB + 768 * 1024;
constexpr size_t WS_SSQN = 12 * MiB;
constexpr size_t WS_CB = 1 * MiB;
constexpr size_t WS_MOD = 4 * MiB;
constexpr size_t WS_COS = 6 * MiB, WS_SIN = 8 * MiB;
constexpr size_t WS_AGG = 10 * MiB;
constexpr size_t WS_WAX = 11 * MiB;
constexpr size_t WS_W = 16 * MiB, W_LAYER = 219 * MiB;
#ifndef FP8_Q
#define FP8_Q 1
#endif
#ifndef FP8_ALL
#define FP8_ALL 0
#endif
#ifndef FP8_DN
#define FP8_DN 15
#endif
constexpr bool fp8_dn(int l, int f) { return ((FP8_DN >> (2 * l + f)) & 1) != 0; }
#ifndef FP8_G4
#define FP8_G4 0
#endif
#ifndef G1_BF16
#define G1_BF16 1
#endif
constexpr int WIN_QF8 = FP8_Q, WINB_REAL = FP8_ALL ? 0 : (WIN_QF8 ? 5696 : 8768), WINB_PADEND = FP8_ALL ? 0 : (WIN_QF8 ? 5888 : 8960), WINB_ROWS = G1_BF16 ? 7936 : WINB_PADEND, WINF_ROWS = FP8_ALL ? 15104 : (WIN_QF8 ? (G1_BF16 ? 7168 : 9216) : 6144);
static_assert(!G1_BF16 || (FP8_Q && !FP8_ALL), "G1_BF16 needs the q + gates fp8 split");
constexpr size_t WO_WIN8 = FP8_ALL ? 132 * MiB : 168 * MiB;
constexpr size_t WO_W13 = 0, WO_W2 = 88 * MiB, WO_WIN = 132 * MiB, WO_WCAT = 191 * MiB  , WO_LRUO = WO_WCAT, WO_SCO = WO_WCAT + 1024 * 2, WO_MLAO = WO_WCAT + 2048 * 2, WO_UKV = 207 * MiB, WO_WO = 211 * MiB;
constexpr int YP = 4096;
constexpr size_t WS_HN = 456 * MiB;
constexpr size_t WS_LRUX = 520 * MiB, WS_LRUG = 552 * MiB, WS_SCB = 584 * MiB, WS_SCC = 616 * MiB, WS_SCX = 648 * MiB, WS_Q = 680 * MiB, WS_KVLAT = 776 * MiB, WS_GATES = 792 * MiB, WS_KPE = 984 * MiB;
constexpr size_t WS_ACT = 520 * MiB;
constexpr size_t WS_KN = 986 * MiB, WS_V = 1050 * MiB;
constexpr size_t WS_R = 456 * MiB, WS_GX = 488 * MiB;
constexpr size_t WS_YCAT = 1114 * MiB, WS_YLRU = WS_YCAT, WS_YSC = WS_YCAT + 1024 * 2, WS_ATT = WS_YCAT + 2048 * 2;
constexpr size_t WS_MERGED = 520 * MiB;
constexpr size_t WS_XH = 1242 * MiB;
constexpr size_t WS_A8 = 1306 * MiB;
constexpr size_t WS_END = 1338 * MiB;
static_assert(WS_W + NL * W_LAYER <= WS_HN && WS_ACT + (size_t)M * DFF * 2 <= WS_KN && WS_KPE + (size_t)M * 64 * 2 <= WS_KN && WS_YCAT + (size_t)M * YP * 2 <= WS_XH && WS_GX + (size_t)M * LW * 2 <= WS_LRUX && WS_XH + (size_t)M * D * 2 <= WS_A8 && WS_A8 + (size_t)M * D <= WS_END, "d_ws map");
static_assert(WS_SSQN + (size_t)NL * 3 * M * 8 <= WS_SSQ && WS_SSQ + (size_t)NL * M * 8 <= WS_W && WS_WAX + (size_t)NL * 2 * 8 * 16384 * 2 <= WS_SSQN && WS_CB + (size_t)NL * 3 * NB * CBW * 4 <= CTL_ZERO_BYTES && WS_MOD + (size_t)NL * NB * MODW * 4 <= WS_COS, "zeroed region map");
constexpr int CW_TMO = 0, CW_CODE = 1, CW_BAR = 4096;
constexpr int RING_OFF = 0, RING_BYTES = 131072;
constexpr int LDSCTL_OFF = RING_BYTES, MISC_OFF = LDSCTL_OFF + 320;
constexpr int LDS_BYTES = 147456;
#define GAS __attribute__((address_space(1)))
#define LAS __attribute__((address_space(3)))
typedef unsigned short bf16;
typedef unsigned v4u __attribute__((ext_vector_type(4)));
typedef unsigned v2u __attribute__((ext_vector_type(2)));
typedef float f32x4 __attribute__((ext_vector_type(4)));
typedef short bf16x8 __attribute__((ext_vector_type(8)));
typedef GAS unsigned gu32;
#define RLX_AGENT __ATOMIC_RELAXED, __HIP_MEMORY_SCOPE_AGENT
#define LDS_WAIT() asm volatile("s_waitcnt lgkmcnt(0)" ::: "memory")
#define VM_WAIT() asm volatile("s_waitcnt vmcnt(0)" ::: "memory")
__device__ __forceinline__ unsigned f2bf(float f) { unsigned u = __builtin_bit_cast(unsigned, f); return (u + 0x7fffu + ((u >> 16) & 1u)) >> 16; }
__device__ __forceinline__ unsigned pk2(float lo, float hi) { return f2bf(lo) | (f2bf(hi) << 16); }
__device__ __forceinline__ float bf2f(unsigned short b) { return __uint_as_float((unsigned)b << 16); }
__device__ __forceinline__ void unpack8(const v4u w, float (&f)[8]) {
    f[0] = __uint_as_float(w.x << 16); f[1] = __uint_as_float(w.x & 0xffff0000u); f[2] = __uint_as_float(w.y << 16); f[3] = __uint_as_float(w.y & 0xffff0000u);
    f[4] = __uint_as_float(w.z << 16); f[5] = __uint_as_float(w.z & 0xffff0000u); f[6] = __uint_as_float(w.w << 16); f[7] = __uint_as_float(w.w & 0xffff0000u); }
__device__ __forceinline__ v4u pack8(const float (&f)[8]) { v4u w; w.x = pk2(f[0], f[1]); w.y = pk2(f[2], f[3]); w.z = pk2(f[4], f[5]); w.w = pk2(f[6], f[7]); return w; }

#define XB_TMO      128
#define XB_XCNT(j)  (256  + 64 * (j))
#define XB_XSUB(j)  (1280 + 64 * (j))
#define XB_XGEN(j)  (2304 + 64 * (j))
#define XB_TOP      3328
#define XB_TOPGEN   3392
#define XCD_BAR_WORDS 3456
#define XB_SPIN_CAP (1u << 18)

__device__ __forceinline__ unsigned xb_ld(unsigned* p)              { return __hip_atomic_load(p, __ATOMIC_RELAXED, __HIP_MEMORY_SCOPE_AGENT); }
__device__ __forceinline__ unsigned xb_add(unsigned* p, unsigned v) { return __hip_atomic_fetch_add(p, v, __ATOMIC_RELAXED, __HIP_MEMORY_SCOPE_AGENT); }
__device__ __forceinline__ unsigned xb_xcc_id() { return (unsigned)__builtin_amdgcn_s_getreg((3 << 11) | 20) & 0xFu; }
#define XB_SPIN(cond, bar) do { unsigned _sp = 0; while (cond) { __builtin_amdgcn_s_sleep(1); \
    if ((++_sp & 255u) == 0u) { if (xb_ld(&(bar)[XB_TMO])) break; if (_sp > XB_SPIN_CAP) { atomicAdd(&(bar)[XB_TMO], 1u); break; } } } } while (0)

struct XcdBarrier {
    unsigned* bar; unsigned x;
    volatile LAS unsigned* st;
};

__device__ __forceinline__ XcdBarrier xcd_barrier_post(unsigned* bar, volatile LAS unsigned* st) {
    XcdBarrier b; b.bar = bar; b.x = xb_xcc_id(); b.st = st;
    if (threadIdx.x == 0) (void)xb_add(&bar[XB_XCNT(b.x)], 1u);
    return b;
}
__device__ __forceinline__ void xcd_barrier_complete(unsigned* bar, unsigned x, unsigned& nloc, unsigned& nx) {
    const unsigned G = gridDim.x * gridDim.y * gridDim.z;
    unsigned sum, cnt, mine, sp = 0u;
    for (;;) {
        sum = 0u; cnt = 0u; mine = 0u;
#pragma unroll
        for (unsigned j = 0; j < 16; ++j) { const unsigned c = xb_ld(&bar[XB_XCNT(j)]); sum += c; cnt += (c > 0u) ? 1u : 0u; mine = (j == x) ? c : mine; }
        if (sum == G) break;
        __builtin_amdgcn_s_sleep(1);
        if ((++sp & 255u) == 0u) { if (xb_ld(&bar[XB_TMO])) break; if (sp > XB_SPIN_CAP) { atomicAdd(&bar[XB_TMO], 1u); break; } }
    }
    nloc = mine > 0u ? mine : 1u; nx = cnt > 0u ? cnt : 1u;
}

__device__ __forceinline__ void xcd_barrier(const XcdBarrier& b) {
    asm volatile("s_waitcnt vmcnt(0)" ::: "memory");
    __syncthreads();
    if (threadIdx.x == 0) {
        unsigned* bar = b.bar;
        __builtin_amdgcn_s_waitcnt(0);
        unsigned nloc = b.st[0], nx = b.st[1];
        if (nloc == 0u) { xcd_barrier_complete(bar, b.x, nloc, nx); b.st[0] = nloc; b.st[1] = nx; }
        const unsigned old = xb_add(&bar[XB_XSUB(b.x)], 1u);
        const unsigned gen = old / nloc;
        if (old + 1u == (gen + 1u) * nloc) {
            __builtin_amdgcn_fence(__ATOMIC_RELEASE, "agent");
            asm volatile("s_waitcnt vmcnt(0)" ::: "memory");
            const unsigned og = xb_add(&bar[XB_TOP], 1u);
            const unsigned tg = og / nx;
            if (og + 1u == (tg + 1u) * nx) xb_add(&bar[XB_TOPGEN], 1u);
            else XB_SPIN(xb_ld(&bar[XB_TOPGEN]) == tg, bar);
            __builtin_amdgcn_fence(__ATOMIC_ACQUIRE, "agent");
            xb_add(&bar[XB_XGEN(b.x)], 1u);
            asm volatile("s_waitcnt vmcnt(0)" ::: "memory");
        } else {
            XB_SPIN(xb_ld(&bar[XB_XGEN(b.x)]) == gen, bar);
            __builtin_amdgcn_fence(__ATOMIC_ACQUIRE, "agent");
            asm volatile("s_waitcnt vmcnt(0)" ::: "memory");
        }
    }
    __syncthreads();
}
struct Frame {
    LAS unsigned char* lds; volatile LAS unsigned* MISC; gu32* ctl;
    int tid, lane, wave, vcu, G;
    GAS float* out; GAS unsigned char* ws;
};
typedef __attribute__((address_space(4))) const char* kaddr_t;
__device__ __forceinline__ const float* in_ptr(int i) { kaddr_t ka = (kaddr_t)__builtin_amdgcn_kernarg_segment_ptr(); asm volatile("" : "+s"(ka)); typedef GAS const float* cfp_t; typedef __attribute__((address_space(4))) const cfp_t* kpp_t; return (const float*)(*(kpp_t)(ka + 8 * i)); }
__device__ __forceinline__ GAS unsigned char* karg_ptr(int i) { kaddr_t ka = (kaddr_t)__builtin_amdgcn_kernarg_segment_ptr(); asm volatile("" : "+s"(ka)); typedef GAS unsigned char* gp_t; typedef __attribute__((address_space(4))) const gp_t* kpp_t; return *(kpp_t)(ka + 8 * i); }
enum { I_X = 0, I_C = 1, I_POS = 2, I_ADAW = 3, I_ADAB = 4, I_NORMG = 5, I_W13 = 6, I_W2 = 7, I_WIN = 8, I_LCW = 9, I_LCB = 10, I_LWA = 11, I_LBA = 12, I_LWX = 13, I_LBX = 14, I_LAM = 15,
       I_LOUT = 16, I_SCW = 17, I_SCOUT = 18, I_KVG = 19, I_UKV = 20, I_MLAO = 21, I_WO = 22, I_FING = 23 };
__device__ __forceinline__ float wave_sum(float v) {
#pragma unroll
    for (int o = 1; o < 64; o <<= 1) v += __shfl_xor(v, o);
    return v;
}
template <bool CB, bool F8 = false>
__device__ __forceinline__ void transpose_item(const float* W, int K, int N, bf16* WT, int dst_row0, int k0, int n0, const float* ks, LAS float* scr, int lane, const float* shp, float (&cbacc)[8], bool tiled = false, int ldk = 0) {
    float v[32];
    const GAS float* wp = (const GAS float*)W + (size_t)(k0 + (lane >> 5)) * N + n0 + (lane & 31);
#pragma unroll
    for (int i = 0; i < 32; ++i) { v[i] = *wp; wp += 2 * (size_t)N; asm volatile("" : "+v"(wp)); }
    if (CB) {
        LAS float* sht = scr + 64 * 33;
        float sv[8];
#pragma unroll
        for (int b = 0; b < 8; ++b) sv[b] = ((const GAS float*)shp)[(size_t)b * MODW + k0 + lane];
#pragma unroll
        for (int b = 0; b < 8; ++b) sht[(b * 2 + (lane & 1)) * 32 + (lane >> 1)] = sv[b];
        LDS_WAIT(); asm volatile("" ::: "memory");
#pragma unroll
        for (int b = 0; b < 8; ++b) { float a = 0.f;
#pragma unroll
            for (int i = 0; i < 32; ++i) a += sht[(b * 2 + (lane >> 5)) * 32 + i] * v[i];
            cbacc[b] += a; asm volatile("" ::: "memory"); }
    }
    if (ks) {
#pragma unroll
        for (int i = 0; i < 32; ++i) v[i] *= ks[k0 + 2 * i + (lane >> 5)]; }
#pragma unroll
    for (int i = 0; i < 32; ++i) scr[(2 * i + (lane >> 5)) * 33 + (lane & 31)] = v[i];
    LDS_WAIT(); asm volatile("" ::: "memory");
    const int c = lane & 7;
#pragma unroll
    for (int j = 0; j < 4; ++j) { const int n = (lane >> 3) + 8 * j; const LAS float* s = scr + (8 * c) * 33 + n;
        v4u o; o.x = pk2(s[0 * 33], s[1 * 33]); o.y = pk2(s[2 * 33], s[3 * 33]); o.z = pk2(s[4 * 33], s[5 * 33]); o.w = pk2(s[6 * 33], s[7 * 33]);
        const int rr = dst_row0 + n;
        if constexpr (F8) { unsigned w0 = 0, w1 = 0;
            w0 = __builtin_amdgcn_cvt_pk_fp8_f32(pg8::sat8(s[0 * 33] * 64.f), pg8::sat8(s[1 * 33] * 64.f), w0, false); w0 = __builtin_amdgcn_cvt_pk_fp8_f32(pg8::sat8(s[2 * 33] * 64.f), pg8::sat8(s[3 * 33] * 64.f), w0, true);
            w1 = __builtin_amdgcn_cvt_pk_fp8_f32(pg8::sat8(s[4 * 33] * 64.f), pg8::sat8(s[5 * 33] * 64.f), w1, false); w1 = __builtin_amdgcn_cvt_pk_fp8_f32(pg8::sat8(s[6 * 33] * 64.f), pg8::sat8(s[7 * 33] * 64.f), w1, true);
            *(GAS v2u*)((GAS unsigned char*)WT + (size_t)rr * (ldk ? ldk : K) + k0 + 8 * c) = (v2u){w0, w1}; } else {
        const size_t eo = tiled ? ((size_t)(rr >> 8) * (K >> 6) + (k0 >> 6)) * 16384 + (size_t)(rr & 255) * 64 + 8 * c : (size_t)rr * (ldk ? ldk : K) + k0 + 8 * c;
        *(GAS v4u*)(WT + eo) = o; } }
    LDS_WAIT(); asm volatile("" ::: "memory");
}
typedef float p0_f32x16 __attribute__((ext_vector_type(16)));
template <bool F8>
__device__ __forceinline__ void transpose_item_cb(const float* W, int K, int N, bf16* WT, int dst_row0, int k0, int n0, LAS unsigned* scr, int lane, const float* shp, p0_f32x16& acc) {
    const int h = lane >> 5, n = lane & 31;
    float v[32];
    const GAS float* wp = (const GAS float*)W + (size_t)(k0 + 32 * h) * N + n0 + n;
#pragma unroll
    for (int i = 0; i < 32; ++i) { v[i] = *wp; wp += (size_t)N; asm volatile("" : "+v"(wp)); }
    const GAS float* sp = (const GAS float*)shp + (size_t)(n & 7) * MODW + k0 + 32 * h;
    f32x4 sa[8];
#pragma unroll
    for (int j = 0; j < 8; ++j) sa[j] = *(const GAS f32x4*)(sp + 4 * j);
    const float msk = n < 8 ? 1.0f : 0.0f;
    unsigned w[16];
#pragma unroll
    for (int t = 0; t < 16; ++t) w[t] = pg8::cvt_pk_bf16(v[2 * t], v[2 * t + 1]);
#pragma unroll
    for (int j = 0; j < 4; ++j) { const f32x4 s0 = sa[2 * j] * msk, s1 = sa[2 * j + 1] * msk;
        v4u a; a.x = pg8::cvt_pk_bf16(s0[0], s0[1]); a.y = pg8::cvt_pk_bf16(s0[2], s0[3]); a.z = pg8::cvt_pk_bf16(s1[0], s1[1]); a.w = pg8::cvt_pk_bf16(s1[2], s1[3]);
        v4u b; b.x = w[4 * j]; b.y = w[4 * j + 1]; b.z = w[4 * j + 2]; b.w = w[4 * j + 3];
        acc = __builtin_amdgcn_mfma_f32_32x32x16_bf16(__builtin_bit_cast(bf16x8, a), __builtin_bit_cast(bf16x8, b), acc, 0, 0, 0); }
    if constexpr (F8) {
#pragma unroll
        for (int t = 0; t < 8; ++t) { unsigned x = 0; x = __builtin_amdgcn_cvt_pk_fp8_f32(pg8::sat8(v[4 * t] * 64.f), pg8::sat8(v[4 * t + 1] * 64.f), x, false); x = __builtin_amdgcn_cvt_pk_fp8_f32(pg8::sat8(v[4 * t + 2] * 64.f), pg8::sat8(v[4 * t + 3] * 64.f), x, true);
            scr[(8 * h + t) * 33 + n] = x; }
        LDS_WAIT(); asm volatile("" ::: "memory");
        const int c = lane & 3;
#pragma unroll
        for (int jj = 0; jj < 2; ++jj) { const int nn = (lane >> 2) + 16 * jj; const LAS unsigned* s = scr + (4 * c) * 33 + nn;
            v4u o; o.x = s[0]; o.y = s[33]; o.z = s[66]; o.w = s[99];
            *(GAS v4u*)((GAS unsigned char*)WT + (size_t)(dst_row0 + nn) * K + k0 + 16 * c) = o; }
    } else {
#pragma unroll
        for (int t = 0; t < 16; ++t) scr[(16 * h + t) * 33 + n] = w[t];
        LDS_WAIT(); asm volatile("" ::: "memory");
        const int c = lane & 7;
#pragma unroll
        for (int jj = 0; jj < 4; ++jj) { const int nn = (lane >> 3) + 8 * jj; const LAS unsigned* s = scr + (4 * c) * 33 + nn;
            v4u o; o.x = s[0]; o.y = s[33]; o.z = s[66]; o.w = s[99];
            *(GAS v4u*)(WT + (size_t)(dst_row0 + nn) * K + k0 + 8 * c) = o; }
    }
    LDS_WAIT(); asm volatile("" ::: "memory");
}
#ifndef W2_TILED
#define W2_TILED false
#endif
constexpr int TI_W13 = (D / 64) * (2 * DFF / 32), TI_W2 = (DFF / 64) * (D / 32), TI_WIN = (D / 64) * (INW / 32), TI_LRUO = (LW / 64) * (D / 32), TI_UKV = (KVR / 64) * (4096 / 32), TI_DD = (D / 64) * (D / 32), TI_WAX = 8 * 2 * 4;
constexpr int TH_W13 = TI_W13 / 4, TH_WIN = TI_WIN / 4, TH_LAYER = 2 * TH_W13 + TH_WIN;
constexpr int TL_LAYER = 2 * TI_W2 + 2 * TI_LRUO + TI_UKV + 2 * TI_DD + 2 * TI_WAX, TU_LAYER = TH_LAYER + TL_LAYER;
__device__ __forceinline__ void p0_weights(const Frame& F, int parts, bool dummy_cb = false) {
    LAS float* scr = (LAS float*)(F.lds + RING_OFF + F.wave * 16384);
    const int gw = F.vcu * NWAVES + F.wave, NGW = F.G * NWAVES;
    if (parts & 1)
    for (int it = gw; it < NL * TH_LAYER; it += NGW) {
        const int l = it / TH_LAYER; int r = it - l * TH_LAYER;
        GAS unsigned char* wl = F.ws + WS_W + (size_t)l * W_LAYER;
        const float* W; bf16* WT; int N, mode, site;
        if (r < 2 * TH_W13) { const int f = r / TH_W13; r -= f * TH_W13; W = in_ptr(I_W13) + (size_t)(l * 2 + f) * D * 2 * DFF; N = 2 * DFF; WT = (bf16*)(wl + WO_W13 + (size_t)f * 44 * MiB); mode = 1; site = f ? 2 : 0; }
        else { r -= 2 * TH_W13; W = in_ptr(I_WIN) + (size_t)l * D * INW; N = INW; WT = (bf16*)(wl + WO_WIN); mode = 2; site = 1; }
        bool f8 = (mode == 1) && (site == 2) && ((FP8_G4 >> l) & 1); int cbi;
        const int nblk = N / 32, kq = r / nblk, nb = r - kq * nblk, n0 = 32 * nb; int dst = n0;
        if (mode == 1) { const int bj = n0 >= DFF ? 1 : 0, j = n0 - bj * DFF; dst = 256 * (j >> 7) + 128 * bj + (j & 127); }
        else {
            if (FP8_ALL) { dst = n0 < 8704 ? n0 : (n0 < 8768 ? 14848 + (n0 - 8704) : 8704 + (n0 - 8768)); f8 = true; }
            else if (WIN_QF8) { if (n0 < 5120) dst = n0; else if (n0 < 8192) { dst = n0 - 5120; f8 = true; } else if (n0 < 8704) dst = 5120 + (n0 - 8192); else if (n0 < 8768) dst = 5632 + (n0 - 8704); else if (G1_BF16 && n0 >= 8768 + 2048 && n0 < 8768 + 4096) dst = WINB_PADEND + (n0 - 8768 - 2048); else if (G1_BF16 && n0 >= 8768 + 4096) { dst = 5120 + (n0 - 8768 - 4096); f8 = true; } else { dst = 3072 + (n0 - 8768); f8 = true; } }
            else { if (n0 < 8768) dst = n0; else { dst = n0 - 8768; f8 = true; } }
            if (f8) WT = (bf16*)(wl + WO_WIN8); }
        cbi = (mode == 2 && f8) ? WINB_ROWS + dst : dst;
        const float* shp = (const float*)(F.ws + WS_MOD) + (size_t)l * NB * MODW + (site == 0 ? 0 : site == 1 ? 6144 : 12288);
        p0_f32x16 cbacc;
#pragma unroll
        for (int r4 = 0; r4 < 16; ++r4) cbacc[r4] = 0.f;
        if (f8) {
#pragma unroll 1
            for (int j = 0; j < 4; ++j) transpose_item_cb<true>(W, D, N, WT, dst, 64 * (4 * kq + j), n0, (LAS unsigned*)scr, F.lane, shp, cbacc);
        } else {
#pragma unroll 1
            for (int j = 0; j < 4; ++j) transpose_item_cb<false>(W, D, N, WT, dst, 64 * (4 * kq + j), n0, (LAS unsigned*)scr, F.lane, shp, cbacc); }
        int* cbp = (int*)(F.ws + (dummy_cb ? WS_KN : WS_CB)) + (size_t)((l * 3 + site) * NB + 4 * (F.lane >> 5)) * CBW + cbi + (F.lane & 31);
#pragma unroll
        for (int r4 = 0; r4 < 4; ++r4) atomicAdd(cbp + (size_t)r4 * CBW, (int)__builtin_rintf(cbacc[r4] * pg8::CB_ENC));
    }
    if (parts & 2)
    for (int it = gw; it < NL * TL_LAYER; it += NGW) {
        const int l = it / TL_LAYER; int r = it - l * TL_LAYER;
        GAS unsigned char* wl = F.ws + WS_W + (size_t)l * W_LAYER;
        const float* W; bf16* WT; const float* ks = nullptr; int K, N, ldk = 0; float dummy[8]; bool tiled = false;
        bool f8w = false;
        if (r < 2 * TI_W2) { tiled = W2_TILED; const int f = r / TI_W2; r -= f * TI_W2; W = in_ptr(I_W2) + (size_t)(l * 2 + f) * DFF * D; K = DFF; N = D; WT = (bf16*)(wl + WO_W2 + (size_t)f * 22 * MiB); f8w = ((FP8_DN >> (2 * l + f)) & 1) != 0; }
        else if ((r -= 2 * TI_W2) < TI_LRUO) { W = in_ptr(I_LOUT) + (size_t)l * LW * D; K = LW; N = D; WT = (bf16*)(wl + WO_LRUO); ldk = YP; }
        else if ((r -= TI_LRUO) < TI_LRUO) { W = in_ptr(I_SCOUT) + (size_t)l * LW * D; K = LW; N = D; WT = (bf16*)(wl + WO_SCO); ldk = YP; }
        else if ((r -= TI_LRUO) < TI_UKV) { W = in_ptr(I_UKV) + (size_t)l * KVR * 4096; K = KVR; N = 4096; WT = (bf16*)(wl + WO_UKV); ks = in_ptr(I_KVG) + l * KVR; }
        else if ((r -= TI_UKV) < TI_DD) { W = in_ptr(I_MLAO) + (size_t)l * D * D; K = D; N = D; WT = (bf16*)(wl + WO_MLAO); ldk = YP; }
        else if ((r -= TI_DD) < TI_DD) { W = in_ptr(I_WO) + (size_t)l * D * D; K = D; N = D; WT = (bf16*)(wl + WO_WO); }
        else { r -= TI_DD; const int which = r / TI_WAX; r -= which * TI_WAX; const int g = r >> 3; r &= 7;
               W = in_ptr(which ? I_LWX : I_LWA) + ((size_t)l * 8 + g) * 16384; K = 128; N = 128; WT = (bf16*)(F.ws + WS_WAX) + ((size_t)(l * 2 + which) * 8 + g) * 16384; }
        const int nblk = N / 32, kb = r / nblk, nb = r - kb * nblk, n0 = 32 * nb;
        if (FP8_DN != 0 && f8w) transpose_item<false, true>(W, K, N, WT, n0, 64 * kb, n0, nullptr, scr, F.lane, nullptr, dummy);
        else transpose_item<false>(W, K, N, WT, n0, 64 * kb, n0, ks, scr, F.lane, nullptr, dummy, tiled, ldk);
    }
    if (parts & 2) { const int gt = (F.vcu * NWAVES + F.wave) * 64 + F.lane, NT = F.G * NWAVES * 64; constexpr int per = FP8_ALL ? 192 * D / 16 : (WINB_PADEND - WINB_REAL) * D * 2 / 16; constexpr size_t pbase = FP8_ALL ? WO_WIN8 + (size_t)14912 * D : WO_WIN + (size_t)WINB_REAL * D * 2;
      for (int i = gt; i < NL * per; i += NT) { const int l = i / per, j = i - l * per; *(GAS v4u*)(F.ws + WS_W + (size_t)l * W_LAYER + pbase + (size_t)j * 16) = (v4u){0u, 0u, 0u, 0u}; } }
    if (parts & 2) { const int gt = (F.vcu * NWAVES + F.wave) * 64 + F.lane, NT = F.G * NWAVES * 64; const int* pos = (const int*)in_ptr(I_POS); float* COS = (float*)(F.ws + WS_COS); float* SIN = (float*)(F.ws + WS_SIN);
      for (int i = gt; i < M * 32; i += NT) { const int row = i >> 5, j = i & 31; const float inv = __builtin_amdgcn_exp2f(-(float)j * (13.287712379549449f / 32.0f)); const float ang = (float)pos[row] * inv;
          const double t = (double)ang * 0.15915494309189535; const float fr = (float)(t - __builtin_rint(t)); COS[i] = __builtin_amdgcn_cosf(fr); SIN[i] = __builtin_amdgcn_sinf(fr); } }
}
__device__ __forceinline__ void p0_mod(const Frame& F) {
    LAS float* sc = (LAS float*)(F.lds + RING_OFF); LAS float* red = (LAS float*)(F.lds + RING_OFF + 65536);
    for (int i = F.tid; i < NB * D; i += NWAVES * 64) { const float c = in_ptr(I_C)[i]; sc[i] = c / (1.0f + __expf(-c)); }
    __syncthreads();
    float* MOD = (float*)(F.ws + WS_MOD);
    for (int task = blockIdx.x; task < NL * (MODW / 64); task += F.G) {
        const int l = task / (MODW / 64), cg = task - l * (MODW / 64);
        const float* Wp = in_ptr(I_ADAW) + ((size_t)l * D + 256 * F.wave) * MODW + 64 * cg + F.lane;
        float acc[8];
#pragma unroll
        for (int b = 0; b < 8; ++b) acc[b] = 0.f;
#pragma unroll 4
        for (int k4 = 0; k4 < 256; k4 += 4) {
            const float w0 = Wp[(size_t)(k4 + 0) * MODW], w1 = Wp[(size_t)(k4 + 1) * MODW], w2 = Wp[(size_t)(k4 + 2) * MODW], w3 = Wp[(size_t)(k4 + 3) * MODW];
#pragma unroll
            for (int b = 0; b < 8; ++b) { const f32x4 s4 = *(const LAS f32x4*)(sc + b * D + 256 * F.wave + k4); acc[b] += (s4[0] * w0 + s4[1] * w1) + (s4[2] * w2 + s4[3] * w3); }
        }
#pragma unroll
        for (int b = 0; b < 8; ++b) red[(F.wave * 8 + b) * 64 + F.lane] = acc[b];
        __syncthreads();
        { const int b = F.wave; float s = 0.f;
#pragma unroll
          for (int w = 0; w < 8; ++w) s += red[(w * 8 + b) * 64 + F.lane];
          MOD[((size_t)l * NB + b) * MODW + 64 * cg + F.lane] = s + in_ptr(I_ADAB)[(size_t)l * MODW + 64 * cg + F.lane]; }
        __syncthreads();
    }
}
__device__ __forceinline__ unsigned pk2h(float lo, float hi) { return pg8::pk2_f16(lo, hi); }
__device__ __forceinline__ void operand0_phase(const Frame& F, const float* xin, const float* g, const float* scale, bf16* out, pg8::ssq_t* ssq, bf16* xh) {
    const int gw = F.vcu * NWAVES + F.wave, NGW = F.G * NWAVES, rpw = (M + NGW - 1) / NGW;
    const int r0 = gw * rpw, r1 = (r0 + rpw < M) ? r0 + rpw : M;
    int curb = -1; f32x4 gp[8];
    for (int row = r0; row < r1; ++row) {
        const int b = row >> 11;
        if (b != curb) { curb = b;
#pragma unroll
            for (int j = 0; j < 8; ++j) { const f32x4 g4 = ((const f32x4*)g)[F.lane + 64 * j]; const f32x4 s4 = ((const f32x4*)(scale + (size_t)b * MODW))[F.lane + 64 * j]; gp[j] = g4 * (s4 + 1.0f); } }
        const f32x4* xr = (const f32x4*)(xin + (size_t)row * D) + F.lane;
        f32x4 v[8]; float ss = 0.f;
#pragma unroll
        for (int j = 0; j < 8; ++j) { v[j] = xr[64 * j]; ss += (v[j][0] * v[j][0] + v[j][1] * v[j][1]) + (v[j][2] * v[j][2] + v[j][3] * v[j][3]); }
        ss = wave_sum(ss); if (F.lane == 0) ssq[row] = pg8::ssq_enc(ss);
        unsigned long long* o8 = (unsigned long long*)(out + (size_t)row * D) + F.lane; unsigned long long* h8 = (unsigned long long*)(xh + (size_t)row * D) + F.lane;
#pragma unroll
        for (int j = 0; j < 8; ++j) { const f32x4 o = v[j] * gp[j]; o8[64 * j] = (unsigned long long)pk2(o[0], o[1]) | ((unsigned long long)pk2(o[2], o[3]) << 32);
            h8[64 * j] = (unsigned long long)pk2h(v[j][0], v[j][1]) | ((unsigned long long)pk2h(v[j][2], v[j][3]) << 32); }
    }
}
__device__ __forceinline__ void final_norm_phase(const Frame& F, const bf16* xh, float* out, const float* g) {
    const int gw = F.vcu * NWAVES + F.wave, NGW = F.G * NWAVES;
    f32x4 g4[8];
#pragma unroll
    for (int j = 0; j < 8; ++j) g4[j] = ((const f32x4*)g)[F.lane + 64 * j];
    for (int row = gw; row < M; row += NGW) {
        const unsigned long long* xr = (const unsigned long long*)(xh + (size_t)row * D) + F.lane; f32x4* orow = (f32x4*)(out + (size_t)row * D) + F.lane;
        f32x4 v[8]; float ss = 0.f;
#pragma unroll
        for (int j = 0; j < 8; ++j) { const unsigned long long hv = xr[64 * j]; const unsigned w0 = (unsigned)hv, w1 = (unsigned)(hv >> 32); v[j] = (f32x4){pg8::h_lo(w0), pg8::h_hi(w0), pg8::h_lo(w1), pg8::h_hi(w1)};
            ss += (v[j][0] * v[j][0] + v[j][1] * v[j][1]) + (v[j][2] * v[j][2] + v[j][3] * v[j][3]); }
        const float rinv = 1.0f / sqrtf(wave_sum(ss) * (1.0f / D) + EPS);
#pragma unroll
        for (int j = 0; j < 8; ++j) orow[64 * j] = v[j] * rinv * g4[j];
    }
}
__device__ __forceinline__ float softplus_f(float z) {
    const float zn = z > 0.f ? -z : z; const float x = __expf(zn); const float u = 1.0f + x; const float l1p = (u == 1.0f) ? x : __logf(u) * (x / (u - 1.0f));
    return (z > 0.f ? z : 0.f) + l1p; }
__device__ __forceinline__ void lru_unit(const Frame& F, int l, int gck, int g) {
    LAS unsigned char* xr = F.lds + RING_OFF;
    const bf16* X = (const bf16*)(F.ws + WS_LRUX);
    const size_t row0 = (size_t)gck * 128; const int ck = gck & 15;
    {
        const int c8 = F.tid & 15, tq = F.tid >> 4, ch0 = 128 * g + 8 * c8;
        float w[4][8], bias[8];
#pragma unroll
        for (int k = 0; k < 4; ++k) { const f32x4 a = *(const f32x4*)(in_ptr(I_LCW) + ((size_t)l * 4 + k) * LW + ch0), b = *(const f32x4*)(in_ptr(I_LCW) + ((size_t)l * 4 + k) * LW + ch0 + 4);
            w[k][0] = a[0]; w[k][1] = a[1]; w[k][2] = a[2]; w[k][3] = a[3]; w[k][4] = b[0]; w[k][5] = b[1]; w[k][6] = b[2]; w[k][7] = b[3]; }
        { const f32x4 a = *(const f32x4*)(in_ptr(I_LCB) + (size_t)l * LW + ch0), b = *(const f32x4*)(in_ptr(I_LCB) + (size_t)l * LW + ch0 + 4);
          bias[0] = a[0]; bias[1] = a[1]; bias[2] = a[2]; bias[3] = a[3]; bias[4] = b[0]; bias[5] = b[1]; bias[6] = b[2]; bias[7] = b[3]; }
        float xin[7][8];
#pragma unroll
        for (int i = 0; i < 7; ++i) { const int trow = 4 * tq + i - 3;
            if (128 * ck + trow >= 0) { const v4u raw = *(const GAS v4u*)(X + (size_t)((long)row0 + trow) * LW + ch0); unpack8(raw, xin[i]); }
            else {
#pragma unroll
                for (int e = 0; e < 8; ++e) xin[i][e] = 0.f; } }
#pragma unroll
        for (int j = 0; j < 4; ++j) { float o[8];
#pragma unroll
            for (int e = 0; e < 8; ++e) o[e] = bias[e] + (w[0][e] * xin[j][e] + w[1][e] * xin[j + 1][e]) + (w[2][e] * xin[j + 2][e] + w[3][e] * xin[j + 3][e]);
            *(LAS v4u*)(xr + (4 * tq + j) * 272 + 16 * c8) = pack8(o); }
    }
    __syncthreads();
    const int fr = F.lane & 15, fq = F.lane >> 4, ch = 16 * F.wave + fr, cg = 128 * g + ch;
    bf16x8 bwa[4], bwx[4];
    { const bf16* WA = (const bf16*)(F.ws + WS_WAX) + ((size_t)(l * 2 + 0) * 8 + g) * 16384 + (size_t)ch * 128 + 8 * fq;
      const bf16* WX = (const bf16*)(F.ws + WS_WAX) + ((size_t)(l * 2 + 1) * 8 + g) * 16384 + (size_t)ch * 128 + 8 * fq;
#pragma unroll
      for (int ks = 0; ks < 4; ++ks) { bwa[ks] = *(const bf16x8*)(WA + 32 * ks); bwx[ks] = *(const bf16x8*)(WX + 32 * ks); } }
    f32x4 accr[8], acci[8];
#pragma unroll
    for (int mt = 0; mt < 8; ++mt) { accr[mt] = (f32x4){0.f, 0.f, 0.f, 0.f}; acci[mt] = (f32x4){0.f, 0.f, 0.f, 0.f};
#pragma unroll
        for (int ks = 0; ks < 4; ++ks) { const bf16x8 a = *(const LAS bf16x8*)(xr + (16 * mt + fr) * 272 + (32 * ks + 8 * fq) * 2);
            accr[mt] = __builtin_amdgcn_mfma_f32_16x16x32_bf16(a, bwa[ks], accr[mt], 0, 0, 0);
            acci[mt] = __builtin_amdgcn_mfma_f32_16x16x32_bf16(a, bwx[ks], acci[mt], 0, 0, 0); } }
    const float ba = in_ptr(I_LBA)[(size_t)l * LW + cg], bx = in_ptr(I_LBX)[(size_t)l * LW + cg];
    const float Lc2 = -8.0f * 1.4426950408889634f * softplus_f(-in_ptr(I_LAM)[(size_t)l * LW + cg]);
    bf16* R = (bf16*)(F.ws + WS_R); bf16* GX = (bf16*)(F.ws + WS_GX);
    float At = 1.f, Bt = 0.f;
#pragma unroll
    for (int mt = 0; mt < 8; ++mt) { float A4 = 1.f, B4 = 0.f;
#pragma unroll
        for (int e = 0; e < 4; ++e) { const int tl = 16 * mt + 4 * fq + e;
            const float r = pg8::fast_sigmoid(accr[mt][e] + ba), ii = pg8::fast_sigmoid(acci[mt][e] + bx);
            const float xv = bf2f(*(const LAS unsigned short*)(xr + tl * 272 + ch * 2));
            const unsigned short rb = (unsigned short)f2bf(r), gb = (unsigned short)f2bf(ii * xv);
            R[(row0 + tl) * LW + cg] = rb; GX[(row0 + tl) * LW + cg] = gb;
            const float a = __builtin_amdgcn_exp2f(Lc2 * bf2f(rb)); const float bb = sqrtf(fmaxf(1.0f - a * a, 0.f)) * bf2f(gb);
            A4 = a * A4; B4 = a * B4 + bb; }
#pragma unroll
        for (int q = 0; q < 4; ++q) { const float Aq = __shfl(A4, fr + 16 * q), Bq = __shfl(B4, fr + 16 * q); Bt = Aq * Bt + Bq; At = Aq * At; } }
    if (fq == 0) { float* AGG = (float*)(F.ws + WS_AGG) + ((size_t)gck * LW + cg) * 2; AGG[0] = At; AGG[1] = Bt; }
    __syncthreads();
}
__device__ __forceinline__ void lru_scan_unit(const Frame& F, int l, int gck, int hf) {
    const int c = 512 * hf + F.tid, b = gck >> 4, ck = gck & 15;
    const float* AGG = (const float*)(F.ws + WS_AGG);
    float h = 0.f;
    for (int j = 0; j < ck; ++j) { const float2 ab = *(const float2*)(AGG + ((size_t)(b * 16 + j) * LW + c) * 2); h = ab.x * h + ab.y; }
    const float Lc2 = -8.0f * 1.4426950408889634f * softplus_f(-in_ptr(I_LAM)[(size_t)l * LW + c]);
    const bf16* R = (const bf16*)(F.ws + WS_R) + (size_t)gck * 128 * LW + c; const bf16* GX = (const bf16*)(F.ws + WS_GX) + (size_t)gck * 128 * LW + c;
    const bf16* GT = (const bf16*)(F.ws + WS_LRUG) + (size_t)gck * 128 * LW + c; bf16* Y = (bf16*)(F.ws + WS_YLRU) + (size_t)gck * 128 * YP + c;
    for (int t0 = 0; t0 < 128; t0 += 8) { unsigned short rr[8], gg[8], tt[8];
#pragma unroll
        for (int i = 0; i < 8; ++i) { rr[i] = R[(size_t)(t0 + i) * LW]; gg[i] = GX[(size_t)(t0 + i) * LW]; tt[i] = GT[(size_t)(t0 + i) * LW]; }
#pragma unroll
        for (int i = 0; i < 8; ++i) { const float a = __builtin_amdgcn_exp2f(Lc2 * bf2f(rr[i])); const float bb = sqrtf(fmaxf(1.0f - a * a, 0.f)) * bf2f(gg[i]); h = a * h + bb;
            Y[(size_t)(t0 + i) * YP] = (unsigned short)f2bf(h * bf2f(tt[i])); } }
}
__device__ __forceinline__ void sc_phase(const Frame& F, int l) {
    const int gt = (F.vcu * NWAVES + F.wave) * 64 + F.lane, NT = F.G * NWAVES * 64;
    const bf16* SB = (const bf16*)(F.ws + WS_SCB); const bf16* SC = (const bf16*)(F.ws + WS_SCC); const bf16* SX = (const bf16*)(F.ws + WS_SCX); bf16* Y = (bf16*)(F.ws + WS_YSC);
    for (int idx = gt; idx < (M / 8) * (LW / 8); idx += NT) {
        const int c8 = idx & 127, tg = idx >> 7, row0 = 8 * tg, s0 = row0 & (SEQ - 1), ch0 = 8 * c8;
        float w[3][8];
#pragma unroll
        for (int k = 0; k < 3; ++k) { const f32x4 a = *(const f32x4*)(in_ptr(I_SCW) + ((size_t)l * 3 + k) * LW + ch0), b = *(const f32x4*)(in_ptr(I_SCW) + ((size_t)l * 3 + k) * LW + ch0 + 4);
            w[k][0] = a[0]; w[k][1] = a[1]; w[k][2] = a[2]; w[k][3] = a[3]; w[k][4] = b[0]; w[k][5] = b[1]; w[k][6] = b[2]; w[k][7] = b[3]; }
        float cx[10][8];
#pragma unroll
        for (int i = 0; i < 10; ++i) {
            if (s0 + i - 2 >= 0) { float a[8], b[8]; unpack8(*(const GAS v4u*)(SC + (size_t)(row0 + i - 2) * LW + ch0), a); unpack8(*(const GAS v4u*)(SX + (size_t)(row0 + i - 2) * LW + ch0), b);
#pragma unroll
                for (int e = 0; e < 8; ++e) cx[i][e] = a[e] * b[e]; }
            else {
#pragma unroll
                for (int e = 0; e < 8; ++e) cx[i][e] = 0.f; } }
#pragma unroll
        for (int j = 0; j < 8; ++j) { float bb[8], o[8]; unpack8(*(const GAS v4u*)(SB + (size_t)(row0 + j) * LW + ch0), bb);
#pragma unroll
            for (int e = 0; e < 8; ++e) o[e] = bb[e] * ((w[0][e] * cx[j][e] + w[1][e] * cx[j + 1][e]) + w[2][e] * cx[j + 2][e]);
            *(GAS v4u*)(Y + (size_t)(row0 + j) * YP + ch0) = pack8(o); }
    }
}
__device__ __forceinline__ void rope8(bf16* p, const float* cs, const float* sn) {
    float x1[8], x2[8], o1[8], o2[8]; unpack8(*(const GAS v4u*)p, x1); unpack8(*(const GAS v4u*)(p + 32), x2);
    const f32x4 c0 = *(const f32x4*)cs, c1 = *(const f32x4*)(cs + 4), s0 = *(const f32x4*)sn, s1 = *(const f32x4*)(sn + 4);
#pragma unroll
    for (int e = 0; e < 8; ++e) { const float c = e < 4 ? c0[e & 3] : c1[e & 3], s = e < 4 ? s0[e & 3] : s1[e & 3]; o1[e] = x1[e] * c - x2[e] * s; o2[e] = x2[e] * c + x1[e] * s; }
    *(GAS v4u*)p = pack8(o1); *(GAS v4u*)(p + 32) = pack8(o2);
}
__device__ __forceinline__ void rope_phase(const Frame& F) {
    const int gt = (F.vcu * NWAVES + F.wave) * 64 + F.lane, NT = F.G * NWAVES * 64;
    const float* COS = (const float*)(F.ws + WS_COS); const float* SIN = (const float*)(F.ws + WS_SIN);
    bf16* Q = (bf16*)(F.ws + WS_Q); bf16* KP = (bf16*)(F.ws + WS_KPE);
    for (int idx = gt; idx < M * 16 * 4; idx += NT) { const int row = idx >> 6, hh = (idx >> 2) & 15, j = idx & 3;
        rope8(Q + (size_t)row * 3072 + hh * 192 + 128 + 8 * j, COS + (size_t)row * 32 + 8 * j, SIN + (size_t)row * 32 + 8 * j); }
    for (int idx = gt; idx < M * 4; idx += NT) { const int row = idx >> 2, j = idx & 3;
        rope8(KP + (size_t)row * 64 + 8 * j, COS + (size_t)row * 32 + 8 * j, SIN + (size_t)row * 32 + 8 * j); }
}
struct Args { const float* in[24]; float* out; unsigned char* ws; int ph_lo, ph_hi; };
#ifndef P0P
#define P0P 3
#endif
#ifndef REP_G2
#define REP_G2 1
#endif
#ifndef REP_G5
#define REP_G5 1
#endif
#ifndef REP_PRO
#define REP_PRO 1
#endif
#ifndef REVK_FFN
#define REVK_FFN false
#endif
#ifndef ACT_TILED
#define ACT_TILED false
#endif
#ifndef G3P
#define G3P 3
#endif
#ifndef REP_ATT
#define REP_ATT 1
#endif
#ifndef REP_BAR
#define REP_BAR 1
#endif
#ifndef PH_MASK
#define PH_MASK 0xFFFFu
#endif
#define EN(j) (((PH_MASK) >> (j)) & 1u)
__global__ void __launch_bounds__(NWAVES * 64, 2) hybrid_fwd(Args args) {
    extern __shared__ __attribute__((aligned(16))) unsigned char lds[];
    Frame F;
    F.lds = (LAS unsigned char*)lds;
    F.MISC = (volatile LAS unsigned*)(F.lds + MISC_OFF);
    F.tid = threadIdx.x; F.lane = F.tid & 63; F.wave = __builtin_amdgcn_readfirstlane(F.tid >> 6);
    F.G = gridDim.x; { const int bx = blockIdx.x; F.vcu = (F.G % 8 == 0) ? (bx % 8) * (F.G / 8) + bx / 8 : bx; }
    F.out = nullptr; F.ws = nullptr; F.ctl = (gu32*)(args.ws + WS_CTL);
    for (int u = F.tid; u < (LDS_BYTES - LDSCTL_OFF) / 4; u += NWAVES * 64) ((LAS unsigned*)(F.lds + LDSCTL_OFF))[u] = 0u;
    __syncthreads();
    XcdBarrier bar; bar.bar = (unsigned*)(F.ctl + CW_BAR); bar.x = 0; bar.st = nullptr;
    if (MK_N_LAUNCHES == 1) bar = xcd_barrier_post((unsigned*)(F.ctl + CW_BAR), F.MISC + 8);
    const int lo = args.ph_lo, hi = args.ph_hi;
#define IN(k) (lo <= (k) && (k) < hi)
#define PHASE_FRAME() Frame P = F; { unsigned m1_ = ~0u; asm volatile("" : "+s"(m1_)); int t_ = F.wave * 64 + (int)__builtin_amdgcn_mbcnt_hi(m1_, __builtin_amdgcn_mbcnt_lo(m1_, 0u)); asm volatile("" : "+v"(t_)); P.tid = t_; P.lane = t_ & 63; P.out = (GAS float*)karg_ptr(24); P.ws = karg_ptr(25); }
#define SEAM(k) do { if (IN(k) && IN((k) + 1)) { if (MK_N_LAUNCHES == 1) { for (int rb_ = 0; rb_ < REP_BAR; ++rb_) { XcdBarrier b_ = bar; GAS unsigned* bp_ = (GAS unsigned*)bar.bar; asm volatile("" : "+s"(bp_)); b_.bar = (unsigned*)bp_; xcd_barrier(b_); } }     } } while (0)
#define HN ((bf16*)(P.ws + WS_HN))
#define XH ((bf16*)(P.ws + WS_XH))
#define A8 ((unsigned char*)(P.ws + WS_A8))
#define ACT ((bf16*)(P.ws + WS_ACT))
#define MERGED ((bf16*)(P.ws + WS_MERGED))
#define ring (F.lds + RING_OFF)
#define MODL(l_) ((const float*)(P.ws + WS_MOD) + (size_t)(l_) * NB * MODW)
#define NORMG(l_, s_) (in_ptr(I_NORMG) + ((size_t)(l_) * 3 + (s_)) * D)
#define SSQN(l_, s_) ((pg8::ssq_t*)(P.ws + WS_SSQN) + ((size_t)(l_) * 3 + (s_)) * M)
#define CBV(l_, s_) ((const int*)(P.ws + WS_CB) + ((size_t)(l_) * 3 + (s_)) * NB * CBW)

    if (EN(12) && IN(0)) { PHASE_FRAME(); p0_mod(P); p0_weights(P, 2);
        for (int i = P.vcu * (NWAVES * 64) + P.tid; i < NL * 4 * M; i += P.G * (NWAVES * 64)) ((GAS pg8::ssq_t*)(P.ws + WS_SSQN))[i] = 0ull;
        SEAM(0); }
    if (EN(13) && IN(1)) { PHASE_FRAME(); if (P0P & 1) for (int rep_ = 0; rep_ < REP_PRO; ++rep_) { p0_weights(P, 1, rep_ + 1 < REP_PRO); __syncthreads(); } if (P0P & 2) operand0_phase(P, in_ptr(I_X), NORMG(0, 0), MODL(0) + 2048, HN, SSQN(0, 0), XH); SEAM(1); }

    for (int l = 0; l < NL; ++l) {
        const int pb = 2 + PPL * l;
#define wl (P.ws + WS_W + (size_t)l * W_LAYER)
#define mod MODL(l)
#define xin0 ((l == 0) ? in_ptr(I_X) : (const float*)P.out)
#define ssq ((pg8::ssq_t*)(P.ws + WS_SSQ) + (size_t)l * M)
#define UP_CALL(F8IN, O8, Wp, SITE) do { pg8::Gemm g{(F8IN) ? (const bf16*)A8 : (const bf16*)HN, (const bf16*)(Wp), M, 2 * DFF, (F8IN) ? D / 2 : D}; \
            pg8::EpiSwiglu<ACT_TILED, (O8)> E{ACT, DFF, SSQN(l, SITE), CBV(l, SITE), CBW, EPS, (F8IN) ? 1.0f / 64.0f : 1.0f}; \
            pg8::gemm_phase<pg8::EpiSwiglu<ACT_TILED, (O8)>, pg8::StaticOrder, true, true, false, false, false, (F8IN)>(ring, g, S, E, P.wave); } while (0)
        if (EN(0) && IN(pb + 0)) { PHASE_FRAME(); pg8::StaticOrder S; S.init(M, 2 * DFF, P.G, (int)blockIdx.x);
            constexpr bool o0 = fp8_dn(0, 0), o1 = fp8_dn(1, 0);
            if (o0 == o1) UP_CALL(false, o0, wl + WO_W13, 0); else if (l == 0) UP_CALL(false, o0, wl + WO_W13, 0); else UP_CALL(false, o1, wl + WO_W13, 0);
            SEAM(pb + 0); }
#define DN_SC(F8) ((F8) ? 1.0f / (64.0f * pg8::ACT8_SC) : 1.0f)
#define G2_CALL(F8) do { pg8::Gemm g{ACT, (const bf16*)(wl + WO_W2), M, D, (F8) ? DFF / 2 : DFF}; pg8::EpiResid<true, true> E{XH, mod + 4096, HN, NORMG(l, 1), mod + 8192, SSQN(l, 1), A8, MODW, 0.5f * DN_SC(F8)}; \
            pg8::gemm_phase<pg8::EpiResid<true, true>, pg8::PanelOrder, true, true, false, false, false, (F8)>(ring, g, S, E, P.wave); } while (0)
        if (EN(1) && IN(pb + 1)) { PHASE_FRAME(); pg8::PanelOrder S; S.init(P.G, (int)blockIdx.x);
            constexpr bool d0 = fp8_dn(0, 0), d1 = fp8_dn(1, 0);
            if (d0 == d1) G2_CALL(d0); else if (l == 0) G2_CALL(d0); else G2_CALL(d1);
            SEAM(pb + 1); }
        if (EN(2) && IN(pb + 2)) { PHASE_FRAME();
            if (G3P & 1) {
                pg8::Gemm g{(const bf16*)A8, (const bf16*)(wl + WO_WIN8), M, WINF_ROWS, D / 2}; pg8::StaticOrder S; S.init(M, WINF_ROWS, P.G, (int)blockIdx.x);
                pg8::EpiWin<(FP8_ALL ? 2 : 1), (bool)WIN_QF8> E{(bf16*)(P.ws + WS_LRUX), (bf16*)(P.ws + WS_LRUG), (bf16*)(P.ws + WS_SCB), (bf16*)(P.ws + WS_SCC), (bf16*)(P.ws + WS_SCX), (bf16*)(P.ws + WS_Q), (bf16*)(P.ws + WS_KVLAT), (bf16*)(P.ws + WS_GATES), (bf16*)(P.ws + WS_KPE), ssq, SSQN(l, 1), CBV(l, 1), CBW, EPS};
                pg8::gemm_phase<pg8::EpiWin<(FP8_ALL ? 2 : 1), (bool)WIN_QF8>, pg8::StaticOrder, true, true, false, false, false, true>(ring, g, S, E, P.wave); }
            if ((G3P & 2) && !FP8_ALL) {
                pg8::Gemm g{HN, (const bf16*)(wl + WO_WIN), M, WINB_ROWS, D}; pg8::StaticOrder S; S.init(M, WINB_ROWS, P.G, (int)blockIdx.x);
                pg8::EpiWin<0, (bool)WIN_QF8> E{(bf16*)(P.ws + WS_LRUX), (bf16*)(P.ws + WS_LRUG), (bf16*)(P.ws + WS_SCB), (bf16*)(P.ws + WS_SCC), (bf16*)(P.ws + WS_SCX), (bf16*)(P.ws + WS_Q), (bf16*)(P.ws + WS_KVLAT), (bf16*)(P.ws + WS_GATES), (bf16*)(P.ws + WS_KPE), ssq, SSQN(l, 1), CBV(l, 1), CBW, EPS};
                pg8::gemm_phase<pg8::EpiWin<0, (bool)WIN_QF8>, pg8::StaticOrder, true, true>(ring, g, S, E, P.wave); }
            SEAM(pb + 2); }
        if (EN(3) && IN(pb + 3)) { PHASE_FRAME();
            for (int u = P.vcu; u < 128 * 8; u += P.G) lru_unit(P, l, u >> 3, u & 7);
            sc_phase(P, l);
            rope_phase(P);
            { pg8::Gemm g{(const bf16*)(P.ws + WS_KVLAT), (const bf16*)(wl + WO_UKV), M, 4096, KVR}; pg8::StaticOrder S; S.init(M, 4096, P.G, (int)blockIdx.x);
              pg8::EpiKV E{(bf16*)(P.ws + WS_KN), (bf16*)(P.ws + WS_V), ssq, EPS}; pg8::gemm_phase<pg8::EpiKV, pg8::StaticOrder, true, true>(ring, g, S, E, P.wave); }
            SEAM(pb + 3);
        }
        if (EN(4) && IN(pb + 4)) { PHASE_FRAME();
            for (int u = P.vcu; u < 128 * 2; u += P.G) lru_scan_unit(P, l, u >> 1, u & 1);
            for (int rep_ = 0; rep_ < REP_ATT; ++rep_)
            for (int item = P.vcu; item < 256; item += P.G) { const int bh = item >> 1, s = item & 1;
#pragma unroll 1
                for (int i = 0; i < 4; ++i) { const int base = 2 * s + (i >> 1), qb = (i & 1) ? 7 - base : base;
                    att::attn_unit(bh >> 4, bh & 15, qb, (const bf16*)(P.ws + WS_Q), (const bf16*)(P.ws + WS_KN), (const bf16*)(P.ws + WS_KPE), (const bf16*)(P.ws + WS_V), (bf16*)(P.ws + WS_ATT), (LAS char*)ring, P.wave); } }
            __syncthreads();
            SEAM(pb + 4);
        }
        if (EN(5) && IN(pb + 5)) { PHASE_FRAME();
            pg8::PanelOrder S; S.init(P.G, (int)blockIdx.x); const bf16* GT = (const bf16*)(P.ws + WS_GATES);
#ifndef MERGE3
#define MERGE3 1
#endif
            if (MERGE3) { pg8::Gemm g{(const bf16*)(P.ws + WS_YCAT), (const bf16*)(wl + WO_WCAT), M, D, YP}; pg8::EpiMerge3 E{MERGED, (const unsigned char*)GT, 6144}; static_assert(GATES_U8 && MERGE3, "the u8 gate store is read by the fused merge GEMM only"); pg8::gemm_phase<pg8::EpiMerge3, pg8::PanelOrder, true, true>(ring, g, S, E, P.wave); }
            else {
            { pg8::Gemm g{(const bf16*)(P.ws + WS_YLRU), (const bf16*)(wl + WO_LRUO), M, D, LW, YP}; pg8::EpiMerge<true> E{MERGED, GT, 6144}; pg8::gemm_phase<pg8::EpiMerge<true>, pg8::PanelOrder, true, true>(ring, g, S, E, P.wave); }
            { pg8::Gemm g{(const bf16*)(P.ws + WS_YSC), (const bf16*)(wl + WO_SCO), M, D, LW, YP}; pg8::EpiMerge<false> E{MERGED, GT + 2048, 6144}; pg8::gemm_phase<pg8::EpiMerge<false>, pg8::PanelOrder, true, true>(ring, g, S, E, P.wave); }
            { pg8::Gemm g{(const bf16*)(P.ws + WS_ATT), (const bf16*)(wl + WO_MLAO), M, D, D, YP}; pg8::EpiMerge<false> E{MERGED, GT + 4096, 6144}; pg8::gemm_phase<pg8::EpiMerge<false>, pg8::PanelOrder, true, true>(ring, g, S, E, P.wave); }
            }
            SEAM(pb + 5);
        }
        if (EN(6) && IN(pb + 6)) { PHASE_FRAME(); pg8::Gemm g{MERGED, (const bf16*)(wl + WO_WO), M, D, D}; pg8::PanelOrder S; S.init(P.G, (int)blockIdx.x);
            pg8::EpiResid<true, (FP8_G4 != 0)> E{XH, mod + 10240, HN, NORMG(l, 2), mod + 14336, SSQN(l, 2), A8, MODW, 1.0f}; pg8::gemm_phase<pg8::EpiResid<true, (FP8_G4 != 0)>, pg8::PanelOrder, true, true>(ring, g, S, E, P.wave); SEAM(pb + 6); }
        if (EN(7) && IN(pb + 7)) { PHASE_FRAME(); pg8::StaticOrder S; S.init(M, 2 * DFF, P.G, (int)blockIdx.x);
            constexpr bool u0 = (FP8_G4 & 1) != 0, u1 = (FP8_G4 & 2) != 0, o0 = fp8_dn(0, 1), o1 = fp8_dn(1, 1);
            if (u0 == u1 && o0 == o1) UP_CALL(u0, o0, wl + WO_W13 + 44 * MiB, 2); else if (l == 0) UP_CALL(u0, o0, wl + WO_W13 + 44 * MiB, 2); else UP_CALL(u1, o1, wl + WO_W13 + 44 * MiB, 2);
            SEAM(pb + 7); }
        if (EN(8) && IN(pb + 8)) { PHASE_FRAME(); pg8::PanelOrder S; S.init(P.G, (int)blockIdx.x); static_assert(NL == 2, "per-layer fp8 flags are written out for two layers");
            if (l + 1 < NL) { constexpr bool f8 = fp8_dn(0, 1); pg8::Gemm g{ACT, (const bf16*)(wl + WO_W2 + 22 * MiB), M, D, f8 ? DFF / 2 : DFF};
                pg8::EpiResid<true> E{XH, mod + 16384, HN, NORMG(l + 1, 0), MODL(l + 1) + 2048, SSQN(l + 1, 0), nullptr, MODW, 0.5f * DN_SC(f8)}; pg8::gemm_phase<pg8::EpiResid<true>, pg8::PanelOrder, true, true, false, false, false, f8>(ring, g, S, E, P.wave); }
            else { constexpr bool f8 = fp8_dn(1, 1); pg8::Gemm g{ACT, (const bf16*)(wl + WO_W2 + 22 * MiB), M, D, f8 ? DFF / 2 : DFF};
                if (REP_G5 > 1) { pg8::EpiNull E0{(float*)(P.ws + WS_AGG)}; pg8::gemm_phase<pg8::EpiNull, pg8::PanelOrder, true, true, false, false, false, f8>(ring, g, S, E0, P.wave); }
                pg8::EpiResid<false> E{XH, mod + 16384, nullptr, nullptr, nullptr, nullptr, nullptr, MODW, 0.5f * DN_SC(f8)}; pg8::gemm_phase<pg8::EpiResid<false>, pg8::PanelOrder, true, true, false, false, false, f8>(ring, g, S, E, P.wave); }
            SEAM(pb + 8); }
    }
    if (EN(14) && IN(N_PHASES - 1)) { PHASE_FRAME(); final_norm_phase(P, XH, (float*)P.out, in_ptr(I_FING)); }
#undef IN
#undef SEAM
#undef HN
#undef XH
#undef A8
#undef ACT
#undef MERGED
#undef ring
#undef wl
#undef mod
#undef xin0
#undef ssq
}

extern "C" void kernel_launch(void* const* d_in, const int* in_sizes, int n_in, void* d_out, int out_size, void* d_ws, size_t ws_size, hipStream_t stream) {
    static int grid = 0;
    if (grid == 0) {
        if (n_in != 24 || in_sizes[0] != M * D || out_size != M * D || ws_size < WS_END) { fprintf(stderr, "kernel_launch: shape/workspace mismatch (n_in %d, in0 %d, out %d, ws %zu < %zu); nothing launched\n", n_in, n_in > 0 ? in_sizes[0] : -1, out_size, ws_size, (size_t)WS_END); grid = -1; return; }
        int dev = 0, cus = 0, per_cu = 0;
        if (hipGetDevice(&dev) != hipSuccess || hipDeviceGetAttribute(&cus, hipDeviceAttributeMultiprocessorCount, dev) != hipSuccess) { fprintf(stderr, "kernel_launch: device query failed\n"); grid = -1; return; }
        if (hipFuncSetAttribute((const void*)hybrid_fwd, hipFuncAttributeMaxDynamicSharedMemorySize, LDS_BYTES) != hipSuccess) { fprintf(stderr, "kernel_launch: hipFuncSetAttribute failed\n"); grid = -1; return; }
        if (hipOccupancyMaxActiveBlocksPerMultiprocessor(&per_cu, (const void*)hybrid_fwd, NWAVES * 64, LDS_BYTES) != hipSuccess || per_cu < 1) fprintf(stderr, "kernel_launch: note: occupancy query reports %d workgroups per CU\n", per_cu);
        (void)hipGetLastError();
        grid = cus;
    }
    if (grid < 0) return;
    if (hipMemsetAsync((char*)d_ws + WS_CTL, 0, CTL_ZERO_BYTES, stream) != hipSuccess) { fprintf(stderr, "kernel_launch: hipMemsetAsync failed\n"); return; }
    Args a{};
    for (int i = 0; i < 24; ++i) a.in[i] = (const float*)d_in[i];
    a.out = (float*)d_out; a.ws = (unsigned char*)d_ws;
#if MK_N_LAUNCHES == 1
    a.ph_lo = 0; a.ph_hi = N_PHASES;
    hipLaunchKernelGGL(hybrid_fwd, dim3(grid), dim3(NWAVES * 64), LDS_BYTES, stream, a);
#else
    for (int p = 0; p < N_PHASES; ++p) { a.ph_lo = p; a.ph_hi = p + 1; hipLaunchKernelGGL(hybrid_fwd, dim3(grid), dim3(NWAVES * 64), LDS_BYTES, stream, a); }
#endif
    const hipError_t le = hipPeekAtLastError();
    if (le != hipSuccess) fprintf(stderr, "kernel_launch: launch failed: %s\n", hipGetErrorName(le));
}
```

```cpp
#include <hip/hip_runtime.h>
#include <cstdio>
#include <cstdint>
#define MK_N_LAUNCHES 1
#ifndef G1_BF16
#define G1_BF16 1
#endif
#ifndef GATES_U8
#define GATES_U8 1
#endif
namespace pg8 {
#define PG8_LAS __attribute__((address_space(3)))
typedef unsigned short bf16_t;
typedef short bf16x8 __attribute__((ext_vector_type(8)));
typedef float f32x4 __attribute__((ext_vector_type(4)));
typedef unsigned u32x4 __attribute__((ext_vector_type(4)));
typedef int v4i_t __attribute__((ext_vector_type(4)));
typedef int v8i_t __attribute__((ext_vector_type(8)));
constexpr int BM = 256, BK = 64, HALF = 128, HTB = HALF * BK * 2  , STAGE_BYTES = 8 * HTB, NXCD = 8, WGM = 8;

__host__ __device__ __forceinline__ int lds_byte(int r, int c) { const int st = (r >> 4) * 2 + (c >> 5), rr = r & 15, cc = c & 31, ob = rr * 64 + cc * 2; return st * 1024 + (ob ^ (((ob >> 9) & 1) << 5)); }
__host__ __device__ __forceinline__ void stage_rc(int b, int& R, int& C) { const int st = b / 1024, sb = b % 1024, swz = sb ^ (((sb >> 9) & 1) << 5); R = (st >> 1) * 16 + swz / 64; C = (st & 1) * 32 + (swz % 64) / 2; }
__host__ __device__ __forceinline__ int perm32(int rho) { const int n = rho >> 4, i = rho & 15; return 8 * (i >> 2) + 4 * n + (i & 3); }

template <class E> struct has_mid { static constexpr bool value = false; };
struct Unit { int pm, pn; };
struct Gemm { const bf16_t* A; const bf16_t* Bt; int M, N, K; int ld = 0; };

struct StaticOrder {
    int nM, nN, nwg, G, c;
    __host__ __device__ void init(int M, int N, int G_, int c_) { nM = M / BM; nN = N / BM; nwg = nM * nN; G = G_; c = c_; }
    __host__ __device__ bool next(int i, Unit& u) const {
        const long L = (long)i * G + c; if (L >= nwg) return false;
        int wgid = (int)L; { const int q = nwg / NXCD, r = nwg % NXCD, xcd = wgid % NXCD, off = wgid / NXCD; wgid = (xcd < r ? xcd * (q + 1) : r * (q + 1) + (xcd - r) * q) + off; }
        const int nig = WGM * nN, gid = wgid / nig, fm = gid * WGM, gsz = (nM - fm) < WGM ? (nM - fm) : WGM;
        u.pm = fm + ((wgid % nig) % gsz); u.pn = (wgid % nig) / gsz; return true;
    }
    __device__ __forceinline__ void a_ready(const Unit&) const {}
    __device__ __forceinline__ void done(const Unit&) const {}
};

__device__ __forceinline__ unsigned cvt_pk_bf16(float lo, float hi) { unsigned r; asm volatile("v_cvt_pk_bf16_f32 %0, %1, %2" : "=v"(r) : "v"(lo), "v"(hi)); return r; }
typedef float f32x2 __attribute__((ext_vector_type(2)));
struct PanelOrder {
    int G, c;
    __host__ __device__ void init(int G_, int c_) { G = G_; c = c_; }
    __host__ __device__ bool next(int i, Unit& u) const { const long L = (long)i * G + c; if (L >= 512) return false; const int x = (int)(L & 7), j = (int)(L >> 3); u.pm = 8 * x + (j >> 3); u.pn = j & 7; return true; }
    __device__ __forceinline__ void a_ready(const Unit&) const {}
    __device__ __forceinline__ void done(const Unit&) const {}
};
typedef unsigned u32x2 __attribute__((ext_vector_type(2)));
__device__ __forceinline__ float fast_sigmoid(float x) { return __builtin_amdgcn_rcpf(1.0f + __builtin_amdgcn_exp2f(-1.4426950408889634f * x)); }
__device__ __forceinline__ float gelu_tanh(float x) { return x * fast_sigmoid(1.5957691216057308f * (x + 0.044715f * x * x * x)); }
__device__ __forceinline__ u32x4 pack8_bf16(const f32x4 a, const f32x4 b) { u32x4 w; w.x = cvt_pk_bf16(a[0], a[1]); w.y = cvt_pk_bf16(a[2], a[3]); w.z = cvt_pk_bf16(b[0], b[1]); w.w = cvt_pk_bf16(b[2], b[3]); return w; }
__device__ __forceinline__ void unpack8_bf16(const u32x4 w, f32x4& a, f32x4& b) {
    a[0] = __uint_as_float(w.x << 16); a[1] = __uint_as_float(w.x & 0xffff0000u); a[2] = __uint_as_float(w.y << 16); a[3] = __uint_as_float(w.y & 0xffff0000u);
    b[0] = __uint_as_float(w.z << 16); b[1] = __uint_as_float(w.z & 0xffff0000u); b[2] = __uint_as_float(w.w << 16); b[3] = __uint_as_float(w.w & 0xffff0000u); }

struct EpiNull {
    static constexpr bool PERM = true, AFTER_DRAIN = false; float* sink;
    __device__ __forceinline__ void operator()(f32x4 (&acc)[2][2][4][2], const Unit& u, int wr, int wc, int fr, int fq) const {
        float t = 0.f;
#pragma unroll
        for (int ai = 0; ai < 2; ++ai)
#pragma unroll
            for (int bj = 0; bj < 2; ++bj)
#pragma unroll
                for (int m = 0; m < 4; ++m)
#pragma unroll
                    for (int n = 0; n < 2; ++n) t += acc[ai][bj][m][n][0] + acc[ai][bj][m][n][3];
        if (t == 123456.75f) sink[0] = t; }
};
typedef unsigned long long ssq_t;
typedef int i32x4 __attribute__((ext_vector_type(4)));
__device__ __forceinline__ ssq_t ssq_enc(float t) { return (ssq_t)(t * 16777216.0f); }
__device__ __forceinline__ float ssq_dec(ssq_t v) { return (float)(unsigned)(v >> 32) * 256.0f + (float)(unsigned)v * (1.0f / 16777216.0f); }
__device__ __forceinline__ void ssq_add(ssq_t* p, float t) { atomicAdd(p, ssq_enc(t)); }
constexpr float CB_ENC = 1048576.0f, CB_DEC = 1.0f / 1048576.0f;
__device__ __forceinline__ f32x4 cb_ld4(const int* p) { return __builtin_convertvector(*(const i32x4*)p, f32x4) * CB_DEC; }
__device__ __forceinline__ float sat8(float x) { return __builtin_amdgcn_fmed3f(x, -448.0f, 448.0f); }
__device__ __forceinline__ u32x2 pack8_fp8(const f32x4 a, const f32x4 b) {
    unsigned w0 = 0, w1 = 0; w0 = __builtin_amdgcn_cvt_pk_fp8_f32(sat8(a[0]), sat8(a[1]), w0, false); w0 = __builtin_amdgcn_cvt_pk_fp8_f32(sat8(a[2]), sat8(a[3]), w0, true);
    w1 = __builtin_amdgcn_cvt_pk_fp8_f32(sat8(b[0]), sat8(b[1]), w1, false); w1 = __builtin_amdgcn_cvt_pk_fp8_f32(sat8(b[2]), sat8(b[3]), w1, true); return (u32x2){w0, w1}; }
constexpr float ACT8_SC = 8.0f;
template <bool TILED, bool O8 = false> struct EpiSwiglu {
    static constexpr bool PERM = true, AFTER_DRAIN = false;
    bf16_t* O; int ldc; const ssq_t* ssq; const int* cb; int cbstride; float eps; float dsc;
    __device__ __forceinline__ void operator()(f32x4 (&acc)[2][2][4][2], const Unit& u, int wr, int wc, int fr, int fq) const {
        const int row0 = u.pm * BM + wr * 64 + fr, lc = wc * 32 + 8 * fq, col0 = u.pn * HALF + lc;
        const int* cbp = cb + (size_t)(u.pm >> 3) * cbstride + u.pn * BM + lc;
        f32x4 cv[2][2];
#pragma unroll
        for (int bj = 0; bj < 2; ++bj)
#pragma unroll
            for (int n = 0; n < 2; ++n) cv[bj][n] = cb_ld4(cbp + bj * HALF + 4 * n);
#pragma unroll
        for (int ai = 0; ai < 2; ++ai)
#pragma unroll
            for (int m = 0; m < 4; ++m) { const int row = row0 + ai * HALF + m * 16;
                bf16_t* rowp = TILED ? O + ((size_t)u.pm * (ldc / 64) + 2 * u.pn + (wc >> 1)) * (BM * 64) + (size_t)(row - u.pm * BM) * 64 + (wc & 1) * 32 + 8 * fq
                                    : O + (size_t)row * ldc + col0;
                const float ri = __builtin_amdgcn_rsqf(ssq_dec(ssq[row]) * (1.0f / 2048.0f) + eps) * dsc;
                f32x4 r0, r1;
#pragma unroll
                for (int e = 0; e < 4; ++e) { const float g0 = acc[ai][0][m][0][e] * ri + cv[0][0][e], g1 = acc[ai][0][m][1][e] * ri + cv[0][1][e];
                    r0[e] = g0 * fast_sigmoid(g0) * (acc[ai][1][m][0][e] * ri + cv[1][0][e]); r1[e] = g1 * fast_sigmoid(g1) * (acc[ai][1][m][1][e] * ri + cv[1][1][e]); }
                if constexpr (O8) *(u32x2*)((unsigned char*)O + (size_t)row * ldc + col0) = pack8_fp8(r0 * ACT8_SC, r1 * ACT8_SC);
                else *(u32x4*)rowp = pack8_bf16(r0, r1); }
    }
};
typedef _Float16 f16_t;
__device__ __forceinline__ float h_lo(unsigned w) { return (float)__builtin_bit_cast(_Float16, (unsigned short)(w & 0xffffu)); }
__device__ __forceinline__ float h_hi(unsigned w) { return (float)__builtin_bit_cast(_Float16, (unsigned short)(w >> 16)); }
__device__ __forceinline__ void unpack8_f16(const u32x4 w, f32x4& a, f32x4& b) {
    const unsigned w0 = w[0], w1 = w[1], w2 = w[2], w3 = w[3];
    a[0] = h_lo(w0); a[1] = h_hi(w0); a[2] = h_lo(w1); a[3] = h_hi(w1); b[0] = h_lo(w2); b[1] = h_hi(w2); b[2] = h_lo(w3); b[3] = h_hi(w3); }
__device__ __forceinline__ unsigned pk2_f16(float lo, float hi) {
    const unsigned short l = __builtin_bit_cast(unsigned short, (_Float16)__builtin_fminf(__builtin_fmaxf(lo, -65504.f), 65504.f)), h = __builtin_bit_cast(unsigned short, (_Float16)__builtin_fminf(__builtin_fmaxf(hi, -65504.f), 65504.f));
    return (unsigned)l | ((unsigned)h << 16); }
__device__ __forceinline__ u32x4 pack8_f16(const f32x4 a, const f32x4 b) { u32x4 w; w[0] = pk2_f16(a[0], a[1]); w[1] = pk2_f16(a[2], a[3]); w[2] = pk2_f16(b[0], b[1]); w[3] = pk2_f16(b[2], b[3]); return w; }
template <bool NEXT, bool F8 = false> struct EpiResid {
    static constexpr bool PERM = true, AFTER_DRAIN = false;
    bf16_t* X; const float* gate; bf16_t* An; const float* gn; const float* scn; ssq_t* ssqn; unsigned char* A8; int gstride; float s;
    __device__ __forceinline__ void operator()(f32x4 (&acc)[2][2][4][2], const Unit& u, int wr, int wc, int fr, int fq) const {
        const int row0 = u.pm * BM + wr * 64 + fr, col0 = u.pn * BM + wc * 32 + 8 * fq;
        const unsigned cofs = (unsigned)((u.pm >> 3) * gstride + col0);
        const unsigned e0 = (unsigned)row0 * 2048u + (unsigned)col0;
#pragma unroll
        for (int ah = 0; ah < 4; ++ah) { const int ai = ah >> 1, mb = (ah & 1) * 2; u32x4 xw[2][2];
#pragma unroll
            for (int mm = 0; mm < 2; ++mm)
#pragma unroll
                for (int bj = 0; bj < 2; ++bj) xw[mm][bj] = *(const u32x4*)(X + (size_t)(e0 + (unsigned)(ai * HALF + (mb + mm) * 16) * 2048u + bj * HALF));
            float ss[2] = {0.f, 0.f};
#pragma unroll
            for (int bj = 0; bj < 2; ++bj) { f32x4 gv[2], nv[2];
#pragma unroll
                for (int n = 0; n < 2; ++n) { gv[n] = *(const f32x4*)(gate + (size_t)(cofs + bj * HALF + 4 * n)) * s;
                    if (NEXT) nv[n] = *(const f32x4*)(gn + (size_t)(unsigned)(col0 + bj * HALF + 4 * n)) * (*(const f32x4*)(scn + (size_t)(cofs + bj * HALF + 4 * n)) + 1.0f); }
#pragma unroll
                for (int mm = 0; mm < 2; ++mm) { const int m = mb + mm; const unsigned off = e0 + (unsigned)(ai * HALF + m * 16) * 2048u + bj * HALF;
                    f32x4 a, b; unpack8_f16(xw[mm][bj], a, b); a += gv[0] * acc[ai][bj][m][0]; b += gv[1] * acc[ai][bj][m][1];
                    *(u32x4*)(X + (size_t)off) = pack8_f16(a, b);
                    if (NEXT) { ss[mm] += ((a[0] * a[0] + a[1] * a[1]) + (a[2] * a[2] + a[3] * a[3])) + ((b[0] * b[0] + b[1] * b[1]) + (b[2] * b[2] + b[3] * b[3]));
                        const f32x4 an = a * nv[0], bn = b * nv[1]; *(u32x4*)(An + (size_t)off) = pack8_bf16(an, bn);
                        if (F8) *(u32x2*)(A8 + (size_t)off) = pack8_fp8(an, bn); } } }
            if (NEXT) {
#pragma unroll
                for (int mm = 0; mm < 2; ++mm) { float t = ss[mm]; t += __shfl_xor(t, 16); t += __shfl_xor(t, 32); if (fq == 0) ssq_add(ssqn + row0 + ai * HALF + (mb + mm) * 16, t); } }
            asm volatile("" ::: "memory"); }
    }
};
template <int MODE, bool QF8> struct EpiWin {
    static constexpr bool PERM = true, AFTER_DRAIN = false;
    bf16_t *LRUX, *LRUG, *SCB, *SCC, *SCX, *Q, *KVLAT, *GATES, *KPE; ssq_t* ssq; const ssq_t* ssqn; const int* cb; int cbstride; float eps;
    __device__ __forceinline__ void operator()(f32x4 (&acc)[2][2][4][2], const Unit& u, int wr, int wc, int fr, int fq) const {
        const int t = u.pn; bf16_t* base; int pitch, cbs, act = 0;
        if (MODE == 0) { const int tq = QF8 ? 20 : 32;
            if (t < 4) { base = LRUX; pitch = 1024; cbs = 256 * t; }
            else if (t < 8) { base = LRUG; pitch = 1024; cbs = 256 * (t - 4); act = 1; }
            else if (t < 12) { base = SCB; pitch = 1024; cbs = 256 * (t - 8); }
            else if (t < 16) { base = SCC; pitch = 1024; cbs = 256 * (t - 12); }
            else if (t < 20) { base = SCX; pitch = 1024; cbs = 256 * (t - 16); }
            else if (t < tq) { base = Q; pitch = 3072; cbs = 256 * (t - 20); }
            else if (t < tq + 2) { base = KVLAT; pitch = 512; cbs = 256 * (t - tq); act = 3; }
            else if (!G1_BF16 || t == tq + 2) { base = KPE; pitch = 64; cbs = 0; act = 4; }
            else { base = GATES; pitch = 6144; cbs = 2048 + 256 * (t - (tq + 3)); act = 2; }
        } else if (MODE == 2) {
            if (t < 4) { base = LRUX; pitch = 1024; cbs = 256 * t; }
            else if (t < 8) { base = LRUG; pitch = 1024; cbs = 256 * (t - 4); act = 1; }
            else if (t < 12) { base = SCB; pitch = 1024; cbs = 256 * (t - 8); }
            else if (t < 16) { base = SCC; pitch = 1024; cbs = 256 * (t - 12); }
            else if (t < 20) { base = SCX; pitch = 1024; cbs = 256 * (t - 16); }
            else if (t < 32) { base = Q; pitch = 3072; cbs = 256 * (t - 20); }
            else if (t < 34) { base = KVLAT; pitch = 512; cbs = 256 * (t - 32); act = 3; }
            else if (t < 58) { base = GATES; pitch = 6144; cbs = 256 * (t - 34); act = 2; }
            else { base = KPE; pitch = 64; cbs = 0; act = 4; }
        } else { const int tg = QF8 ? 12 : 0;
            if (t < tg) { base = Q; pitch = 3072; cbs = 256 * t; }
            else { base = GATES; pitch = 6144; cbs = 256 * (t - tg) + ((G1_BF16 && t >= tg + 8) ? 2048 : 0); act = 2; }
        }
        const float dsc = MODE >= 1 ? (1.0f / 64.0f) : 1.0f;
        const int row0 = u.pm * BM + wr * 64 + fr;
        bf16_t* p0 = base + (size_t)row0 * pitch + cbs + wc * 32 + 8 * fq;
        const size_t rstep = (size_t)16 * pitch;
        const int* cbp = cb + (size_t)(u.pm >> 3) * cbstride + (MODE == 1 ? (QF8 ? (G1_BF16 ? 7936 : 5888) : 8960) : 0) + u.pn * BM + wc * 32 + 8 * fq;
        if (act == 4) {
            if (wc < 2) { f32x4 cv[1][2]; cv[0][0] = cb_ld4(cbp); cv[0][1] = cb_ld4(cbp + 4);
#pragma unroll
                for (int ai = 0; ai < 2; ++ai)
#pragma unroll
                    for (int m = 0; m < 4; ++m) { const float ri = __builtin_amdgcn_rsqf(ssq_dec(ssqn[row0 + ai * HALF + m * 16]) * (1.0f / 2048.0f) + eps) * dsc;
                        *(u32x4*)(p0 + (size_t)(ai * 8 + m) * rstep) = pack8_bf16(acc[ai][0][m][0] * ri + cv[0][0], acc[ai][0][m][1] * ri + cv[0][1]); }
            }
            return;
        }
        f32x4 cv[2][2];
#pragma unroll
        for (int bj = 0; bj < 2; ++bj)
#pragma unroll
            for (int n = 0; n < 2; ++n) cv[bj][n] = cb_ld4(cbp + bj * HALF + 4 * n);
#pragma unroll
        for (int ai = 0; ai < 2; ++ai)
#pragma unroll
            for (int m = 0; m < 4; ++m) { bf16_t* rowp = p0 + (size_t)(ai * 8 + m) * rstep;
                const float ri = __builtin_amdgcn_rsqf(ssq_dec(ssqn[row0 + ai * HALF + m * 16]) * (1.0f / 2048.0f) + eps) * dsc;
                f32x4 v[2][2];
#pragma unroll
                for (int bj = 0; bj < 2; ++bj)
#pragma unroll
                    for (int n = 0; n < 2; ++n) v[bj][n] = acc[ai][bj][m][n] * ri + cv[bj][n];
                if (act == 1) {
#pragma unroll
                    for (int bj = 0; bj < 2; ++bj)
#pragma unroll
                        for (int n = 0; n < 2; ++n)
#pragma unroll
                            for (int e = 0; e < 4; ++e) v[bj][n][e] = gelu_tanh(v[bj][n][e]);
                } else if (act == 2) {
#pragma unroll
                    for (int bj = 0; bj < 2; ++bj)
#pragma unroll
                        for (int n = 0; n < 2; ++n)
#pragma unroll
                            for (int e = 0; e < 4; ++e) v[bj][n][e] = fast_sigmoid(v[bj][n][e]);
                } else if (act == 3) { float s = 0.f;
#pragma unroll
                    for (int bj = 0; bj < 2; ++bj)
#pragma unroll
                        for (int n = 0; n < 2; ++n) { const f32x4 x = v[bj][n]; s += (x[0] * x[0] + x[1] * x[1]) + (x[2] * x[2] + x[3] * x[3]); }
                    s += __shfl_xor(s, 16); s += __shfl_xor(s, 32);
                    if (fq == 0) ssq_add(ssq + row0 + ai * HALF + m * 16, s); }
                if (GATES_U8 && act == 2) { unsigned char* r8 = (unsigned char*)base + (size_t)(row0 + ai * HALF + m * 16) * pitch + cbs + wc * 32 + 8 * fq;
#pragma unroll
                    for (int bj = 0; bj < 2; ++bj) { unsigned w0 = 0u, w1 = 0u;
#pragma unroll
                        for (int e = 0; e < 4; ++e) { w0 = __builtin_amdgcn_cvt_pk_u8_f32(v[bj][0][e] * 255.0f, e, w0); w1 = __builtin_amdgcn_cvt_pk_u8_f32(v[bj][1][e] * 255.0f, e, w1); }
                        *(u32x2*)(r8 + bj * HALF) = (u32x2){w0, w1}; } }
                else { *(u32x4*)rowp = pack8_bf16(v[0][0], v[0][1]); *(u32x4*)(rowp + HALF) = pack8_bf16(v[1][0], v[1][1]); }
                asm volatile("" ::: "memory"); }
    }
};
struct EpiKV {
    static constexpr bool PERM = true, AFTER_DRAIN = false;
    bf16_t *KN, *V; const ssq_t* ssq; float eps;
    __device__ __forceinline__ void operator()(f32x4 (&acc)[2][2][4][2], const Unit& u, int wr, int wc, int fr, int fq) const {
        const int row0 = u.pm * BM + wr * 64 + fr, col0 = u.pn * HALF + wc * 32 + 8 * fq;
#pragma unroll
        for (int ai = 0; ai < 2; ++ai)
#pragma unroll
            for (int m = 0; m < 4; ++m) { const int row = row0 + ai * HALF + m * 16; const float ri = __builtin_amdgcn_rsqf(ssq_dec(ssq[row]) * (1.0f / 512.0f) + eps);
                *(u32x4*)(KN + (size_t)row * 2048 + col0) = pack8_bf16(acc[ai][0][m][0] * ri, acc[ai][0][m][1] * ri);
                *(u32x4*)(V + (size_t)row * 2048 + col0) = pack8_bf16(acc[ai][1][m][0] * ri, acc[ai][1][m][1] * ri); }
    }
};
struct EpiMerge3 {
    static constexpr bool PERM = true, AFTER_DRAIN = false;
    bf16_t* Mg; const unsigned char* G; int gp;
    static __device__ __forceinline__ void un8(const u32x2 w, f32x4& a, f32x4& b) {
        a[0] = __builtin_fmaxf((float)(w[0] & 0xffu), 0.00390625f); a[1] = __builtin_fmaxf((float)((w[0] >> 8) & 0xffu), 0.00390625f); a[2] = __builtin_fmaxf((float)((w[0] >> 16) & 0xffu), 0.00390625f); a[3] = __builtin_fmaxf((float)(w[0] >> 24), 0.00390625f);
        b[0] = __builtin_fmaxf((float)(w[1] & 0xffu), 0.00390625f); b[1] = __builtin_fmaxf((float)((w[1] >> 8) & 0xffu), 0.00390625f); b[2] = __builtin_fmaxf((float)((w[1] >> 16) & 0xffu), 0.00390625f); b[3] = __builtin_fmaxf((float)(w[1] >> 24), 0.00390625f); }
    static __device__ __forceinline__ f32x4 rcp4(f32x4 g) { f32x4 r; r[0] = __builtin_amdgcn_rcpf(g[0]); r[1] = __builtin_amdgcn_rcpf(g[1]); r[2] = __builtin_amdgcn_rcpf(g[2]); r[3] = __builtin_amdgcn_rcpf(g[3]); return r; }
    __device__ __forceinline__ bool mid_at(int t) const { return t == 16 || t == 32; }
    __device__ __forceinline__ void mid(f32x4 (&acc)[2][2][4][2], const Unit& u, int wr, int wc, int fr, int fq, int t) const {
        const int row0 = u.pm * BM + wr * 64 + fr, col0 = u.pn * BM + wc * 32 + 8 * fq + (t == 16 ? 0 : 2048);
        const unsigned char* g0p = G + (size_t)row0 * gp + col0;
#pragma unroll
        for (int ai = 0; ai < 2; ++ai) { u32x2 nw[4][2], dw[4][2];
#pragma unroll
            for (int m = 0; m < 4; ++m)
#pragma unroll
                for (int bj = 0; bj < 2; ++bj) { const size_t ro = (size_t)(ai * HALF + m * 16);
                    nw[m][bj] = *(const u32x2*)(g0p + ro * gp + bj * HALF); dw[m][bj] = *(const u32x2*)(g0p + ro * gp + bj * HALF + 2048); }
#pragma unroll
            for (int m = 0; m < 4; ++m)
#pragma unroll
                for (int bj = 0; bj < 2; ++bj) { f32x4 n0, n1, d0, d1; un8(nw[m][bj], n0, n1); un8(dw[m][bj], d0, d1);
                    acc[ai][bj][m][0] *= n0 * rcp4(d0); acc[ai][bj][m][1] *= n1 * rcp4(d1); }
            asm volatile("" ::: "memory"); }
    }
    __device__ __forceinline__ void operator()(f32x4 (&acc)[2][2][4][2], const Unit& u, int wr, int wc, int fr, int fq) const {
        const int row0 = u.pm * BM + wr * 64 + fr, col0 = u.pn * BM + wc * 32 + 8 * fq;
        const unsigned char* g0p = G + (size_t)row0 * gp + col0 + 4096; bf16_t* m0p = Mg + (size_t)row0 * 2048 + col0;
#pragma unroll
        for (int ai = 0; ai < 2; ++ai) { u32x2 gw[4][2];
#pragma unroll
            for (int m = 0; m < 4; ++m)
#pragma unroll
                for (int bj = 0; bj < 2; ++bj) gw[m][bj] = *(const u32x2*)(g0p + (size_t)(ai * HALF + m * 16) * gp + bj * HALF);
#pragma unroll
            for (int m = 0; m < 4; ++m)
#pragma unroll
                for (int bj = 0; bj < 2; ++bj) { f32x4 g0, g1; un8(gw[m][bj], g0, g1);
                    *(u32x4*)(m0p + (size_t)(ai * HALF + m * 16) * 2048 + bj * HALF) = pack8_bf16(acc[ai][bj][m][0] * (g0 * (1.0f / 255.0f)), acc[ai][bj][m][1] * (g1 * (1.0f / 255.0f))); }
            asm volatile("" ::: "memory"); }
    }
};
template <> struct has_mid<EpiMerge3> { static constexpr bool value = true; };
template <bool FIRST> struct EpiMerge {
    static constexpr bool PERM = true, AFTER_DRAIN = false;
    bf16_t* Mg; const bf16_t* G; int gp;
    __device__ __forceinline__ void operator()(f32x4 (&acc)[2][2][4][2], const Unit& u, int wr, int wc, int fr, int fq) const {
        const int row0 = u.pm * BM + wr * 64 + fr, col0 = u.pn * BM + wc * 32 + 8 * fq;
        const bf16_t* g0p = G + (size_t)row0 * gp + col0; bf16_t* m0p = Mg + (size_t)row0 * 2048 + col0;
#pragma unroll
        for (int ai = 0; ai < 2; ++ai) { u32x4 gw[4][2], mw[4][2];
#pragma unroll
            for (int m = 0; m < 4; ++m)
#pragma unroll
                for (int bj = 0; bj < 2; ++bj) { const size_t ro = (size_t)(ai * HALF + m * 16);
                    gw[m][bj] = *(const u32x4*)(g0p + ro * gp + bj * HALF); if (!FIRST) mw[m][bj] = *(const u32x4*)(m0p + ro * 2048 + bj * HALF); }
#pragma unroll
            for (int m = 0; m < 4; ++m)
#pragma unroll
                for (int bj = 0; bj < 2; ++bj) { const size_t ro = (size_t)(ai * HALF + m * 16);
                    f32x4 g0, g1; unpack8_bf16(gw[m][bj], g0, g1); f32x4 v0 = acc[ai][bj][m][0] * g0, v1 = acc[ai][bj][m][1] * g1;
                    if (!FIRST) { f32x4 m0, m1; unpack8_bf16(mw[m][bj], m0, m1); v0 += m0; v1 += m1; }
                    *(u32x4*)(m0p + ro * 2048 + bj * HALF) = pack8_bf16(v0, v1); }
            asm volatile("" ::: "memory"); }
    }
};
template <bool F> struct FragA_ { bf16x8 v[4][2]; }; template <> struct FragA_<true> { v8i_t v[4]; };
template <bool F> struct FragB_ { bf16x8 v[2][2]; }; template <> struct FragB_<true> { v8i_t v[2]; };
template <class Epi, class Sched, bool ALIGN_EPI = false, bool SP2 = false, bool REVK = false, bool ATILED = false, bool BTILED = false, bool FP8 = false>
__device__ __forceinline__ void gemm_phase(PG8_LAS unsigned char* lds, const Gemm g, const Sched S, const Epi E, int wave_id) {
    unsigned m1_ = ~0u; asm volatile("" : "+s"(m1_)); int tid_ = wave_id * 64 + (int)__builtin_amdgcn_mbcnt_hi(m1_, __builtin_amdgcn_mbcnt_lo(m1_, 0u)); asm volatile("" : "+v"(tid_));
    const int tid = tid_, wid = __builtin_amdgcn_readfirstlane(tid >> 6), lane = tid & 63, wr = wid >> 2, wc = wid & 3, fr = lane & 15, fq = lane >> 4;
    const int K = g.K, nt = K / BK, LD = g.ld ? g.ld : K;
    unsigned voffA[2], voffB[2];
#pragma unroll
    for (int i = 0; i < 2; ++i) { int R, C; stage_rc(tid * 16 + i * 8192, R, C); const int Rb = Epi::PERM ? ((R & ~31) + perm32(R & 31)) : R;
        voffA[i] = ATILED ? (unsigned)(R * BK + C) * 2u : (unsigned)(R * LD + C) * 2u; voffB[i] = BTILED ? (unsigned)(Rb * BK + C) * 2u : (unsigned)(Rb * LD + C) * 2u; }
    const size_t kstep = REVK ? (size_t)0 - (size_t)(BK * 2) : (size_t)(BK * 2), kbase = REVK ? (size_t)(K - BK) * 2 : (size_t)0;
    const size_t hstep = (size_t)HALF * LD * 2;
    const size_t kstepB = BTILED ? (size_t)(BM * BK * 2) : kstep, hstepB = BTILED ? (size_t)(HALF * BK * 2) : hstep;
    const size_t kstepA = ATILED ? (size_t)(BM * BK * 2) : kstep, hstepA = ATILED ? (size_t)(HALF * BK * 2) : hstep;
    const size_t tstep = 2 * hstep;
    const unsigned ldsw = (unsigned)wid * 1024u;
    const int aoff = lds_byte(wr * 64 + fr, fq * 8), boff = lds_byte(wc * 32 + fr, fq * 8);
#define PG8_SA(b, h) (((b) * 2 + (h)) * HTB)
#define PG8_SB(b, h) ((4 + (b) * 2 + (h)) * HTB)
#define PG8_STAGE(bufoff, gbase, voff) do { _Pragma("unroll") for (int _i = 0; _i < 2; ++_i) \
        __builtin_amdgcn_global_load_lds((const unsigned*)((const char*)(gbase) + (voff)[_i]), (PG8_LAS unsigned*)(lds + (bufoff) + ldsw + _i * 8192), 16, 0, 0); } while (0)
#define PG8_LDA(dst, b, h) do { if constexpr (FP8) { _Pragma("unroll") for (int m = 0; m < 4; ++m) { const v4i_t lo_ = *(const PG8_LAS v4i_t*)(lds + PG8_SA(b, h) + aoff + m * 2048), hi_ = *(const PG8_LAS v4i_t*)(lds + PG8_SA(b, h) + aoff + m * 2048 + 1024); dst.v[m] = __builtin_shufflevector(lo_, hi_, 0, 1, 2, 3, 4, 5, 6, 7); } } \
        else { _Pragma("unroll") for (int m = 0; m < 4; ++m) _Pragma("unroll") for (int k = 0; k < 2; ++k) dst.v[m][k] = *(const PG8_LAS bf16x8*)(lds + PG8_SA(b, h) + aoff + m * 2048 + k * 1024); } } while (0)
#define PG8_LDB(dst, b, h) do { if constexpr (FP8) { _Pragma("unroll") for (int n = 0; n < 2; ++n) { const v4i_t lo_ = *(const PG8_LAS v4i_t*)(lds + PG8_SB(b, h) + boff + n * 2048), hi_ = *(const PG8_LAS v4i_t*)(lds + PG8_SB(b, h) + boff + n * 2048 + 1024); dst.v[n] = __builtin_shufflevector(lo_, hi_, 0, 1, 2, 3, 4, 5, 6, 7); } } \
        else { _Pragma("unroll") for (int n = 0; n < 2; ++n) _Pragma("unroll") for (int k = 0; k < 2; ++k) dst.v[n][k] = *(const PG8_LAS bf16x8*)(lds + PG8_SB(b, h) + boff + n * 2048 + k * 1024); } } while (0)
#define PG8_MMA(ai, bj, At, Bt) do { __builtin_amdgcn_s_setprio(1); \
        if constexpr (FP8) { _Pragma("unroll") for (int m = 0; m < 4; ++m) _Pragma("unroll") for (int n = 0; n < 2; ++n) \
            asm volatile("v_mfma_scale_f32_16x16x128_f8f6f4 %0, %1, %2, %0, %3, %3 op_sel_hi:[0,0,0]" : "+v"(acc[ai][bj][m][n]) : "v"(Bt.v[n]), "v"(At.v[m]), "v"(sc_one)); } \
        else { _Pragma("unroll") for (int m = 0; m < 4; ++m) _Pragma("unroll") for (int n = 0; n < 2; ++n) _Pragma("unroll") for (int k = 0; k < 2; ++k) \
            acc[ai][bj][m][n] = __builtin_amdgcn_mfma_f32_16x16x32_bf16(Bt.v[n][k], At.v[m][k], acc[ai][bj][m][n], 0, 0, 0); } \
        __builtin_amdgcn_s_setprio(0); } while (0)
#define PG8_WAIT_V(n) asm volatile("s_waitcnt vmcnt(" #n ")" ::: "memory")
#define PG8_WAIT_L(n) asm volatile("s_waitcnt lgkmcnt(" #n ")" ::: "memory")
#define PG8_BAR __builtin_amdgcn_s_barrier()
#define PG8_SCHED __builtin_amdgcn_sched_barrier(0)
    Unit cur, nxt; int ui = 0;
    if (!S.next(0, cur)) return;
    f32x4 acc[2][2][4][2];
#pragma unroll
    for (int a = 0; a < 2; ++a)
#pragma unroll
        for (int b = 0; b < 2; ++b)
#pragma unroll
            for (int m = 0; m < 4; ++m)
#pragma unroll
                for (int n = 0; n < 2; ++n) acc[a][b][m][n] = (f32x4){0.f, 0.f, 0.f, 0.f};
    int sc_one = 0x7f7f7f7f; asm volatile("" : "+v"(sc_one));
    FragA_<FP8> At; FragB_<FP8> B0, B1;
    const char* cA = (const char*)g.A + (size_t)cur.pm * tstep + kbase; const char* cB = (const char*)g.Bt + (size_t)cur.pn * tstep + kbase;
    S.a_ready(cur);
    if constexpr (SP2) {
        PG8_STAGE(PG8_SB(0, 0), cB, voffB); PG8_STAGE(PG8_SB(0, 1), cB + hstepB, voffB); PG8_STAGE(PG8_SA(0, 0), cA, voffA); PG8_STAGE(PG8_SA(0, 1), cA + hstepA, voffA);
        if (wr == 1) PG8_BAR;
        PG8_WAIT_V(2); PG8_BAR;
        PG8_STAGE(PG8_SB(1, 0), cB + kstepB, voffB); PG8_STAGE(PG8_SA(1, 0), cA + kstepA, voffA); PG8_STAGE(PG8_SB(1, 1), cB + hstepB + kstepB, voffB);
        PG8_WAIT_V(6); PG8_BAR;
    } else {
        PG8_STAGE(PG8_SB(0, 0), cB, voffB); PG8_STAGE(PG8_SA(0, 0), cA, voffA); PG8_STAGE(PG8_SB(0, 1), cB + hstepB, voffB); PG8_STAGE(PG8_SA(0, 1), cA + hstepA, voffA);
        if (wr == 1) PG8_BAR;
        PG8_WAIT_V(4); PG8_BAR;
        PG8_STAGE(PG8_SB(1, 0), cB + kstepB, voffB); PG8_STAGE(PG8_SA(1, 0), cA + kstepA, voffA); PG8_STAGE(PG8_SB(1, 1), cB + hstepB + kstepB, voffB);
        PG8_WAIT_V(6); PG8_BAR;
    }
    for (;;) {
        const bool has_next = S.next(ui + 1, nxt);
        const char* nA = has_next ? (const char*)g.A + (size_t)nxt.pm * tstep + kbase : cA; const char* nB = has_next ? (const char*)g.Bt + (size_t)nxt.pn * tstep + kbase : cB;
        for (int t = 0; t < nt; t += 2) {
            if constexpr (has_mid<Epi>::value) { if (E.mid_at(t)) { int fr_m = fr, fq_m = fq; asm volatile("" : "+v"(fr_m), "+v"(fq_m)); E.mid(acc, cur, wr, wc, fr_m, fq_m, t); } }
            const bool last = (t == nt - 2);
            const char* a1 = cA + (size_t)(t + 1) * kstepA;
            const char* a2 = last ? nA : cA + (size_t)(t + 2) * kstepA; const char* b2 = last ? nB : cB + (size_t)(t + 2) * kstepB;
            const char* a3 = a2 + kstepA; const char* b3 = b2 + kstepB;
            if (last && has_next) S.a_ready(nxt);
            if constexpr (SP2) {
            PG8_LDB(B0, 0, 0); PG8_LDB(B1, 0, 1); PG8_SCHED; PG8_LDA(At, 0, 0); PG8_STAGE(PG8_SA(1, 1), a1 + hstepA, voffA);
            PG8_WAIT_V(8); PG8_WAIT_L(0); PG8_BAR; PG8_MMA(0, 0, At, B0); PG8_MMA(0, 1, At, B1); PG8_BAR; PG8_SCHED;
            PG8_LDA(At, 0, 1); PG8_STAGE(PG8_SB(0, 0), b2, voffB); PG8_STAGE(PG8_SB(0, 1), b2 + hstepB, voffB); PG8_STAGE(PG8_SA(0, 0), a2, voffA);
            PG8_WAIT_V(8); PG8_WAIT_L(0); PG8_BAR; PG8_MMA(1, 0, At, B0); PG8_MMA(1, 1, At, B1); PG8_BAR; PG8_SCHED;
            PG8_LDB(B0, 1, 0); PG8_LDB(B1, 1, 1); PG8_SCHED; PG8_LDA(At, 1, 0); PG8_STAGE(PG8_SA(0, 1), a2 + hstepA, voffA);
            PG8_WAIT_V(8); PG8_WAIT_L(0); PG8_BAR; PG8_MMA(0, 0, At, B0); PG8_MMA(0, 1, At, B1); PG8_BAR; PG8_SCHED;
            PG8_LDA(At, 1, 1); PG8_STAGE(PG8_SB(1, 0), b3, voffB); PG8_STAGE(PG8_SB(1, 1), b3 + hstepB, voffB); PG8_STAGE(PG8_SA(1, 0), a3, voffA);
            PG8_WAIT_V(8); PG8_WAIT_L(0); PG8_BAR; PG8_MMA(1, 0, At, B0); PG8_MMA(1, 1, At, B1); PG8_BAR; PG8_SCHED;
            } else {
            PG8_LDB(B0, 0, 0); PG8_SCHED; PG8_LDA(At, 0, 0); PG8_STAGE(PG8_SA(1, 1), a1 + hstepA, voffA);
            PG8_WAIT_L(8); PG8_BAR; PG8_WAIT_L(0); PG8_MMA(0, 0, At, B0); PG8_BAR; PG8_SCHED;
            PG8_LDB(B1, 0, 1); PG8_STAGE(PG8_SB(0, 0), b2, voffB);
            PG8_BAR; PG8_WAIT_L(0); PG8_MMA(0, 1, At, B1); PG8_BAR;
            PG8_LDA(At, 0, 1); PG8_STAGE(PG8_SA(0, 0), a2, voffA);
            PG8_BAR; PG8_WAIT_L(0); PG8_MMA(1, 0, At, B0); PG8_BAR; PG8_SCHED;
            PG8_STAGE(PG8_SB(0, 1), b2 + hstepB, voffB);
            PG8_WAIT_V(6); PG8_BAR; PG8_MMA(1, 1, At, B1); PG8_BAR;
            PG8_LDB(B0, 1, 0); PG8_SCHED; PG8_LDA(At, 1, 0); PG8_STAGE(PG8_SA(0, 1), a2 + hstepA, voffA);
            PG8_WAIT_L(8); PG8_BAR; PG8_WAIT_L(0); PG8_MMA(0, 0, At, B0); PG8_BAR; PG8_SCHED;
            PG8_LDB(B1, 1, 1); PG8_STAGE(PG8_SB(1, 0), b3, voffB);
            PG8_BAR; PG8_WAIT_L(0); PG8_MMA(0, 1, At, B1); PG8_BAR;
            PG8_LDA(At, 1, 1); PG8_STAGE(PG8_SA(1, 0), a3, voffA);
            PG8_BAR; PG8_WAIT_L(0); PG8_MMA(1, 0, At, B0); PG8_BAR; PG8_SCHED;
            PG8_STAGE(PG8_SB(1, 1), b3 + hstepB, voffB);
            PG8_WAIT_V(6); PG8_BAR; PG8_MMA(1, 1, At, B1); PG8_BAR;
            }
        }
        if constexpr (FP8) { asm volatile("s_nop 15\n\ts_nop 15\n\ts_nop 15\n\ts_nop 15\n\ts_nop 15" ::: "memory"); }
        if constexpr (ALIGN_EPI) { if (wr == 0) PG8_BAR; }
        if constexpr (!Epi::AFTER_DRAIN) { int fr_e = fr, fq_e = fq; asm volatile("" : "+v"(fr_e), "+v"(fq_e));
            E(acc, cur, wr, wc, fr_e, fq_e); S.done(cur); }
        if (!has_next) break;
#pragma unroll
        for (int a = 0; a < 2; ++a)
#pragma unroll
            for (int b = 0; b < 2; ++b)
#pragma unroll
                for (int m = 0; m < 4; ++m)
#pragma unroll
                    for (int n = 0; n < 2; ++n) acc[a][b][m][n] = (f32x4){0.f, 0.f, 0.f, 0.f};
        cur = nxt; cA = nA; cB = nB; ++ui;
        if constexpr (ALIGN_EPI) { if (wr == 1) PG8_BAR; }
    }
    PG8_WAIT_V(0);
    if constexpr (!ALIGN_EPI) { if (wr == 0) PG8_BAR; }
    PG8_BAR;
    if constexpr (Epi::AFTER_DRAIN) { E.fused(acc, cur, wr, wc, fr, fq, lds, wid, lane); S.done(cur); }
#undef PG8_SA
#undef PG8_SB
#undef PG8_STAGE
#undef PG8_LDA
#undef PG8_LDB
#undef PG8_MMA
#undef PG8_WAIT_V
#undef PG8_WAIT_L
#undef PG8_BAR
#undef PG8_SCHED
}
}
namespace att {
#define ATT_LAS __attribute__((address_space(3)))
typedef unsigned short bf16;
typedef short bf16x8 __attribute__((ext_vector_type(8)));
typedef short s16x4 __attribute__((ext_vector_type(4)));
typedef float f32x16 __attribute__((ext_vector_type(16)));
typedef float f32x4 __attribute__((ext_vector_type(4)));
typedef unsigned u32x4 __attribute__((ext_vector_type(4)));
constexpr int NW = 8, QBLK = 32, KVBLK = 64, QB = NW * QBLK;
constexpr int SEQ = 2048, NH = 16, QPITCH = 3072, KPITCH = 2048, PEPITCH = 64, OPITCH = 4096  , QHEAD = 192;
constexpr float SCALE = 0.07216878364870322f;
constexpr float THR = 8.f;
constexpr int SHM_V = 16384, SHM_KN = 16384, SHM_KP = 8192;
constexpr int OFF_V = 0, OFF_KN = 3 * SHM_V, OFF_KP = OFF_KN + 2 * SHM_KN, OFF_WS = OFF_KP + 2 * SHM_KP, LDS_BYTES = OFF_WS + NW * 64 * 4;
#define ATT_KSWZ(row, colB) ((row) * 256 + ((colB) ^ (((row) & 7) << 4)))
#define ATT_KPSWZ(row, ch) ((row) * 128 + ((((ch) ^ (((row) >> 1) & 7))) << 4))
#define ATT_SBAR() __builtin_amdgcn_sched_barrier(0)
__device__ __forceinline__ int v_st(int k, int c) { const int kk = (k & ~0xC) | ((k & 4) << 1) | ((k & 8) >> 1); return ((kk >> 3) * 4 + (c >> 5)) * 512 + ((kk & 7) * 32 + (c & 31)) * 2; }
__device__ __forceinline__ int v_rd_base(int lane) { return ((lane & 3) << 3) | (((lane >> 2) & 3) << 6) | (((lane >> 4) & 1) << 5) | (((lane >> 5) & 1) << 8); }
constexpr int v_rd_off(int d0, int ks, int half) { return d0 * 512 + ks * 4096 + half * 2048; }
__device__ __forceinline__ int crow(int r, int hi) { return (r & 3) + 8 * (r >> 2) + 4 * hi; }
__device__ __forceinline__ unsigned cvtpk(float lo, float hi) { unsigned r; asm volatile("v_cvt_pk_bf16_f32 %0, %1, %2" : "=v"(r) : "v"(lo), "v"(hi)); return r; }
__device__ __forceinline__ void mask_tile(f32x16& p0, f32x16& p1, int dq) {
    const float NEG = -__builtin_inff();
#pragma unroll
    for (int r = 0; r < 16; ++r) { const int c = (r & 3) + 8 * (r >> 2); if (dq - c < 0) p0[r] = NEG; if (dq - c - 32 < 0) p1[r] = NEG; }
}
__device__ __forceinline__ void partialSM(f32x16& p0, f32x16& p1, float& m_reg, float& mn, float& alpha) {
    float pmax = p0[0];
#pragma unroll
    for (int r = 1; r < 16; ++r) pmax = fmaxf(pmax, p0[r]);
#pragma unroll
    for (int r = 0; r < 16; ++r) pmax = fmaxf(pmax, p1[r]);
    { auto rr = __builtin_amdgcn_permlane32_swap(__float_as_uint(pmax), __float_as_uint(pmax), false, false); pmax = fmaxf(__uint_as_float(rr[0]), __uint_as_float(rr[1])); }
    constexpr float C2 = 1.4426950408889634f * SCALE;
    if (__builtin_expect(__all((pmax - m_reg) * SCALE <= THR), 1)) { mn = m_reg; alpha = 1.f; }
    else { mn = fmaxf(m_reg, pmax); alpha = __builtin_amdgcn_exp2f((m_reg - mn) * C2); m_reg = mn; }
    const float mnL = -mn * C2;
#pragma unroll
    for (int r = 0; r < 16; ++r) p0[r] = fmaf(p0[r], C2, mnL);
#pragma unroll
    for (int r = 0; r < 16; ++r) p1[r] = fmaf(p1[r], C2, mnL);
#pragma unroll
    for (int r = 0; r < 16; ++r) p0[r] = __builtin_amdgcn_exp2f(p0[r]);
}
__device__ __forceinline__ void finishSM(f32x16& p0, f32x16& p1, float alpha, float& l_reg, bf16x8& pa0, bf16x8& pa1, bf16x8& pa2, bf16x8& pa3) {
#pragma unroll
    for (int r = 0; r < 16; ++r) p1[r] = __builtin_amdgcn_exp2f(p1[r]);
    float ps = 0;
#pragma unroll
    for (int r = 0; r < 16; ++r) ps += p0[r];
#pragma unroll
    for (int r = 0; r < 16; ++r) ps += p1[r];
    { auto rr = __builtin_amdgcn_permlane32_swap(__float_as_uint(ps), __float_as_uint(ps), false, false); ps = __uint_as_float(rr[0]) + __uint_as_float(rr[1]); }
    l_reg = l_reg * alpha + ps;
#define ATT_PK4(P, B_, OUT) do { unsigned a0 = cvtpk(P[B_+0], P[B_+1]), a1 = cvtpk(P[B_+2], P[B_+3]);                          \
        unsigned b0 = cvtpk(P[B_+4], P[B_+5]), b1 = cvtpk(P[B_+6], P[B_+7]);                                             \
        auto r0 = __builtin_amdgcn_permlane32_swap(a0, b0, false, false); auto r1 = __builtin_amdgcn_permlane32_swap(a1, b1, false, false); \
        u32x4 w = {r0[0], r1[0], r0[1], r1[1]}; OUT = __builtin_bit_cast(bf16x8, w); } while (0)
    ATT_PK4(p0, 0, pa0); ATT_PK4(p0, 8, pa1); ATT_PK4(p1, 0, pa2); ATT_PK4(p1, 8, pa3);
#undef ATT_PK4
}
__device__ __forceinline__ void qkt(f32x16& p0, f32x16& p1, ATT_LAS const char* lds, int kbuf, int r32, int hi, const bf16x8* qr) {
    p0 = f32x16{}; p1 = f32x16{};
    ATT_LAS const char* kb[4];
#pragma unroll
    for (int dd = 0; dd < 4; ++dd) kb[dd] = lds + OFF_KN + kbuf * SHM_KN + ATT_KSWZ(r32, (dd * 16 + hi * 8) * 2);
#pragma unroll
    for (int d0 = 0; d0 < 8; ++d0) { ATT_LAS const char* a = kb[d0 & 3] + (d0 >> 2) * 128;
        const bf16x8 b0 = *(ATT_LAS const bf16x8*)a;
        const bf16x8 b1 = *(ATT_LAS const bf16x8*)(a + 32 * 256);
        p0 = __builtin_amdgcn_mfma_f32_32x32x16_bf16(b0, qr[d0], p0, 0, 0, 0);
        p1 = __builtin_amdgcn_mfma_f32_32x32x16_bf16(b1, qr[d0], p1, 0, 0, 0); }
#pragma unroll
    for (int d1 = 0; d1 < 4; ++d1) { ATT_LAS const char* a = lds + OFF_KP + kbuf * SHM_KP + ATT_KPSWZ(r32, 2 * d1 + hi);
        const bf16x8 b0 = *(ATT_LAS const bf16x8*)a;
        const bf16x8 b1 = *(ATT_LAS const bf16x8*)(a + 32 * 128);
        p0 = __builtin_amdgcn_mfma_f32_32x32x16_bf16(b0, qr[8 + d1], p0, 0, 0, 0);
        p1 = __builtin_amdgcn_mfma_f32_32x32x16_bf16(b1, qr[8 + d1], p1, 0, 0, 0); }
}
__device__ __forceinline__ void pv_tile(f32x16* o, int vb0, bf16x8 pa0, bf16x8 pa1, bf16x8 pa2, bf16x8 pa3) {
#define ATT_TRRD(dst, off) asm volatile("ds_read_b64_tr_b16 %0, %1 offset:%2" : "=&v"(dst) : "v"(vb0), "i"(off) : "memory")
#define ATT_PV_RD(S, d0) do { constexpr int b_ = OFF_V + v_rd_off(d0, 0, 0); \
        ATT_TRRD(S##l0, b_); ATT_TRRD(S##h0, b_ + 2048); ATT_TRRD(S##l1, b_ + 4096); ATT_TRRD(S##h1, b_ + 6144); ATT_TRRD(S##l2, b_ + 8192); ATT_TRRD(S##h2, b_ + 10240); ATT_TRRD(S##l3, b_ + 12288); ATT_TRRD(S##h3, b_ + 14336); } while (0)
#define ATT_PV_MM(S, d0) do { \
        o[d0] = __builtin_amdgcn_mfma_f32_32x32x16_bf16(pa0, (bf16x8){S##l0[0], S##l0[1], S##l0[2], S##l0[3], S##h0[0], S##h0[1], S##h0[2], S##h0[3]}, o[d0], 0, 0, 0);   \
        o[d0] = __builtin_amdgcn_mfma_f32_32x32x16_bf16(pa1, (bf16x8){S##l1[0], S##l1[1], S##l1[2], S##l1[3], S##h1[0], S##h1[1], S##h1[2], S##h1[3]}, o[d0], 0, 0, 0);   \
        o[d0] = __builtin_amdgcn_mfma_f32_32x32x16_bf16(pa2, (bf16x8){S##l2[0], S##l2[1], S##l2[2], S##l2[3], S##h2[0], S##h2[1], S##h2[2], S##h2[3]}, o[d0], 0, 0, 0);   \
        o[d0] = __builtin_amdgcn_mfma_f32_32x32x16_bf16(pa3, (bf16x8){S##l3[0], S##l3[1], S##l3[2], S##l3[3], S##h3[0], S##h3[1], S##h3[2], S##h3[3]}, o[d0], 0, 0, 0); } while (0)
#define ATT_LGK(n) do { asm volatile("s_waitcnt lgkmcnt(" #n ")" ::: "memory"); ATT_SBAR(); } while (0)
    s16x4 Al0, Al1, Al2, Al3, Ah0, Ah1, Ah2, Ah3, Bl0, Bl1, Bl2, Bl3, Bh0, Bh1, Bh2, Bh3;
    ATT_PV_RD(A, 0);
    ATT_PV_RD(B, 1); ATT_LGK(8); ATT_PV_MM(A, 0); ATT_SBAR();
    ATT_PV_RD(A, 2); ATT_LGK(8); ATT_PV_MM(B, 1); ATT_SBAR();
    ATT_PV_RD(B, 3); ATT_LGK(8); ATT_PV_MM(A, 2); ATT_SBAR();
    ATT_LGK(0); ATT_PV_MM(B, 3);
#undef ATT_LGK
#undef ATT_PV_MM
#undef ATT_PV_RD
#undef ATT_TRRD
}
__device__ __forceinline__ void attn_unit(int b, int h, int qb, const bf16* __restrict__ Q, const bf16* __restrict__ KN, const bf16* __restrict__ KPE, const bf16* __restrict__ V, bf16* __restrict__ O, ATT_LAS char* lds, int wave_id) {
    unsigned m1_ = ~0u; asm volatile("" : "+s"(m1_)); int tid_ = wave_id * 64 + (int)__builtin_amdgcn_mbcnt_hi(m1_, __builtin_amdgcn_mbcnt_lo(m1_, 0u)); asm volatile("" : "+v"(tid_));
    const int tid = tid_, wid = __builtin_amdgcn_readfirstlane(tid >> 6), lane = tid & 63, r32 = lane & 31, hi = lane >> 5;
    const size_t rowbase = (size_t)b * SEQ; const int q0 = qb * QB, NT = (q0 + QB) / KVBLK;
    const int qlo = q0 + wid * QBLK, qm = qlo + r32 - 4 * hi;
    ATT_LAS float* ws = (ATT_LAS float*)(lds + OFF_WS) + wid * 64; ATT_LAS float* li_l = ws; ATT_LAS float* al_l = ws + 32;
    const int sr = tid >> 4, sc = (tid & 15) * 8, vst0 = v_st(sr, sc), vst1 = v_st(32 + sr, sc), kws = ATT_KSWZ(sr, sc * 2);
    const int pr = tid >> 3, pc = tid & 7, kpw = ATT_KPSWZ(pr, pc);
    const bf16* gK = KN + (rowbase + sr) * KPITCH + h * 128 + sc;
    const bf16* gV = V + (rowbase + sr) * KPITCH + h * 128 + sc;
    const bf16* gP = KPE + (rowbase + pr) * PEPITCH + pc * 8;
    const int vb0 = (int)(uintptr_t)lds + v_rd_base(lane);
    bf16x8 st_k0, st_k1, st_v0, st_v1, st_p;
#define ATT_SLOAD(t) do { const size_t ko_ = (size_t)(t) * KVBLK; st_v0 = *(const bf16x8*)(gV + ko_ * KPITCH); st_v1 = *(const bf16x8*)(gV + (ko_ + 32) * KPITCH); \
        st_k0 = *(const bf16x8*)(gK + ko_ * KPITCH); st_k1 = *(const bf16x8*)(gK + (ko_ + 32) * KPITCH); st_p = *(const bf16x8*)(gP + ko_ * PEPITCH); } while (0)
#define ATT_SWRITE(kbf, vbf) do { *(ATT_LAS bf16x8*)(lds + OFF_V + (vbf) * SHM_V + vst0) = st_v0; *(ATT_LAS bf16x8*)(lds + OFF_V + (vbf) * SHM_V + vst1) = st_v1; \
        *(ATT_LAS bf16x8*)(lds + OFF_KN + (kbf) * SHM_KN + kws) = st_k0; *(ATT_LAS bf16x8*)(lds + OFF_KN + (kbf) * SHM_KN + kws + 32 * 256) = st_k1; \
        *(ATT_LAS bf16x8*)(lds + OFF_KP + (kbf) * SHM_KP + kpw) = st_p; } while (0)
#define ATT_VMW() asm volatile("s_waitcnt vmcnt(0)" ::: "memory")
    bf16x8 qr[12];
    { const bf16* Qw = Q + (rowbase + qlo + r32) * QPITCH + h * QHEAD + hi * 8;
#pragma unroll
      for (int d0 = 0; d0 < 12; ++d0) qr[d0] = *(const bf16x8*)(Qw + d0 * 16); }
    ATT_SLOAD(0); ATT_VMW(); ATT_SWRITE(0, 0); __syncthreads();
    float m_reg = -1e30f, l_reg = 0.f; f32x16 o[4] = {};
#define ATT_RESC(a) do { if (__any((a) < 1.f)) { if (hi == 0) al_l[r32] = (a); asm volatile("s_waitcnt lgkmcnt(0)" ::: "memory");              \
        _Pragma("unroll") for (int d_ = 0; d_ < 4; ++d_) _Pragma("unroll") for (int r = 0; r < 16; ++r) o[d_][r] *= al_l[crow(r, hi)]; } } while (0)
    const bool grpB = wid >= 4;
    bf16x8 pa0 = {}, pa1 = {}, pa2 = {}, pa3 = {};
    bool act_prev = false; int kbuf = 0, vbuf = 0, vprev = 0;
    for (int t = 0; t < NT; ++t) {
        const int vnext = (vbuf == 2) ? 0 : vbuf + 1;
        if (t + 1 < NT) ATT_SLOAD(t + 1);
        ATT_SBAR();
        const int kb_ = t * KVBLK; const bool act = kb_ <= qlo + QBLK - 1;
        if (grpB && act_prev) { pv_tile(o, vb0 + vprev * SHM_V, pa0, pa1, pa2, pa3); ATT_SBAR(); }
        if (act) {
            f32x16 p0, p1; qkt(p0, p1, lds, kbuf, r32, hi, qr);
            if (kb_ + KVBLK - 1 > qlo) mask_tile(p0, p1, qm - kb_);
            float mn, alpha; partialSM(p0, p1, m_reg, mn, alpha);
            ATT_RESC(alpha);
            finishSM(p0, p1, alpha, l_reg, pa0, pa1, pa2, pa3); ATT_SBAR();
            if (!grpB) pv_tile(o, vb0 + vbuf * SHM_V, pa0, pa1, pa2, pa3); }
        ATT_SBAR();
        if (t + 1 < NT) { ATT_VMW(); ATT_SWRITE(kbuf ^ 1, vnext); }
        __syncthreads();
        act_prev = act; vprev = vbuf; vbuf = vnext; kbuf ^= 1;
    }
    if (grpB && act_prev) pv_tile(o, vb0 + vprev * SHM_V, pa0, pa1, pa2, pa3);
    if (hi == 0) li_l[r32] = l_reg; asm volatile("s_waitcnt lgkmcnt(0)" ::: "memory");
    float rli[16];
#pragma unroll
    for (int r = 0; r < 16; ++r) rli[r] = __builtin_amdgcn_rcpf(li_l[crow(r, hi)]);
    bf16* Ow = O + (rowbase + qlo) * OPITCH + h * 128;
#pragma unroll
    for (int r = 0; r < 16; ++r) { const int orow = crow(r, hi);
#pragma unroll
        for (int d0 = 0; d0 < 4; ++d0) { const float v = o[d0][r] * rli[r]; const float vn = __shfl_xor(v, 1);
            if ((r32 & 1) == 0) *(unsigned*)(Ow + (size_t)orow * OPITCH + d0 * 32 + r32) = cvtpk(v, vn); } }
    __syncthreads();
#undef ATT_SLOAD
#undef ATT_SWRITE
#undef ATT_VMW
#undef ATT_RESC
}
}
#ifndef MK_N_LAUNCHES
#define MK_N_LAUNCHES 1
#endif
constexpr int NWAVES = 8;
constexpr int NB = 8, SEQ = 2048, M = NB * SEQ, D = 2048, DFF = 5632, LW = 1024, NHD = 16, KVR = 512, INW = 14912, INWP = 15104, MODW = 9 * 2048, NL = 2;
constexpr float EPS = 1e-6f;
constexpr int PPL = 9, N_PHASES = 3 + PPL * NL;
constexpr int CBW = 15104;
constexpr size_t MiB = 1u << 20;
constexpr size_t WS_CTL = 0, CTL_ZERO_BYTES = 4 * MiB;
constexpr size_t WS_SSQ = 12 * MiB + 768 * 1024;
constexpr size_t WS_SSQN = 12 * MiB;
constexpr size_t WS_CB = 1 * MiB;
constexpr size_t WS_MOD = 4 * MiB;
constexpr size_t WS_COS = 6 * MiB, WS_SIN = 8 * MiB;
constexpr size_t WS_AGG = 10 * MiB;
constexpr size_t WS_WAX = 11 * MiB;
constexpr size_t WS_W = 16 * MiB, W_LAYER = 219 * MiB;
#ifndef FP8_Q
#define FP8_Q 1
#endif
#ifndef FP8_ALL
#define FP8_ALL 0
#endif
#ifndef FP8_DN
#define FP8_DN 15
#endif
constexpr bool fp8_dn(int l, int f) { return ((FP8_DN >> (2 * l + f)) & 1) != 0; }
#ifndef FP8_G4
#define FP8_G4 0
#endif
#ifndef G1_BF16
#define G1_BF16 1
#endif
constexpr int WIN_QF8 = FP8_Q, WINB_REAL = FP8_ALL ? 0 : (WIN_QF8 ? 5696 : 8768), WINB_PADEND = FP8_ALL ? 0 : (WIN_QF8 ? 5888 : 8960), WINB_ROWS = G1_BF16 ? 7936 : WINB_PADEND, WINF_ROWS = FP8_ALL ? 15104 : (WIN_QF8 ? (G1_BF16 ? 7168 : 9216) : 6144);
static_assert(!G1_BF16 || (FP8_Q && !FP8_ALL), "G1_BF16 needs the q + gates fp8 split");
constexpr size_t WO_WIN8 = FP8_ALL ? 132 * MiB : 168 * MiB;
constexpr size_t WO_W13 = 0, WO_W2 = 88 * MiB, WO_WIN = 132 * MiB, WO_WCAT = 191 * MiB  , WO_LRUO = WO_WCAT, WO_SCO = WO_WCAT + 1024 * 2, WO_MLAO = WO_WCAT + 2048 * 2, WO_UKV = 207 * MiB, WO_WO = 211 * MiB;
constexpr int YP = 4096;
constexpr size_t WS_HN = 456 * MiB;
constexpr size_t WS_LRUX = 520 * MiB, WS_LRUG = 552 * MiB, WS_SCB = 584 * MiB, WS_SCC = 616 * MiB, WS_SCX = 648 * MiB, WS_Q = 680 * MiB, WS_KVLAT = 776 * MiB, WS_GATES = 792 * MiB, WS_KPE = 984 * MiB;
constexpr size_t WS_ACT = 520 * MiB;
constexpr size_t WS_KN = 986 * MiB, WS_V = 1050 * MiB;
constexpr size_t WS_R = 456 * MiB, WS_GX = 488 * MiB;
constexpr size_t WS_YCAT = 1114 * MiB, WS_YLRU = WS_YCAT, WS_YSC = WS_YCAT + 1024 * 2, WS_ATT = WS_YCAT + 2048 * 2;
constexpr size_t WS_MERGED = 520 * MiB;
constexpr size_t WS_XH = 1242 * MiB;
constexpr size_t WS_A8 = 1306 * MiB;
constexpr size_t WS_END = 1338 * MiB;
static_assert(WS_W + NL * W_LAYER <= WS_HN && WS_ACT + (size_t)M * DFF * 2 <= WS_KN && WS_KPE + (size_t)M * 64 * 2 <= WS_KN && WS_YCAT + (size_t)M * YP * 2 <= WS_XH && WS_GX + (size_t)M * LW * 2 <= WS_LRUX && WS_XH + (size_t)M * D * 2 <= WS_A8 && WS_A8 + (size_t)M * D <= WS_END, "d_ws map");
static_assert(WS_SSQN + (size_t)NL * 3 * M * 8 <= WS_SSQ && WS_SSQ + (size_t)NL * M * 8 <= WS_W && WS_WAX + (size_t)NL * 2 * 8 * 16384 * 2 <= WS_SSQN && WS_CB + (size_t)NL * 3 * NB * CBW * 4 <= CTL_ZERO_BYTES && WS_MOD + (size_t)NL * NB * MODW * 4 <= WS_COS, "zeroed region map");
constexpr int CW_TMO = 0, CW_CODE = 1, CW_BAR = 4096;
constexpr int RING_OFF = 0, RING_BYTES = 131072;
constexpr int LDSCTL_OFF = RING_BYTES, MISC_OFF = LDSCTL_OFF + 320;
constexpr int LDS_BYTES = 147456;
#define GAS __attribute__((address_space(1)))
#define LAS __attribute__((address_space(3)))
typedef unsigned short bf16;
typedef unsigned v4u __attribute__((ext_vector_type(4)));
typedef unsigned v2u __attribute__((ext_vector_type(2)));
typedef float f32x4 __attribute__((ext_vector_type(4)));
typedef short bf16x8 __attribute__((ext_vector_type(8)));
typedef GAS unsigned gu32;
#define RLX_AGENT __ATOMIC_RELAXED, __HIP_MEMORY_SCOPE_AGENT
#define LDS_WAIT() asm volatile("s_waitcnt lgkmcnt(0)" ::: "memory")
#define VM_WAIT() asm volatile("s_waitcnt vmcnt(0)" ::: "memory")
__device__ __forceinline__ unsigned f2bf(float f) { unsigned u = __builtin_bit_cast(unsigned, f); return (u + 0x7fffu + ((u >> 16) & 1u)) >> 16; }
__device__ __forceinline__ unsigned pk2(float lo, float hi) { return f2bf(lo) | (f2bf(hi) << 16); }
__device__ __forceinline__ float bf2f(unsigned short b) { return __uint_as_float((unsigned)b << 16); }
__device__ __forceinline__ void unpack8(const v4u w, float (&f)[8]) {
    f[0] = __uint_as_float(w.x << 16); f[1] = __uint_as_float(w.x & 0xffff0000u); f[2] = __uint_as_float(w.y << 16); f[3] = __uint_as_float(w.y & 0xffff0000u);
    f[4] = __uint_as_float(w.z << 16); f[5] = __uint_as_float(w.z & 0xffff0000u); f[6] = __uint_as_float(w.w << 16); f[7] = __uint_as_float(w.w & 0xffff0000u); }
__device__ __forceinline__ v4u pack8(const float (&f)[8]) { v4u w; w.x = pk2(f[0], f[1]); w.y = pk2(f[2], f[3]); w.z = pk2(f[4], f[5]); w.w = pk2(f[6], f[7]); return w; }

#define XB_TMO      128
#define XB_XCNT(j)  (256  + 64 * (j))
#define XB_XSUB(j)  (1280 + 64 * (j))
#define XB_XGEN(j)  (2304 + 64 * (j))
#define XB_TOP      3328
#define XB_TOPGEN   3392
#define XCD_BAR_WORDS 3456
#define XB_SPIN_CAP (1u << 18)

__device__ __forceinline__ unsigned xb_ld(unsigned* p)              { return __hip_atomic_load(p, __ATOMIC_RELAXED, __HIP_MEMORY_SCOPE_AGENT); }
__device__ __forceinline__ unsigned xb_add(unsigned* p, unsigned v) { return __hip_atomic_fetch_add(p, v, __ATOMIC_RELAXED, __HIP_MEMORY_SCOPE_AGENT); }
__device__ __forceinline__ unsigned xb_xcc_id() { return (unsigned)__builtin_amdgcn_s_getreg((3 << 11) | 20) & 0xFu; }
#define XB_SPIN(cond, bar) do { unsigned _sp = 0; while (cond) { __builtin_amdgcn_s_sleep(1); \
    if ((++_sp & 255u) == 0u) { if (xb_ld(&(bar)[XB_TMO])) break; if (_sp > XB_SPIN_CAP) { atomicAdd(&(bar)[XB_TMO], 1u); break; } } } } while (0)

struct XcdBarrier {
    unsigned* bar; unsigned x;
    volatile LAS unsigned* st;
};

__device__ __forceinline__ XcdBarrier xcd_barrier_post(unsigned* bar, volatile LAS unsigned* st) {
    XcdBarrier b; b.bar = bar; b.x = xb_xcc_id(); b.st = st;
    if (threadIdx.x == 0) (void)xb_add(&bar[XB_XCNT(b.x)], 1u);
    return b;
}
__device__ __forceinline__ void xcd_barrier_complete(unsigned* bar, unsigned x, unsigned& nloc, unsigned& nx) {
    const unsigned G = gridDim.x * gridDim.y * gridDim.z;
    unsigned sum, cnt, mine, sp = 0u;
    for (;;) {
        sum = 0u; cnt = 0u; mine = 0u;
#pragma unroll
        for (unsigned j = 0; j < 16; ++j) { const unsigned c = xb_ld(&bar[XB_XCNT(j)]); sum += c; cnt += (c > 0u) ? 1u : 0u; mine = (j == x) ? c : mine; }
        if (sum == G) break;
        __builtin_amdgcn_s_sleep(1);
        if ((++sp & 255u) == 0u) { if (xb_ld(&bar[XB_TMO])) break; if (sp > XB_SPIN_CAP) { atomicAdd(&bar[XB_TMO], 1u); break; } }
    }
    nloc = mine > 0u ? mine : 1u; nx = cnt > 0u ? cnt : 1u;
}

__device__ __forceinline__ void xcd_barrier(const XcdBarrier& b) {
    asm volatile("s_waitcnt vmcnt(0)" ::: "memory");
    __syncthreads();
    if (threadIdx.x == 0) {
        unsigned* bar = b.bar;
        __builtin_amdgcn_s_waitcnt(0);
        unsigned nloc = b.st[0], nx = b.st[1];
        if (nloc == 0u) { xcd_barrier_complete(bar, b.x, nloc, nx); b.st[0] = nloc; b.st[1] = nx; }
        const unsigned old = xb_add(&bar[XB_XSUB(b.x)], 1u);
        const unsigned gen = old / nloc;
        if (old + 1u == (gen + 1u) * nloc) {
            __builtin_amdgcn_fence(__ATOMIC_RELEASE, "agent");
            asm volatile("s_waitcnt vmcnt(0)" ::: "memory");
            const unsigned og = xb_add(&bar[XB_TOP], 1u);
            const unsigned tg = og / nx;
            if (og + 1u == (tg + 1u) * nx) xb_add(&bar[XB_TOPGEN], 1u);
            else XB_SPIN(xb_ld(&bar[XB_TOPGEN]) == tg, bar);
            __builtin_amdgcn_fence(__ATOMIC_ACQUIRE, "agent");
            xb_add(&bar[XB_XGEN(b.x)], 1u);
            asm volatile("s_waitcnt vmcnt(0)" ::: "memory");
        } else {
            XB_SPIN(xb_ld(&bar[XB_XGEN(b.x)]) == gen, bar);
            __builtin_amdgcn_fence(__ATOMIC_ACQUIRE, "agent");
            asm volatile("s_waitcnt vmcnt(0)" ::: "memory");
        }
    }
    __syncthreads();
}
struct Frame {
    LAS unsigned char* lds; volatile LAS unsigned* MISC; gu32* ctl;
    int tid, lane, wave, vcu, G;
    GAS float* out; GAS unsigned char* ws;
};
typedef __attribute__((address_space(4))) const char* kaddr_t;
__device__ __forceinline__ const float* in_ptr(int i) { kaddr_t ka = (kaddr_t)__builtin_amdgcn_kernarg_segment_ptr(); asm volatile("" : "+s"(ka)); typedef GAS const float* cfp_t; typedef __attribute__((address_space(4))) const cfp_t* kpp_t; return (const float*)(*(kpp_t)(ka + 8 * i)); }
__device__ __forceinline__ GAS unsigned char* karg_ptr(int i) { kaddr_t ka = (kaddr_t)__builtin_amdgcn_kernarg_segment_ptr(); asm volatile("" : "+s"(ka)); typedef GAS unsigned char* gp_t; typedef __attribute__((address_space(4))) const gp_t* kpp_t; return *(kpp_t)(ka + 8 * i); }
enum { I_X = 0, I_C = 1, I_POS = 2, I_ADAW = 3, I_ADAB = 4, I_NORMG = 5, I_W13 = 6, I_W2 = 7, I_WIN = 8, I_LCW = 9, I_LCB = 10, I_LWA = 11, I_LBA = 12, I_LWX = 13, I_LBX = 14, I_LAM = 15,
       I_LOUT = 16, I_SCW = 17, I_SCOUT = 18, I_KVG = 19, I_UKV = 20, I_MLAO = 21, I_WO = 22, I_FING = 23 };
__device__ __forceinline__ float wave_sum(float v) {
#pragma unroll
    for (int o = 1; o < 64; o <<= 1) v += __shfl_xor(v, o);
    return v;
}
template <bool CB, bool F8 = false>
__device__ __forceinline__ void transpose_item(const float* W, int K, int N, bf16* WT, int dst_row0, int k0, int n0, const float* ks, LAS float* scr, int lane, const float* shp, float (&cbacc)[8], bool tiled = false, int ldk = 0) {
    float v[32];
    const GAS float* wp = (const GAS float*)W + (size_t)(k0 + (lane >> 5)) * N + n0 + (lane & 31);
#pragma unroll
    for (int i = 0; i < 32; ++i) { v[i] = *wp; wp += 2 * (size_t)N; asm volatile("" : "+v"(wp)); }
    if (CB) {
        LAS float* sht = scr + 64 * 33;
        float sv[8];
#pragma unroll
        for (int b = 0; b < 8; ++b) sv[b] = ((const GAS float*)shp)[(size_t)b * MODW + k0 + lane];
#pragma unroll
        for (int b = 0; b < 8; ++b) sht[(b * 2 + (lane & 1)) * 32 + (lane >> 1)] = sv[b];
        LDS_WAIT(); asm volatile("" ::: "memory");
#pragma unroll
        for (int b = 0; b < 8; ++b) { float a = 0.f;
#pragma unroll
            for (int i = 0; i < 32; ++i) a += sht[(b * 2 + (lane >> 5)) * 32 + i] * v[i];
            cbacc[b] += a; asm volatile("" ::: "memory"); }
    }
    if (ks) {
#pragma unroll
        for (int i = 0; i < 32; ++i) v[i] *= ks[k0 + 2 * i + (lane >> 5)]; }
#pragma unroll
    for (int i = 0; i < 32; ++i) scr[(2 * i + (lane >> 5)) * 33 + (lane & 31)] = v[i];
    LDS_WAIT(); asm volatile("" ::: "memory");
    const int c = lane & 7;
#pragma unroll
    for (int j = 0; j < 4; ++j) { const int n = (lane >> 3) + 8 * j; const LAS float* s = scr + (8 * c) * 33 + n;
        v4u o; o.x = pk2(s[0 * 33], s[1 * 33]); o.y = pk2(s[2 * 33], s[3 * 33]); o.z = pk2(s[4 * 33], s[5 * 33]); o.w = pk2(s[6 * 33], s[7 * 33]);
        const int rr = dst_row0 + n;
        if constexpr (F8) { unsigned w0 = 0, w1 = 0;
            w0 = __builtin_amdgcn_cvt_pk_fp8_f32(pg8::sat8(s[0 * 33] * 64.f), pg8::sat8(s[1 * 33] * 64.f), w0, false); w0 = __builtin_amdgcn_cvt_pk_fp8_f32(pg8::sat8(s[2 * 33] * 64.f), pg8::sat8(s[3 * 33] * 64.f), w0, true);
            w1 = __builtin_amdgcn_cvt_pk_fp8_f32(pg8::sat8(s[4 * 33] * 64.f), pg8::sat8(s[5 * 33] * 64.f), w1, false); w1 = __builtin_amdgcn_cvt_pk_fp8_f32(pg8::sat8(s[6 * 33] * 64.f), pg8::sat8(s[7 * 33] * 64.f), w1, true);
            *(GAS v2u*)((GAS unsigned char*)WT + (size_t)rr * (ldk ? ldk : K) + k0 + 8 * c) = (v2u){w0, w1}; } else {
        const size_t eo = tiled ? ((size_t)(rr >> 8) * (K >> 6) + (k0 >> 6)) * 16384 + (size_t)(rr & 255) * 64 + 8 * c : (size_t)rr * (ldk ? ldk : K) + k0 + 8 * c;
        *(GAS v4u*)(WT + eo) = o; } }
    LDS_WAIT(); asm volatile("" ::: "memory");
}
typedef float p0_f32x16 __attribute__((ext_vector_type(16)));
template <bool F8>
__device__ __forceinline__ void transpose_item_cb(const float* W, int K, int N, bf16* WT, int dst_row0, int k0, int n0, LAS unsigned* scr, int lane, const float* shp, p0_f32x16& acc) {
    const int h = lane >> 5, n = lane & 31;
    float v[32];
    const GAS float* wp = (const GAS float*)W + (size_t)(k0 + 32 * h) * N + n0 + n;
#pragma unroll
    for (int i = 0; i < 32; ++i) { v[i] = *wp; wp += (size_t)N; asm volatile("" : "+v"(wp)); }
    const GAS float* sp = (const GAS float*)shp + (size_t)(n & 7) * MODW + k0 + 32 * h;
    f32x4 sa[8];
#pragma unroll
    for (int j = 0; j < 8; ++j) sa[j] = *(const GAS f32x4*)(sp + 4 * j);
    const float msk = n < 8 ? 1.0f : 0.0f;
    unsigned w[16];
#pragma unroll
    for (int t = 0; t < 16; ++t) w[t] = pg8::cvt_pk_bf16(v[2 * t], v[2 * t + 1]);
#pragma unroll
    for (int j = 0; j < 4; ++j) { const f32x4 s0 = sa[2 * j] * msk, s1 = sa[2 * j + 1] * msk;
        v4u a; a.x = pg8::cvt_pk_bf16(s0[0], s0[1]); a.y = pg8::cvt_pk_bf16(s0[2], s0[3]); a.z = pg8::cvt_pk_bf16(s1[0], s1[1]); a.w = pg8::cvt_pk_bf16(s1[2], s1[3]);
        v4u b; b.x = w[4 * j]; b.y = w[4 * j + 1]; b.z = w[4 * j + 2]; b.w = w[4 * j + 3];
        acc = __builtin_amdgcn_mfma_f32_32x32x16_bf16(__builtin_bit_cast(bf16x8, a), __builtin_bit_cast(bf16x8, b), acc, 0, 0, 0); }
    if constexpr (F8) {
#pragma unroll
        for (int t = 0; t < 8; ++t) { unsigned x = 0; x = __builtin_amdgcn_cvt_pk_fp8_f32(pg8::sat8(v[4 * t] * 64.f), pg8::sat8(v[4 * t + 1] * 64.f), x, false); x = __builtin_amdgcn_cvt_pk_fp8_f32(pg8::sat8(v[4 * t + 2] * 64.f), pg8::sat8(v[4 * t + 3] * 64.f), x, true);
            scr[(8 * h + t) * 33 + n] = x; }
        LDS_WAIT(); asm volatile("" ::: "memory");
        const int c = lane & 3;
#pragma unroll
        for (int jj = 0; jj < 2; ++jj) { const int nn = (lane >> 2) + 16 * jj; const LAS unsigned* s = scr + (4 * c) * 33 + nn;
            v4u o; o.x = s[0]; o.y = s[33]; o.z = s[66]; o.w = s[99];
            *(GAS v4u*)((GAS unsigned char*)WT + (size_t)(dst_row0 + nn) * K + k0 + 16 * c) = o; }
    } else {
#pragma unroll
        for (int t = 0; t < 16; ++t) scr[(16 * h + t) * 33 + n] = w[t];
        LDS_WAIT(); asm volatile("" ::: "memory");
        const int c = lane & 7;
#pragma unroll
        for (int jj = 0; jj < 4; ++jj) { const int nn = (lane >> 3) + 8 * jj; const LAS unsigned* s = scr + (4 * c) * 33 + nn;
            v4u o; o.x = s[0]; o.y = s[33]; o.z = s[66]; o.w = s[99];
            *(GAS v4u*)(WT + (size_t)(dst_row0 + nn) * K + k0 + 8 * c) = o; }
    }
    LDS_WAIT(); asm volatile("" ::: "memory");
}
#ifndef W2_TILED
#define W2_TILED false
#endif
constexpr int TI_W13 = (D / 64) * (2 * DFF / 32), TI_W2 = (DFF / 64) * (D / 32), TI_WIN = (D / 64) * (INW / 32), TI_LRUO = (LW / 64) * (D / 32), TI_UKV = (KVR / 64) * (4096 / 32), TI_DD = (D / 64) * (D / 32), TI_WAX = 8 * 2 * 4;
constexpr int TH_W13 = TI_W13 / 4, TH_WIN = TI_WIN / 4, TH_LAYER = 2 * TH_W13 + TH_WIN;
constexpr int TL_LAYER = 2 * TI_W2 + 2 * TI_LRUO + TI_UKV + 2 * TI_DD + 2 * TI_WAX, TU_LAYER = TH_LAYER + TL_LAYER;
__device__ __forceinline__ void p0_weights(const Frame& F, int parts, bool dummy_cb = false) {
    LAS float* scr = (LAS float*)(F.lds + RING_OFF + F.wave * 16384);
    const int gw = F.vcu * NWAVES + F.wave, NGW = F.G * NWAVES;
    if (parts & 1)
    for (int it = gw; it < NL * TH_LAYER; it += NGW) {
        const int l = it / TH_LAYER; int r = it - l * TH_LAYER;
        GAS unsigned char* wl = F.ws + WS_W + (size_t)l * W_LAYER;
        const float* W; bf16* WT; int N, mode, site;
        if (r < 2 * TH_W13) { const int f = r / TH_W13; r -= f * TH_W13; W = in_ptr(I_W13) + (size_t)(l * 2 + f) * D * 2 * DFF; N = 2 * DFF; WT = (bf16*)(wl + WO_W13 + (size_t)f * 44 * MiB); mode = 1; site = f ? 2 : 0; }
        else { r -= 2 * TH_W13; W = in_ptr(I_WIN) + (size_t)l * D * INW; N = INW; WT = (bf16*)(wl + WO_WIN); mode = 2; site = 1; }
        bool f8 = (mode == 1) && (site == 2) && ((FP8_G4 >> l) & 1); int cbi;
        const int nblk = N / 32, kq = r / nblk, nb = r - kq * nblk, n0 = 32 * nb; int dst = n0;
        if (mode == 1) { const int bj = n0 >= DFF ? 1 : 0, j = n0 - bj * DFF; dst = 256 * (j >> 7) + 128 * bj + (j & 127); }
        else {
            if (FP8_ALL) { dst = n0 < 8704 ? n0 : (n0 < 8768 ? 14848 + (n0 - 8704) : 8704 + (n0 - 8768)); f8 = true; }
            else if (WIN_QF8) { if (n0 < 5120) dst = n0; else if (n0 < 8192) { dst = n0 - 5120; f8 = true; } else if (n0 < 8704) dst = 5120 + (n0 - 8192); else if (n0 < 8768) dst = 5632 + (n0 - 8704); else if (G1_BF16 && n0 >= 8768 + 2048 && n0 < 8768 + 4096) dst = WINB_PADEND + (n0 - 8768 - 2048); else if (G1_BF16 && n0 >= 8768 + 4096) { dst = 5120 + (n0 - 8768 - 4096); f8 = true; } else { dst = 3072 + (n0 - 8768); f8 = true; } }
            else { if (n0 < 8768) dst = n0; else { dst = n0 - 8768; f8 = true; } }
            if (f8) WT = (bf16*)(wl + WO_WIN8); }
        cbi = (mode == 2 && f8) ? WINB_ROWS + dst : dst;
        const float* shp = (const float*)(F.ws + WS_MOD) + (size_t)l * NB * MODW + (site == 0 ? 0 : site == 1 ? 6144 : 12288);
        p0_f32x16 cbacc;
#pragma unroll
        for (int r4 = 0; r4 < 16; ++r4) cbacc[r4] = 0.f;
        if (f8) {
#pragma unroll 1
            for (int j = 0; j < 4; ++j) transpose_item_cb<true>(W, D, N, WT, dst, 64 * (4 * kq + j), n0, (LAS unsigned*)scr, F.lane, shp, cbacc);
        } else {
#pragma unroll 1
            for (int j = 0; j < 4; ++j) transpose_item_cb<false>(W, D, N, WT, dst, 64 * (4 * kq + j), n0, (LAS unsigned*)scr, F.lane, shp, cbacc); }
        int* cbp = (int*)(F.ws + (dummy_cb ? WS_KN : WS_CB)) + (size_t)((l * 3 + site) * NB + 4 * (F.lane >> 5)) * CBW + cbi + (F.lane & 31);
#pragma unroll
        for (int r4 = 0; r4 < 4; ++r4) atomicAdd(cbp + (size_t)r4 * CBW, (int)__builtin_rintf(cbacc[r4] * pg8::CB_ENC));
    }
    if (parts & 2)
    for (int it = gw; it < NL * TL_LAYER; it += NGW) {
        const int l = it / TL_LAYER; int r = it - l * TL_LAYER;
        GAS unsigned char* wl = F.ws + WS_W + (size_t)l * W_LAYER;
        const float* W; bf16* WT; const float* ks = nullptr; int K, N, ldk = 0; float dummy[8]; bool tiled = false;
        bool f8w = false;
        if (r < 2 * TI_W2) { tiled = W2_TILED; const int f = r / TI_W2; r -= f * TI_W2; W = in_ptr(I_W2) + (size_t)(l * 2 + f) * DFF * D; K = DFF; N = D; WT = (bf16*)(wl + WO_W2 + (size_t)f * 22 * MiB); f8w = ((FP8_DN >> (2 * l + f)) & 1) != 0; }
        else if ((r -= 2 * TI_W2) < TI_LRUO) { W = in_ptr(I_LOUT) + (size_t)l * LW * D; K = LW; N = D; WT = (bf16*)(wl + WO_LRUO); ldk = YP; }
        else if ((r -= TI_LRUO) < TI_LRUO) { W = in_ptr(I_SCOUT) + (size_t)l * LW * D; K = LW; N = D; WT = (bf16*)(wl + WO_SCO); ldk = YP; }
        else if ((r -= TI_LRUO) < TI_UKV) { W = in_ptr(I_UKV) + (size_t)l * KVR * 4096; K = KVR; N = 4096; WT = (bf16*)(wl + WO_UKV); ks = in_ptr(I_KVG) + l * KVR; }
        else if ((r -= TI_UKV) < TI_DD) { W = in_ptr(I_MLAO) + (size_t)l * D * D; K = D; N = D; WT = (bf16*)(wl + WO_MLAO); ldk = YP; }
        else if ((r -= TI_DD) < TI_DD) { W = in_ptr(I_WO) + (size_t)l * D * D; K = D; N = D; WT = (bf16*)(wl + WO_WO); }
        else { r -= TI_DD; const int which = r / TI_WAX; r -= which * TI_WAX; const int g = r >> 3; r &= 7;
               W = in_ptr(which ? I_LWX : I_LWA) + ((size_t)l * 8 + g) * 16384; K = 128; N = 128; WT = (bf16*)(F.ws + WS_WAX) + ((size_t)(l * 2 + which) * 8 + g) * 16384; }
        const int nblk = N / 32, kb = r / nblk, nb = r - kb * nblk, n0 = 32 * nb;
        if (FP8_DN != 0 && f8w) transpose_item<false, true>(W, K, N, WT, n0, 64 * kb, n0, nullptr, scr, F.lane, nullptr, dummy);
        else transpose_item<false>(W, K, N, WT, n0, 64 * kb, n0, ks, scr, F.lane, nullptr, dummy, tiled, ldk);
    }
    if (parts & 2) { const int gt = (F.vcu * NWAVES + F.wave) * 64 + F.lane, NT = F.G * NWAVES * 64; constexpr int per = FP8_ALL ? 192 * D / 16 : (WINB_PADEND - WINB_REAL) * D * 2 / 16; constexpr size_t pbase = FP8_ALL ? WO_WIN8 + (size_t)14912 * D : WO_WIN + (size_t)WINB_REAL * D * 2;
      for (int i = gt; i < NL * per; i += NT) { const int l = i / per, j = i - l * per; *(GAS v4u*)(F.ws + WS_W + (size_t)l * W_LAYER + pbase + (size_t)j * 16) = (v4u){0u, 0u, 0u, 0u}; } }
    if (parts & 2) { const int gt = (F.vcu * NWAVES + F.wave) * 64 + F.lane, NT = F.G * NWAVES * 64; const int* pos = (const int*)in_ptr(I_POS); float* COS = (float*)(F.ws + WS_COS); float* SIN = (float*)(F.ws + WS_SIN);
      for (int i = gt; i < M * 32; i += NT) { const int row = i >> 5, j = i & 31; const float inv = __builtin_amdgcn_exp2f(-(float)j * (13.287712379549449f / 32.0f)); const float ang = (float)pos[row] * inv;
          const double t = (double)ang * 0.15915494309189535; const float fr = (float)(t - __builtin_rint(t)); COS[i] = __builtin_amdgcn_cosf(fr); SIN[i] = __builtin_amdgcn_sinf(fr); } }
}
__device__ __forceinline__ void p0_mod(const Frame& F) {
    LAS float* sc = (LAS float*)(F.lds + RING_OFF); LAS float* red = (LAS float*)(F.lds + RING_OFF + 65536);
    for (int i = F.tid; i < NB * D; i += NWAVES * 64) { const float c = in_ptr(I_C)[i]; sc[i] = c / (1.0f + __expf(-c)); }
    __syncthreads();
    float* MOD = (float*)(F.ws + WS_MOD);
    for (int task = blockIdx.x; task < NL * (MODW / 64); task += F.G) {
        const int l = task / (MODW / 64), cg = task - l * (MODW / 64);
        const float* Wp = in_ptr(I_ADAW) + ((size_t)l * D + 256 * F.wave) * MODW + 64 * cg + F.lane;
        float acc[8];
#pragma unroll
        for (int b = 0; b < 8; ++b) acc[b] = 0.f;
#pragma unroll 4
        for (int k4 = 0; k4 < 256; k4 += 4) {
            const float w0 = Wp[(size_t)(k4 + 0) * MODW], w1 = Wp[(size_t)(k4 + 1) * MODW], w2 = Wp[(size_t)(k4 + 2) * MODW], w3 = Wp[(size_t)(k4 + 3) * MODW];
#pragma unroll
            for (int b = 0; b < 8; ++b) { const f32x4 s4 = *(const LAS f32x4*)(sc + b * D + 256 * F.wave + k4); acc[b] += (s4[0] * w0 + s4[1] * w1) + (s4[2] * w2 + s4[3] * w3); }
        }
#pragma unroll
        for (int b = 0; b < 8; ++b) red[(F.wave * 8 + b) * 64 + F.lane] = acc[b];
        __syncthreads();
        { const int b = F.wave; float s = 0.f;
#pragma unroll
          for (int w = 0; w < 8; ++w) s += red[(w * 8 + b) * 64 + F.lane];
          MOD[((size_t)l * NB + b) * MODW + 64 * cg + F.lane] = s + in_ptr(I_ADAB)[(size_t)l * MODW + 64 * cg + F.lane]; }
        __syncthreads();
    }
}
__device__ __forceinline__ unsigned pk2h(float lo, float hi) { return pg8::pk2_f16(lo, hi); }
__device__ __forceinline__ void operand0_phase(const Frame& F, const float* xin, const float* g, const float* scale, bf16* out, pg8::ssq_t* ssq, bf16* xh) {
    const int gw = F.vcu * NWAVES + F.wave, NGW = F.G * NWAVES, rpw = (M + NGW - 1) / NGW;
    const int r0 = gw * rpw, r1 = (r0 + rpw < M) ? r0 + rpw : M;
    int curb = -1; f32x4 gp[8];
    for (int row = r0; row < r1; ++row) {
        const int b = row >> 11;
        if (b != curb) { curb = b;
#pragma unroll
            for (int j = 0; j < 8; ++j) { const f32x4 g4 = ((const f32x4*)g)[F.lane + 64 * j]; const f32x4 s4 = ((const f32x4*)(scale + (size_t)b * MODW))[F.lane + 64 * j]; gp[j] = g4 * (s4 + 1.0f); } }
        const f32x4* xr = (const f32x4*)(xin + (size_t)row * D) + F.lane;
        f32x4 v[8]; float ss = 0.f;
#pragma unroll
        for (int j = 0; j < 8; ++j) { v[j] = xr[64 * j]; ss += (v[j][0] * v[j][0] + v[j][1] * v[j][1]) + (v[j][2] * v[j][2] + v[j][3] * v[j][3]); }
        ss = wave_sum(ss); if (F.lane == 0) ssq[row] = pg8::ssq_enc(ss);
        unsigned long long* o8 = (unsigned long long*)(out + (size_t)row * D) + F.lane; unsigned long long* h8 = (unsigned long long*)(xh + (size_t)row * D) + F.lane;
#pragma unroll
        for (int j = 0; j < 8; ++j) { const f32x4 o = v[j] * gp[j]; o8[64 * j] = (unsigned long long)pk2(o[0], o[1]) | ((unsigned long long)pk2(o[2], o[3]) << 32);
            h8[64 * j] = (unsigned long long)pk2h(v[j][0], v[j][1]) | ((unsigned long long)pk2h(v[j][2], v[j][3]) << 32); }
    }
}
__device__ __forceinline__ void final_norm_phase(const Frame& F, const bf16* xh, float* out, const float* g) {
    const int gw = F.vcu * NWAVES + F.wave, NGW = F.G * NWAVES;
    f32x4 g4[8];
#pragma unroll
    for (int j = 0; j < 8; ++j) g4[j] = ((const f32x4*)g)[F.lane + 64 * j];
    for (int row = gw; row < M; row += NGW) {
        const unsigned long long* xr = (const unsigned long long*)(xh + (size_t)row * D) + F.lane; f32x4* orow = (f32x4*)(out + (size_t)row * D) + F.lane;
        f32x4 v[8]; float ss = 0.f;
#pragma unroll
        for (int j = 0; j < 8; ++j) { const unsigned long long hv = xr[64 * j]; const unsigned w0 = (unsigned)hv, w1 = (unsigned)(hv >> 32); v[j] = (f32x4){pg8::h_lo(w0), pg8::h_hi(w0), pg8::h_lo(w1), pg8::h_hi(w1)};
            ss += (v[j][0] * v[j][0] + v[j][1] * v[j][1]) + (v[j][2] * v[j][2] + v[j][3] * v[j][3]); }
        const float rinv = 1.0f / sqrtf(wave_sum(ss) * (1.0f / D) + EPS);
#pragma unroll
        for (int j = 0; j < 8; ++j) orow[64 * j] = v[j] * rinv * g4[j];
    }
}
__device__ __forceinline__ float softplus_f(float z) {
    const float zn = z > 0.f ? -z : z; const float x = __expf(zn); const float u = 1.0f + x; const float l1p = (u == 1.0f) ? x : __logf(u) * (x / (u - 1.0f));
    return (z > 0.f ? z : 0.f) + l1p; }
__device__ __forceinline__ void lru_unit(const Frame& F, int l, int gck, int g) {
    LAS unsigned char* xr = F.lds + RING_OFF;
    const bf16* X = (const bf16*)(F.ws + WS_LRUX);
    const size_t row0 = (size_t)gck * 128; const int ck = gck & 15;
    {
        const int c8 = F.tid & 15, tq = F.tid >> 4, ch0 = 128 * g + 8 * c8;
        float w[4][8], bias[8];
#pragma unroll
        for (int k = 0; k < 4; ++k) { const f32x4 a = *(const f32x4*)(in_ptr(I_LCW) + ((size_t)l * 4 + k) * LW + ch0), b = *(const f32x4*)(in_ptr(I_LCW) + ((size_t)l * 4 + k) * LW + ch0 + 4);
            w[k][0] = a[0]; w[k][1] = a[1]; w[k][2] = a[2]; w[k][3] = a[3]; w[k][4] = b[0]; w[k][5] = b[1]; w[k][6] = b[2]; w[k][7] = b[3]; }
        { const f32x4 a = *(const f32x4*)(in_ptr(I_LCB) + (size_t)l * LW + ch0), b = *(const f32x4*)(in_ptr(I_LCB) + (size_t)l * LW + ch0 + 4);
          bias[0] = a[0]; bias[1] = a[1]; bias[2] = a[2]; bias[3] = a[3]; bias[4] = b[0]; bias[5] = b[1]; bias[6] = b[2]; bias[7] = b[3]; }
        float xin[7][8];
#pragma unroll
        for (int i = 0; i < 7; ++i) { const int trow = 4 * tq + i - 3;
            if (128 * ck + trow >= 0) { const v4u raw = *(const GAS v4u*)(X + (size_t)((long)row0 + trow) * LW + ch0); unpack8(raw, xin[i]); }
            else {
#pragma unroll
                for (int e = 0; e < 8; ++e) xin[i][e] = 0.f; } }
#pragma unroll
        for (int j = 0; j < 4; ++j) { float o[8];
#pragma unroll
            for (int e = 0; e < 8; ++e) o[e] = bias[e] + (w[0][e] * xin[j][e] + w[1][e] * xin[j + 1][e]) + (w[2][e] * xin[j + 2][e] + w[3][e] * xin[j + 3][e]);
            *(LAS v4u*)(xr + (4 * tq + j) * 272 + 16 * c8) = pack8(o); }
    }
    __syncthreads();
    const int fr = F.lane & 15, fq = F.lane >> 4, ch = 16 * F.wave + fr, cg = 128 * g + ch;
    bf16x8 bwa[4], bwx[4];
    { const bf16* WA = (const bf16*)(F.ws + WS_WAX) + ((size_t)(l * 2 + 0) * 8 + g) * 16384 + (size_t)ch * 128 + 8 * fq;
      const bf16* WX = (const bf16*)(F.ws + WS_WAX) + ((size_t)(l * 2 + 1) * 8 + g) * 16384 + (size_t)ch * 128 + 8 * fq;
#pragma unroll
      for (int ks = 0; ks < 4; ++ks) { bwa[ks] = *(const bf16x8*)(WA + 32 * ks); bwx[ks] = *(const bf16x8*)(WX + 32 * ks); } }
    f32x4 accr[8], acci[8];
#pragma unroll
    for (int mt = 0; mt < 8; ++mt) { accr[mt] = (f32x4){0.f, 0.f, 0.f, 0.f}; acci[mt] = (f32x4){0.f, 0.f, 0.f, 0.f};
#pragma unroll
        for (int ks = 0; ks < 4; ++ks) { const bf16x8 a = *(const LAS bf16x8*)(xr + (16 * mt + fr) * 272 + (32 * ks + 8 * fq) * 2);
            accr[mt] = __builtin_amdgcn_mfma_f32_16x16x32_bf16(a, bwa[ks], accr[mt], 0, 0, 0);
            acci[mt] = __builtin_amdgcn_mfma_f32_16x16x32_bf16(a, bwx[ks], acci[mt], 0, 0, 0); } }
    const float ba = in_ptr(I_LBA)[(size_t)l * LW + cg], bx = in_ptr(I_LBX)[(size_t)l * LW + cg];
    const float Lc2 = -8.0f * 1.4426950408889634f * softplus_f(-in_ptr(I_LAM)[(size_t)l * LW + cg]);
    bf16* R = (bf16*)(F.ws + WS_R); bf16* GX = (bf16*)(F.ws + WS_GX);
    float At = 1.f, Bt = 0.f;
#pragma unroll
    for (int mt = 0; mt < 8; ++mt) { float A4 = 1.f, B4 = 0.f;
#pragma unroll
        for (int e = 0; e < 4; ++e) { const int tl = 16 * mt + 4 * fq + e;
            const float r = pg8::fast_sigmoid(accr[mt][e] + ba), ii = pg8::fast_sigmoid(acci[mt][e] + bx);
            const float xv = bf2f(*(const LAS unsigned short*)(xr + tl * 272 + ch * 2));
            const unsigned short rb = (unsigned short)f2bf(r), gb = (unsigned short)f2bf(ii * xv);
            R[(row0 + tl) * LW + cg] = rb; GX[(row0 + tl) * LW + cg] = gb;
            const float a = __builtin_amdgcn_exp2f(Lc2 * bf2f(rb)); const float bb = sqrtf(fmaxf(1.0f - a * a, 0.f)) * bf2f(gb);
            A4 = a * A4; B4 = a * B4 + bb; }
#pragma unroll
        for (int q = 0; q < 4; ++q) { const float Aq = __shfl(A4, fr + 16 * q), Bq = __shfl(B4, fr + 16 * q); Bt = Aq * Bt + Bq; At = Aq * At; } }
    if (fq == 0) { float* AGG = (float*)(F.ws + WS_AGG) + ((size_t)gck * LW + cg) * 2; AGG[0] = At; AGG[1] = Bt; }
    __syncthreads();
}
__device__ __forceinline__ void lru_scan_unit(const Frame& F, int l, int gck, int hf) {
    const int c = 512 * hf + F.tid, b = gck >> 4, ck = gck & 15;
    const float* AGG = (const float*)(F.ws + WS_AGG);
    float h = 0.f;
    for (int j = 0; j < ck; ++j) { const float2 ab = *(const float2*)(AGG + ((size_t)(b * 16 + j) * LW + c) * 2); h = ab.x * h + ab.y; }
    const float Lc2 = -8.0f * 1.4426950408889634f * softplus_f(-in_ptr(I_LAM)[(size_t)l * LW + c]);
    const bf16* R = (const bf16*)(F.ws + WS_R) + (size_t)gck * 128 * LW + c; const bf16* GX = (const bf16*)(F.ws + WS_GX) + (size_t)gck * 128 * LW + c;
    const bf16* GT = (const bf16*)(F.ws + WS_LRUG) + (size_t)gck * 128 * LW + c; bf16* Y = (bf16*)(F.ws + WS_YLRU) + (size_t)gck * 128 * YP + c;
    for (int t0 = 0; t0 < 128; t0 += 8) { unsigned short rr[8], gg[8], tt[8];
#pragma unroll
        for (int i = 0; i < 8; ++i) { rr[i] = R[(size_t)(t0 + i) * LW]; gg[i] = GX[(size_t)(t0 + i) * LW]; tt[i] = GT[(size_t)(t0 + i) * LW]; }
#pragma unroll
        for (int i = 0; i < 8; ++i) { const float a = __builtin_amdgcn_exp2f(Lc2 * bf2f(rr[i])); const float bb = sqrtf(fmaxf(1.0f - a * a, 0.f)) * bf2f(gg[i]); h = a * h + bb;
            Y[(size_t)(t0 + i) * YP] = (unsigned short)f2bf(h * bf2f(tt[i])); } }
}
__device__ __forceinline__ void sc_phase(const Frame& F, int l) {
    const int gt = (F.vcu * NWAVES + F.wave) * 64 + F.lane, NT = F.G * NWAVES * 64;
    const bf16* SB = (const bf16*)(F.ws + WS_SCB); const bf16* SC = (const bf16*)(F.ws + WS_SCC); const bf16* SX = (const bf16*)(F.ws + WS_SCX); bf16* Y = (bf16*)(F.ws + WS_YSC);
    for (int idx = gt; idx < (M / 8) * (LW / 8); idx += NT) {
        const int c8 = idx & 127, tg = idx >> 7, row0 = 8 * tg, s0 = row0 & (SEQ - 1), ch0 = 8 * c8;
        float w[3][8];
#pragma unroll
        for (int k = 0; k < 3; ++k) { const f32x4 a = *(const f32x4*)(in_ptr(I_SCW) + ((size_t)l * 3 + k) * LW + ch0), b = *(const f32x4*)(in_ptr(I_SCW) + ((size_t)l * 3 + k) * LW + ch0 + 4);
            w[k][0] = a[0]; w[k][1] = a[1]; w[k][2] = a[2]; w[k][3] = a[3]; w[k][4] = b[0]; w[k][5] = b[1]; w[k][6] = b[2]; w[k][7] = b[3]; }
        float cx[10][8];
#pragma unroll
        for (int i = 0; i < 10; ++i) {
            if (s0 + i - 2 >= 0) { float a[8], b[8]; unpack8(*(const GAS v4u*)(SC + (size_t)(row0 + i - 2) * LW + ch0), a); unpack8(*(const GAS v4u*)(SX + (size_t)(row0 + i - 2) * LW + ch0), b);
#pragma unroll
                for (int e = 0; e < 8; ++e) cx[i][e] = a[e] * b[e]; }
            else {
#pragma unroll
                for (int e = 0; e < 8; ++e) cx[i][e] = 0.f; } }
#pragma unroll
        for (int j = 0; j < 8; ++j) { float bb[8], o[8]; unpack8(*(const GAS v4u*)(SB + (size_t)(row0 + j) * LW + ch0), bb);
#pragma unroll
            for (int e = 0; e < 8; ++e) o[e] = bb[e] * ((w[0][e] * cx[j][e] + w[1][e] * cx[j + 1][e]) + w[2][e] * cx[j + 2][e]);
            *(GAS v4u*)(Y + (size_t)(row0 + j) * YP + ch0) = pack8(o); }
    }
}
__device__ __forceinline__ void rope8(bf16* p, const float* cs, const float* sn) {
    float x1[8], x2[8], o1[8], o2[8]; unpack8(*(const GAS v4u*)p, x1); unpack8(*(const GAS v4u*)(p + 32), x2);
    const f32x4 c0 = *(const f32x4*)cs, c1 = *(const f32x4*)(cs + 4), s0 = *(const f32x4*)sn, s1 = *(const f32x4*)(sn + 4);
#pragma unroll
    for (int e = 0; e < 8; ++e) { const float c = e < 4 ? c0[e & 3] : c1[e & 3], s = e < 4 ? s0[e & 3] : s1[e & 3]; o1[e] = x1[e] * c - x2[e] * s; o2[e] = x2[e] * c + x1[e] * s; }
    *(GAS v4u*)p = pack8(o1); *(GAS v4u*)(p + 32) = pack8(o2);
}
__device__ __forceinline__ void rope_phase(const Frame& F) {
    const int gt = (F.vcu * NWAVES + F.wave) * 64 + F.lane, NT = F.G * NWAVES * 64;
    const float* COS = (const float*)(F.ws + WS_COS); const float* SIN = (const float*)(F.ws + WS_SIN);
    bf16* Q = (bf16*)(F.ws + WS_Q); bf16* KP = (bf16*)(F.ws + WS_KPE);
    for (int idx = gt; idx < M * 16 * 4; idx += NT) { const int row = idx >> 6, hh = (idx >> 2) & 15, j = idx & 3;
        rope8(Q + (size_t)row * 3072 + hh * 192 + 128 + 8 * j, COS + (size_t)row * 32 + 8 * j, SIN + (size_t)row * 32 + 8 * j); }
    for (int idx = gt; idx < M * 4; idx += NT) { const int row = idx >> 2, j = idx & 3;
        rope8(KP + (size_t)row * 64 + 8 * j, COS + (size_t)row * 32 + 8 * j, SIN + (size_t)row * 32 + 8 * j); }
}
struct Args { const float* in[24]; float* out; unsigned char* ws; int ph_lo, ph_hi; };
#ifndef P0P
#define P0P 3
#endif
#ifndef REP_G2
#define REP_G2 1
#endif
#ifndef REP_G5
#define REP_G5 1
#endif
#ifndef SPLIT_ORDER
#define SPLIT_ORDER 1
#endif
#ifndef REP_PRO
#define REP_PRO 1
#endif
#ifndef REVK_FFN
#define REVK_FFN false
#endif
#ifndef ACT_TILED
#define ACT_TILED false
#endif
#ifndef G3P
#define G3P 3
#endif
#ifndef REP_ATT
#define REP_ATT 1
#endif
#ifndef REP_BAR
#define REP_BAR 1
#endif
#ifndef PH_MASK
#define PH_MASK 0xFFFFu
#endif
#define EN(j) (((PH_MASK) >> (j)) & 1u)
__global__ void __launch_bounds__(NWAVES * 64, 2) hybrid_fwd(Args args) {
    extern __shared__ __attribute__((aligned(16))) unsigned char lds[];
    Frame F;
    F.lds = (LAS unsigned char*)lds;
    F.MISC = (volatile LAS unsigned*)(F.lds + MISC_OFF);
    F.tid = threadIdx.x; F.lane = F.tid & 63; F.wave = __builtin_amdgcn_readfirstlane(F.tid >> 6);
    F.G = gridDim.x; { const int bx = blockIdx.x; F.vcu = (F.G % 8 == 0) ? (bx % 8) * (F.G / 8) + bx / 8 : bx; }
    F.out = nullptr; F.ws = nullptr; F.ctl = (gu32*)(args.ws + WS_CTL);
    for (int u = F.tid; u < (LDS_BYTES - LDSCTL_OFF) / 4; u += NWAVES * 64) ((LAS unsigned*)(F.lds + LDSCTL_OFF))[u] = 0u;
    __syncthreads();
    XcdBarrier bar; bar.bar = (unsigned*)(F.ctl + CW_BAR); bar.x = 0; bar.st = nullptr;
    if (MK_N_LAUNCHES == 1) bar = xcd_barrier_post((unsigned*)(F.ctl + CW_BAR), F.MISC + 8);
    const int lo = args.ph_lo, hi = args.ph_hi;
#define IN(k) (lo <= (k) && (k) < hi)
#define PHASE_FRAME() Frame P = F; { unsigned m1_ = ~0u; asm volatile("" : "+s"(m1_)); int t_ = F.wave * 64 + (int)__builtin_amdgcn_mbcnt_hi(m1_, __builtin_amdgcn_mbcnt_lo(m1_, 0u)); asm volatile("" : "+v"(t_)); P.tid = t_; P.lane = t_ & 63; P.out = (GAS float*)karg_ptr(24); P.ws = karg_ptr(25); }
#define SEAM(k) do { if (IN(k) && IN((k) + 1)) { if (MK_N_LAUNCHES == 1) { for (int rb_ = 0; rb_ < REP_BAR; ++rb_) { XcdBarrier b_ = bar; GAS unsigned* bp_ = (GAS unsigned*)bar.bar; asm volatile("" : "+s"(bp_)); b_.bar = (unsigned*)bp_; xcd_barrier(b_); } }     } } while (0)
#define HN ((bf16*)(P.ws + WS_HN))
#define XH ((bf16*)(P.ws + WS_XH))
#define A8 ((unsigned char*)(P.ws + WS_A8))
#define ACT ((bf16*)(P.ws + WS_ACT))
#define MERGED ((bf16*)(P.ws + WS_MERGED))
#define ring (F.lds + RING_OFF)
#define MODL(l_) ((const float*)(P.ws + WS_MOD) + (size_t)(l_) * NB * MODW)
#define NORMG(l_, s_) (in_ptr(I_NORMG) + ((size_t)(l_) * 3 + (s_)) * D)
#define SSQN(l_, s_) ((pg8::ssq_t*)(P.ws + WS_SSQN) + ((size_t)(l_) * 3 + (s_)) * M)
#define CBV(l_, s_) ((const int*)(P.ws + WS_CB) + ((size_t)(l_) * 3 + (s_)) * NB * CBW)

    if (EN(12) && IN(0)) { PHASE_FRAME(); p0_mod(P); p0_weights(P, 2);
        for (int i = P.vcu * (NWAVES * 64) + P.tid; i < NL * 4 * M; i += P.G * (NWAVES * 64)) ((GAS pg8::ssq_t*)(P.ws + WS_SSQN))[i] = 0ull;
        SEAM(0); }
    if (EN(13) && IN(1)) { PHASE_FRAME(); if (P0P & 1) for (int rep_ = 0; rep_ < REP_PRO; ++rep_) { p0_weights(P, 1, rep_ + 1 < REP_PRO); __syncthreads(); } if (P0P & 2) operand0_phase(P, in_ptr(I_X), NORMG(0, 0), MODL(0) + 2048, HN, SSQN(0, 0), XH); SEAM(1); }

    for (int l = 0; l < NL; ++l) {
        const int pb = 2 + PPL * l;
#define wl (P.ws + WS_W + (size_t)l * W_LAYER)
#define mod MODL(l)
#define xin0 ((l == 0) ? in_ptr(I_X) : (const float*)P.out)
#define ssq ((pg8::ssq_t*)(P.ws + WS_SSQ) + (size_t)l * M)
#define UP_CALL(F8IN, O8, Wp, SITE) do { pg8::Gemm g{(F8IN) ? (const bf16*)A8 : (const bf16*)HN, (const bf16*)(Wp), M, 2 * DFF, (F8IN) ? D / 2 : D}; \
            pg8::EpiSwiglu<ACT_TILED, (O8)> E{ACT, DFF, SSQN(l, SITE), CBV(l, SITE), CBW, EPS, (F8IN) ? 1.0f / 64.0f : 1.0f}; \
            pg8::gemm_phase<pg8::EpiSwiglu<ACT_TILED, (O8)>, pg8::StaticOrder, true, true, false, false, false, (F8IN)>(ring, g, S, E, P.wave); } while (0)
        if (EN(0) && IN(pb + 0)) { PHASE_FRAME(); pg8::StaticOrder S; S.init(M, 2 * DFF, P.G, (int)blockIdx.x);
            constexpr bool o0 = fp8_dn(0, 0), o1 = fp8_dn(1, 0);
            if (o0 == o1) UP_CALL(false, o0, wl + WO_W13, 0); else if (l == 0) UP_CALL(false, o0, wl + WO_W13, 0); else UP_CALL(false, o1, wl + WO_W13, 0);
            SEAM(pb + 0); }
#define DN_SC(F8) ((F8) ? 1.0f / (64.0f * pg8::ACT8_SC) : 1.0f)
#define G2_CALL(F8) do { pg8::Gemm g{ACT, (const bf16*)(wl + WO_W2), M, D, (F8) ? DFF / 2 : DFF}; pg8::EpiResid<true, true> E{XH, mod + 4096, HN, NORMG(l, 1), mod + 8192, SSQN(l, 1), A8, MODW, 0.5f * DN_SC(F8)}; \
            pg8::gemm_phase<pg8::EpiResid<true, true>, pg8::PanelOrder, true, true, false, false, false, (F8)>(ring, g, S, E, P.wave); } while (0)
        if (EN(1) && IN(pb + 1)) { PHASE_FRAME(); pg8::PanelOrder S; S.init(P.G, (int)blockIdx.x);
            constexpr bool d0 = fp8_dn(0, 0), d1 = fp8_dn(1, 0);
            if (d0 == d1) G2_CALL(d0); else if (l == 0) G2_CALL(d0); else G2_CALL(d1);
            SEAM(pb + 1); }
        if (EN(2) && IN(pb + 2)) { PHASE_FRAME();
            if (G3P & 1) {
                pg8::Gemm g{(const bf16*)A8, (const bf16*)(wl + WO_WIN8), M, WINF_ROWS, D / 2}; pg8::StaticOrder S; S.init(M, WINF_ROWS, P.G, (int)blockIdx.x);
                pg8::EpiWin<(FP8_ALL ? 2 : 1), (bool)WIN_QF8> E{(bf16*)(P.ws + WS_LRUX), (bf16*)(P.ws + WS_LRUG), (bf16*)(P.ws + WS_SCB), (bf16*)(P.ws + WS_SCC), (bf16*)(P.ws + WS_SCX), (bf16*)(P.ws + WS_Q), (bf16*)(P.ws + WS_KVLAT), (bf16*)(P.ws + WS_GATES), (bf16*)(P.ws + WS_KPE), ssq, SSQN(l, 1), CBV(l, 1), CBW, EPS};
                pg8::gemm_phase<pg8::EpiWin<(FP8_ALL ? 2 : 1), (bool)WIN_QF8>, pg8::StaticOrder, true, true, false, false, false, true>(ring, g, S, E, P.wave); }
            if ((G3P & 2) && !FP8_ALL) {
                pg8::Gemm g{HN, (const bf16*)(wl + WO_WIN), M, WINB_ROWS, D}; pg8::StaticOrder S; S.init(M, WINB_ROWS, P.G, (int)blockIdx.x);
                pg8::EpiWin<0, (bool)WIN_QF8> E{(bf16*)(P.ws + WS_LRUX), (bf16*)(P.ws + WS_LRUG), (bf16*)(P.ws + WS_SCB), (bf16*)(P.ws + WS_SCC), (bf16*)(P.ws + WS_SCX), (bf16*)(P.ws + WS_Q), (bf16*)(P.ws + WS_KVLAT), (bf16*)(P.ws + WS_GATES), (bf16*)(P.ws + WS_KPE), ssq, SSQN(l, 1), CBV(l, 1), CBW, EPS};
                pg8::gemm_phase<pg8::EpiWin<0, (bool)WIN_QF8>, pg8::StaticOrder, true, true>(ring, g, S, E, P.wave); }
            SEAM(pb + 2); }
        if (EN(3) && IN(pb + 3)) { PHASE_FRAME();
#define KV_GEMM() do { pg8::Gemm g{(const bf16*)(P.ws + WS_KVLAT), (const bf16*)(wl + WO_UKV), M, 4096, KVR}; pg8::StaticOrder S; S.init(M, 4096, P.G, (int)blockIdx.x); \
              pg8::EpiKV E{(bf16*)(P.ws + WS_KN), (bf16*)(P.ws + WS_V), ssq, EPS}; pg8::gemm_phase<pg8::EpiKV, pg8::StaticOrder, true, true>(ring, g, S, E, P.wave); } while (0)
            const bool gemm_first = SPLIT_ORDER && (((blockIdx.x >> 3) & 1) != 0);
            if (gemm_first) KV_GEMM();
            for (int u = P.vcu; u < 128 * 8; u += P.G) lru_unit(P, l, u >> 3, u & 7);
            sc_phase(P, l);
            rope_phase(P);
            if (!gemm_first) KV_GEMM();
            SEAM(pb + 3);
        }
        if (EN(4) && IN(pb + 4)) { PHASE_FRAME();
            for (int u = P.vcu; u < 128 * 2; u += P.G) lru_scan_unit(P, l, u >> 1, u & 1);
            for (int rep_ = 0; rep_ < REP_ATT; ++rep_)
            for (int item = P.vcu; item < 256; item += P.G) { const int bh = item >> 1, s = item & 1;
#pragma unroll 1
                for (int i = 0; i < 4; ++i) { const int base = 2 * s + (i >> 1), qb = (i & 1) ? 7 - base : base;
                    att::attn_unit(bh >> 4, bh & 15, qb, (const bf16*)(P.ws + WS_Q), (const bf16*)(P.ws + WS_KN), (const bf16*)(P.ws + WS_KPE), (const bf16*)(P.ws + WS_V), (bf16*)(P.ws + WS_ATT), (LAS char*)ring, P.wave); } }
            __syncthreads();
            SEAM(pb + 4);
        }
        if (EN(5) && IN(pb + 5)) { PHASE_FRAME();
            pg8::PanelOrder S; S.init(P.G, (int)blockIdx.x); const bf16* GT = (const bf16*)(P.ws + WS_GATES);
#ifndef MERGE3
#define MERGE3 1
#endif
            if (MERGE3) { pg8::Gemm g{(const bf16*)(P.ws + WS_YCAT), (const bf16*)(wl + WO_WCAT), M, D, YP}; pg8::EpiMerge3 E{MERGED, (const unsigned char*)GT, 6144}; static_assert(GATES_U8 && MERGE3, "the u8 gate store is read by the fused merge GEMM only"); pg8::gemm_phase<pg8::EpiMerge3, pg8::PanelOrder, true, true>(ring, g, S, E, P.wave); }
            else {
            { pg8::Gemm g{(const bf16*)(P.ws + WS_YLRU), (const bf16*)(wl + WO_LRUO), M, D, LW, YP}; pg8::EpiMerge<true> E{MERGED, GT, 6144}; pg8::gemm_phase<pg8::EpiMerge<true>, pg8::PanelOrder, true, true>(ring, g, S, E, P.wave); }
            { pg8::Gemm g{(const bf16*)(P.ws + WS_YSC), (const bf16*)(wl + WO_SCO), M, D, LW, YP}; pg8::EpiMerge<false> E{MERGED, GT + 2048, 6144}; pg8::gemm_phase<pg8::EpiMerge<false>, pg8::PanelOrder, true, true>(ring, g, S, E, P.wave); }
            { pg8::Gemm g{(const bf16*)(P.ws + WS_ATT), (const bf16*)(wl + WO_MLAO), M, D, D, YP}; pg8::EpiMerge<false> E{MERGED, GT + 4096, 6144}; pg8::gemm_phase<pg8::EpiMerge<false>, pg8::PanelOrder, true, true>(ring, g, S, E, P.wave); }
            }
            SEAM(pb + 5);
        }
        if (EN(6) && IN(pb + 6)) { PHASE_FRAME(); pg8::Gemm g{MERGED, (const bf16*)(wl + WO_WO), M, D, D}; pg8::PanelOrder S; S.init(P.G, (int)blockIdx.x);
            pg8::EpiResid<true, (FP8_G4 != 0)> E{XH, mod + 10240, HN, NORMG(l, 2), mod + 14336, SSQN(l, 2), A8, MODW, 1.0f}; pg8::gemm_phase<pg8::EpiResid<true, (FP8_G4 != 0)>, pg8::PanelOrder, true, true>(ring, g, S, E, P.wave); SEAM(pb + 6); }
        if (EN(7) && IN(pb + 7)) { PHASE_FRAME(); pg8::StaticOrder S; S.init(M, 2 * DFF, P.G, (int)blockIdx.x);
            constexpr bool u0 = (FP8_G4 & 1) != 0, u1 = (FP8_G4 & 2) != 0, o0 = fp8_dn(0, 1), o1 = fp8_dn(1, 1);
            if (u0 == u1 && o0 == o1) UP_CALL(u0, o0, wl + WO_W13 + 44 * MiB, 2); else if (l == 0) UP_CALL(u0, o0, wl + WO_W13 + 44 * MiB, 2); else UP_CALL(u1, o1, wl + WO_W13 + 44 * MiB, 2);
            SEAM(pb + 7); }
        if (EN(8) && IN(pb + 8)) { PHASE_FRAME(); pg8::PanelOrder S; S.init(P.G, (int)blockIdx.x); static_assert(NL == 2, "per-layer fp8 flags are written out for two layers");
            if (l + 1 < NL) { constexpr bool f8 = fp8_dn(0, 1); pg8::Gemm g{ACT, (const bf16*)(wl + WO_W2 + 22 * MiB), M, D, f8 ? DFF / 2 : DFF};
                pg8::EpiResid<true> E{XH, mod + 16384, HN, NORMG(l + 1, 0), MODL(l + 1) + 2048, SSQN(l + 1, 0), nullptr, MODW, 0.5f * DN_SC(f8)}; pg8::gemm_phase<pg8::EpiResid<true>, pg8::PanelOrder, true, true, false, false, false, f8>(ring, g, S, E, P.wave); }
            else { constexpr bool f8 = fp8_dn(1, 1); pg8::Gemm g{ACT, (const bf16*)(wl + WO_W2 + 22 * MiB), M, D, f8 ? DFF / 2 : DFF};
                if (REP_G5 > 1) { pg8::EpiNull E0{(float*)(P.ws + WS_AGG)}; pg8::gemm_phase<pg8::EpiNull, pg8::PanelOrder, true, true, false, false, false, f8>(ring, g, S, E0, P.wave); }
                pg8::EpiResid<false> E{XH, mod + 16384, nullptr, nullptr, nullptr, nullptr, nullptr, MODW, 0.5f * DN_SC(f8)}; pg8::gemm_phase<pg8::EpiResid<false>, pg8::PanelOrder, true, true, false, false, false, f8>(ring, g, S, E, P.wave); }
            SEAM(pb + 8); }
    }
    if (EN(14) && IN(N_PHASES - 1)) { PHASE_FRAME(); final_norm_phase(P, XH, (float*)P.out, in_ptr(I_FING)); }
#undef IN
#undef SEAM
#undef HN
#undef XH
#undef A8
#undef ACT
#undef MERGED
#undef ring
#undef wl
#undef mod
#undef xin0
#undef ssq
}

extern "C" void kernel_launch(void* const* d_in, const int* in_sizes, int n_in, void* d_out, int out_size, void* d_ws, size_t ws_size, hipStream_t stream) {
    static int grid = 0;
    if (grid == 0) {
        if (n_in != 24 || in_sizes[0] != M * D || out_size != M * D || ws_size < WS_END) { fprintf(stderr, "kernel_launch: shape/workspace mismatch (n_in %d, in0 %d, out %d, ws %zu < %zu); nothing launched\n", n_in, n_in > 0 ? in_sizes[0] : -1, out_size, ws_size, (size_t)WS_END); grid = -1; return; }
        int dev = 0, cus = 0, per_cu = 0;
        if (hipGetDevice(&dev) != hipSuccess || hipDeviceGetAttribute(&cus, hipDeviceAttributeMultiprocessorCount, dev) != hipSuccess) { fprintf(stderr, "kernel_launch: device query failed\n"); grid = -1; return; }
        if (hipFuncSetAttribute((const void*)hybrid_fwd, hipFuncAttributeMaxDynamicSharedMemorySize, LDS_BYTES) != hipSuccess) { fprintf(stderr, "kernel_launch: hipFuncSetAttribute failed\n"); grid = -1; return; }
        if (hipOccupancyMaxActiveBlocksPerMultiprocessor(&per_cu, (const void*)hybrid_fwd, NWAVES * 64, LDS_BYTES) != hipSuccess || per_cu < 1) fprintf(stderr, "kernel_launch: note: occupancy query reports %d workgroups per CU\n", per_cu);
        (void)hipGetLastError();
        grid = cus;
    }
    if (grid < 0) return;
    if (hipMemsetAsync((char*)d_ws + WS_CTL, 0, CTL_ZERO_BYTES, stream) != hipSuccess) { fprintf(stderr, "kernel_launch: hipMemsetAsync failed\n"); return; }
    Args a{};
    for (int i = 0; i < 24; ++i) a.in[i] = (const float*)d_in[i];
    a.out = (float*)d_out; a.ws = (unsigned char*)d_ws;
#if MK_N_LAUNCHES == 1
    a.ph_lo = 0; a.ph_hi = N_PHASES;
    hipLaunchKernelGGL(hybrid_fwd, dim3(grid), dim3(NWAVES * 64), LDS_BYTES, stream, a);
#else
    for (int p = 0; p < N_PHASES; ++p) { a.ph_lo = p; a.ph_hi = p + 1; hipLaunchKernelGGL(hybrid_fwd, dim3(grid), dim3(NWAVES * 64), LDS_BYTES, stream, a); }
#endif
    const hipError_t le = hipPeekAtLastError();
    if (le != hipSuccess) fprintf(stderr, "kernel_launch: launch failed: %s\n", hipGetErrorName(le));
}
```

```cpp
#include <hip/hip_runtime.h>
#include <cstdio>
#include <cstdint>
#define MK_N_LAUNCHES 1
#define G1_BF16 0
#define FP8_G4 3
#ifndef G1_BF16
#define G1_BF16 1
#endif
#ifndef GATES_U8
#define GATES_U8 1
#endif
namespace pg8 {
#define PG8_LAS __attribute__((address_space(3)))
typedef unsigned short bf16_t;
typedef short bf16x8 __attribute__((ext_vector_type(8)));
typedef float f32x4 __attribute__((ext_vector_type(4)));
typedef unsigned u32x4 __attribute__((ext_vector_type(4)));
typedef int v4i_t __attribute__((ext_vector_type(4)));
typedef int v8i_t __attribute__((ext_vector_type(8)));
constexpr int BM = 256, BK = 64, HALF = 128, HTB = HALF * BK * 2  , STAGE_BYTES = 8 * HTB, NXCD = 8, WGM = 8;

__host__ __device__ __forceinline__ int lds_byte(int r, int c) { const int st = (r >> 4) * 2 + (c >> 5), rr = r & 15, cc = c & 31, ob = rr * 64 + cc * 2; return st * 1024 + (ob ^ (((ob >> 9) & 1) << 5)); }
__host__ __device__ __forceinline__ void stage_rc(int b, int& R, int& C) { const int st = b / 1024, sb = b % 1024, swz = sb ^ (((sb >> 9) & 1) << 5); R = (st >> 1) * 16 + swz / 64; C = (st & 1) * 32 + (swz % 64) / 2; }
__host__ __device__ __forceinline__ int perm32(int rho) { const int n = rho >> 4, i = rho & 15; return 8 * (i >> 2) + 4 * n + (i & 3); }

template <class E> struct has_mid { static constexpr bool value = false; };
struct Unit { int pm, pn; };
struct Gemm { const bf16_t* A; const bf16_t* Bt; int M, N, K; int ld = 0; };

struct StaticOrder {
    int nM, nN, nwg, G, c;
    __host__ __device__ void init(int M, int N, int G_, int c_) { nM = M / BM; nN = N / BM; nwg = nM * nN; G = G_; c = c_; }
    __host__ __device__ bool next(int i, Unit& u) const {
        const long L = (long)i * G + c; if (L >= nwg) return false;
        int wgid = (int)L; { const int q = nwg / NXCD, r = nwg % NXCD, xcd = wgid % NXCD, off = wgid / NXCD; wgid = (xcd < r ? xcd * (q + 1) : r * (q + 1) + (xcd - r) * q) + off; }
        const int nig = WGM * nN, gid = wgid / nig, fm = gid * WGM, gsz = (nM - fm) < WGM ? (nM - fm) : WGM;
        u.pm = fm + ((wgid % nig) % gsz); u.pn = (wgid % nig) / gsz; return true;
    }
    __device__ __forceinline__ void a_ready(const Unit&) const {}
    __device__ __forceinline__ void done(const Unit&) const {}
};

__device__ __forceinline__ unsigned cvt_pk_bf16(float lo, float hi) { unsigned r; asm volatile("v_cvt_pk_bf16_f32 %0, %1, %2" : "=v"(r) : "v"(lo), "v"(hi)); return r; }
typedef float f32x2 __attribute__((ext_vector_type(2)));
struct PanelOrder {
    int G, c;
    __host__ __device__ void init(int G_, int c_) { G = G_; c = c_; }
    __host__ __device__ bool next(int i, Unit& u) const { const long L = (long)i * G + c; if (L >= 512) return false; const int x = (int)(L & 7), j = (int)(L >> 3); u.pm = 8 * x + (j >> 3); u.pn = j & 7; return true; }
    __device__ __forceinline__ void a_ready(const Unit&) const {}
    __device__ __forceinline__ void done(const Unit&) const {}
};
typedef unsigned u32x2 __attribute__((ext_vector_type(2)));
__device__ __forceinline__ float fast_sigmoid(float x) { return __builtin_amdgcn_rcpf(1.0f + __builtin_amdgcn_exp2f(-1.4426950408889634f * x)); }
__device__ __forceinline__ float gelu_tanh(float x) { return x * fast_sigmoid(1.5957691216057308f * (x + 0.044715f * x * x * x)); }
__device__ __forceinline__ u32x4 pack8_bf16(const f32x4 a, const f32x4 b) { u32x4 w; w.x = cvt_pk_bf16(a[0], a[1]); w.y = cvt_pk_bf16(a[2], a[3]); w.z = cvt_pk_bf16(b[0], b[1]); w.w = cvt_pk_bf16(b[2], b[3]); return w; }
__device__ __forceinline__ void unpack8_bf16(const u32x4 w, f32x4& a, f32x4& b) {
    a[0] = __uint_as_float(w.x << 16); a[1] = __uint_as_float(w.x & 0xffff0000u); a[2] = __uint_as_float(w.y << 16); a[3] = __uint_as_float(w.y & 0xffff0000u);
    b[0] = __uint_as_float(w.z << 16); b[1] = __uint_as_float(w.z & 0xffff0000u); b[2] = __uint_as_float(w.w << 16); b[3] = __uint_as_float(w.w & 0xffff0000u); }

struct EpiNull {
    static constexpr bool PERM = true, AFTER_DRAIN = false; float* sink;
    __device__ __forceinline__ void operator()(f32x4 (&acc)[2][2][4][2], const Unit& u, int wr, int wc, int fr, int fq) const {
        float t = 0.f;
#pragma unroll
        for (int ai = 0; ai < 2; ++ai)
#pragma unroll
            for (int bj = 0; bj < 2; ++bj)
#pragma unroll
                for (int m = 0; m < 4; ++m)
#pragma unroll
                    for (int n = 0; n < 2; ++n) t += acc[ai][bj][m][n][0] + acc[ai][bj][m][n][3];
        if (t == 123456.75f) sink[0] = t; }
};
typedef unsigned long long ssq_t;
typedef int i32x4 __attribute__((ext_vector_type(4)));
__device__ __forceinline__ ssq_t ssq_enc(float t) { return (ssq_t)(t * 16777216.0f); }
__device__ __forceinline__ float ssq_dec(ssq_t v) { return (float)(unsigned)(v >> 32) * 256.0f + (float)(unsigned)v * (1.0f / 16777216.0f); }
__device__ __forceinline__ void ssq_add(ssq_t* p, float t) { atomicAdd(p, ssq_enc(t)); }
constexpr float CB_ENC = 1048576.0f, CB_DEC = 1.0f / 1048576.0f;
__device__ __forceinline__ f32x4 cb_ld4(const int* p) { return __builtin_convertvector(*(const i32x4*)p, f32x4) * CB_DEC; }
__device__ __forceinline__ float sat8(float x) { return __builtin_amdgcn_fmed3f(x, -448.0f, 448.0f); }
__device__ __forceinline__ u32x2 pack8_fp8(const f32x4 a, const f32x4 b) {
    unsigned w0 = 0, w1 = 0; w0 = __builtin_amdgcn_cvt_pk_fp8_f32(sat8(a[0]), sat8(a[1]), w0, false); w0 = __builtin_amdgcn_cvt_pk_fp8_f32(sat8(a[2]), sat8(a[3]), w0, true);
    w1 = __builtin_amdgcn_cvt_pk_fp8_f32(sat8(b[0]), sat8(b[1]), w1, false); w1 = __builtin_amdgcn_cvt_pk_fp8_f32(sat8(b[2]), sat8(b[3]), w1, true); return (u32x2){w0, w1}; }
constexpr float A8_CLIP = 6.0f;
__device__ __forceinline__ float a8_rms(ssq_t prev) { return __builtin_sqrtf(ssq_dec(prev) * (1.0f / 2048.0f) + 1e-20f); }
__device__ __forceinline__ float a8_scale(ssq_t prev) { return a8_rms(prev) * (A8_CLIP / 127.0f); }
__device__ __forceinline__ float a8_inv(ssq_t prev) { return (127.0f / A8_CLIP) * __builtin_amdgcn_rcpf(a8_rms(prev)); }
__device__ __forceinline__ unsigned pk4_i8(float a, float b, float c, float d) {
    unsigned w = 0u;
    w = __builtin_amdgcn_cvt_pk_u8_f32(__builtin_amdgcn_fmed3f(__builtin_rintf(a), -127.0f, 127.0f) + 128.0f, 0, w); w = __builtin_amdgcn_cvt_pk_u8_f32(__builtin_amdgcn_fmed3f(__builtin_rintf(b), -127.0f, 127.0f) + 128.0f, 1, w);
    w = __builtin_amdgcn_cvt_pk_u8_f32(__builtin_amdgcn_fmed3f(__builtin_rintf(c), -127.0f, 127.0f) + 128.0f, 2, w); w = __builtin_amdgcn_cvt_pk_u8_f32(__builtin_amdgcn_fmed3f(__builtin_rintf(d), -127.0f, 127.0f) + 128.0f, 3, w);
    return w ^ 0x80808080u; }
__device__ __forceinline__ u32x2 pack8_i8(const f32x4 a, const f32x4 b) { return (u32x2){pk4_i8(a[0], a[1], a[2], a[3]), pk4_i8(b[0], b[1], b[2], b[3])}; }
__device__ __forceinline__ f32x4 i2f(const f32x4 bits) { return __builtin_convertvector(__builtin_bit_cast(i32x4, bits), f32x4); }
constexpr float ACT8_SC = 8.0f;
template <bool TILED, bool O8 = false, bool I8IN = false> struct EpiSwiglu {
    static constexpr bool PERM = true, AFTER_DRAIN = false;
    bf16_t* O; int ldc; const ssq_t* ssq; const int* cb; int cbstride; float eps; float dsc; const ssq_t* ssqp; const float* wsc;
    __device__ __forceinline__ void operator()(f32x4 (&acc)[2][2][4][2], const Unit& u, int wr, int wc, int fr, int fq) const {
        const int row0 = u.pm * BM + wr * 64 + fr, lc = wc * 32 + 8 * fq, col0 = u.pn * HALF + lc;
        const int* cbp = cb + (size_t)(u.pm >> 3) * cbstride + u.pn * BM + lc;
        f32x4 cv[2][2];
#pragma unroll
        for (int bj = 0; bj < 2; ++bj)
#pragma unroll
            for (int n = 0; n < 2; ++n) cv[bj][n] = cb_ld4(cbp + bj * HALF + 4 * n);
#pragma unroll
        for (int ai = 0; ai < 2; ++ai)
#pragma unroll
            for (int m = 0; m < 4; ++m) { const int row = row0 + ai * HALF + m * 16;
                bf16_t* rowp = TILED ? O + ((size_t)u.pm * (ldc / 64) + 2 * u.pn + (wc >> 1)) * (BM * 64) + (size_t)(row - u.pm * BM) * 64 + (wc & 1) * 32 + 8 * fq
                                    : O + (size_t)row * ldc + col0;
                float ri = __builtin_amdgcn_rsqf(ssq_dec(ssq[row]) * (1.0f / 2048.0f) + eps) * dsc;
                if constexpr (I8IN) { ri *= a8_scale(ssqp[row]) * wsc[0];
#pragma unroll
                    for (int bj = 0; bj < 2; ++bj)
#pragma unroll
                        for (int n = 0; n < 2; ++n) acc[ai][bj][m][n] = i2f(acc[ai][bj][m][n]); }
                f32x4 r0, r1;
#pragma unroll
                for (int e = 0; e < 4; ++e) { const float g0 = acc[ai][0][m][0][e] * ri + cv[0][0][e], g1 = acc[ai][0][m][1][e] * ri + cv[0][1][e];
                    r0[e] = g0 * fast_sigmoid(g0) * (acc[ai][1][m][0][e] * ri + cv[1][0][e]); r1[e] = g1 * fast_sigmoid(g1) * (acc[ai][1][m][1][e] * ri + cv[1][1][e]); }
                if constexpr (O8) *(u32x2*)((unsigned char*)O + (size_t)row * ldc + col0) = pack8_fp8(r0 * ACT8_SC, r1 * ACT8_SC);
                else *(u32x4*)rowp = pack8_bf16(r0, r1); }
    }
};
typedef _Float16 f16_t;
__device__ __forceinline__ float h_lo(unsigned w) { return (float)__builtin_bit_cast(_Float16, (unsigned short)(w & 0xffffu)); }
__device__ __forceinline__ float h_hi(unsigned w) { return (float)__builtin_bit_cast(_Float16, (unsigned short)(w >> 16)); }
__device__ __forceinline__ void unpack8_f16(const u32x4 w, f32x4& a, f32x4& b) {
    const unsigned w0 = w[0], w1 = w[1], w2 = w[2], w3 = w[3];
    a[0] = h_lo(w0); a[1] = h_hi(w0); a[2] = h_lo(w1); a[3] = h_hi(w1); b[0] = h_lo(w2); b[1] = h_hi(w2); b[2] = h_lo(w3); b[3] = h_hi(w3); }
__device__ __forceinline__ unsigned pk2_f16(float lo, float hi) {
    const unsigned short l = __builtin_bit_cast(unsigned short, (_Float16)__builtin_fminf(__builtin_fmaxf(lo, -65504.f), 65504.f)), h = __builtin_bit_cast(unsigned short, (_Float16)__builtin_fminf(__builtin_fmaxf(hi, -65504.f), 65504.f));
    return (unsigned)l | ((unsigned)h << 16); }
__device__ __forceinline__ u32x4 pack8_f16(const f32x4 a, const f32x4 b) { u32x4 w; w[0] = pk2_f16(a[0], a[1]); w[1] = pk2_f16(a[2], a[3]); w[2] = pk2_f16(b[0], b[1]); w[3] = pk2_f16(b[2], b[3]); return w; }
template <bool NEXT, bool F8 = false> struct EpiResid {
    static constexpr bool PERM = true, AFTER_DRAIN = false;
    bf16_t* X; const float* gate; bf16_t* An; const float* gn; const float* scn; ssq_t* ssqn; unsigned char* A8; int gstride; float s; const ssq_t* ssqp;
    __device__ __forceinline__ void operator()(f32x4 (&acc)[2][2][4][2], const Unit& u, int wr, int wc, int fr, int fq) const {
        const int row0 = u.pm * BM + wr * 64 + fr, col0 = u.pn * BM + wc * 32 + 8 * fq;
        const unsigned cofs = (unsigned)((u.pm >> 3) * gstride + col0);
        const unsigned e0 = (unsigned)row0 * 2048u + (unsigned)col0;
#pragma unroll
        for (int ah = 0; ah < 4; ++ah) { const int ai = ah >> 1, mb = (ah & 1) * 2; u32x4 xw[2][2];
#pragma unroll
            for (int mm = 0; mm < 2; ++mm)
#pragma unroll
                for (int bj = 0; bj < 2; ++bj) xw[mm][bj] = *(const u32x4*)(X + (size_t)(e0 + (unsigned)(ai * HALF + (mb + mm) * 16) * 2048u + bj * HALF));
            float ss[2] = {0.f, 0.f}, qs[2] = {0.f, 0.f};
            if (NEXT && F8) {
#pragma unroll
                for (int mm = 0; mm < 2; ++mm) qs[mm] = a8_inv(ssqp[row0 + ai * HALF + (mb + mm) * 16]); }
#pragma unroll
            for (int bj = 0; bj < 2; ++bj) { f32x4 gv[2], nv[2];
#pragma unroll
                for (int n = 0; n < 2; ++n) { gv[n] = *(const f32x4*)(gate + (size_t)(cofs + bj * HALF + 4 * n)) * s;
                    if (NEXT) nv[n] = *(const f32x4*)(gn + (size_t)(unsigned)(col0 + bj * HALF + 4 * n)) * (*(const f32x4*)(scn + (size_t)(cofs + bj * HALF + 4 * n)) + 1.0f); }
#pragma unroll
                for (int mm = 0; mm < 2; ++mm) { const int m = mb + mm; const unsigned off = e0 + (unsigned)(ai * HALF + m * 16) * 2048u + bj * HALF;
                    f32x4 a, b; unpack8_f16(xw[mm][bj], a, b); a += gv[0] * acc[ai][bj][m][0]; b += gv[1] * acc[ai][bj][m][1];
                    *(u32x4*)(X + (size_t)off) = pack8_f16(a, b);
                    if (NEXT) { ss[mm] += ((a[0] * a[0] + a[1] * a[1]) + (a[2] * a[2] + a[3] * a[3])) + ((b[0] * b[0] + b[1] * b[1]) + (b[2] * b[2] + b[3] * b[3]));
                        const f32x4 an = a * nv[0], bn = b * nv[1]; *(u32x4*)(An + (size_t)off) = pack8_bf16(an, bn);
                        if (F8) *(u32x2*)(A8 + (size_t)off) = pack8_i8(an * qs[mm], bn * qs[mm]); } } }
            if (NEXT) {
#pragma unroll
                for (int mm = 0; mm < 2; ++mm) { float t = ss[mm]; t += __shfl_xor(t, 16); t += __shfl_xor(t, 32); if (fq == 0) ssq_add(ssqn + row0 + ai * HALF + (mb + mm) * 16, t); } }
            asm volatile("" ::: "memory"); }
    }
};
template <int MODE, bool QF8> struct EpiWin {
    static constexpr bool PERM = true, AFTER_DRAIN = false;
    bf16_t *LRUX, *LRUG, *SCB, *SCC, *SCX, *Q, *KVLAT, *GATES, *KPE; ssq_t* ssq; const ssq_t* ssqn; const int* cb; int cbstride; float eps; const ssq_t* ssqp; const float* wsc;
    __device__ __forceinline__ void operator()(f32x4 (&acc)[2][2][4][2], const Unit& u, int wr, int wc, int fr, int fq) const {
        const int t = u.pn; bf16_t* base; int pitch, cbs, act = 0;
        if (MODE == 0) { const int tq = QF8 ? 20 : 32;
            if (t < 4) { base = LRUX; pitch = 1024; cbs = 256 * t; }
            else if (t < 8) { base = LRUG; pitch = 1024; cbs = 256 * (t - 4); act = 1; }
            else if (t < 12) { base = SCB; pitch = 1024; cbs = 256 * (t - 8); }
            else if (t < 16) { base = SCC; pitch = 1024; cbs = 256 * (t - 12); }
            else if (t < 20) { base = SCX; pitch = 1024; cbs = 256 * (t - 16); }
            else if (t < tq) { base = Q; pitch = 3072; cbs = 256 * (t - 20); }
            else if (t < tq + 2) { base = KVLAT; pitch = 512; cbs = 256 * (t - tq); act = 3; }
            else if (!G1_BF16 || t == tq + 2) { base = KPE; pitch = 64; cbs = 0; act = 4; }
            else { base = GATES; pitch = 6144; cbs = 2048 + 256 * (t - (tq + 3)); act = 2; }
        } else if (MODE == 2) {
            if (t < 4) { base = LRUX; pitch = 1024; cbs = 256 * t; }
            else if (t < 8) { base = LRUG; pitch = 1024; cbs = 256 * (t - 4); act = 1; }
            else if (t < 12) { base = SCB; pitch = 1024; cbs = 256 * (t - 8); }
            else if (t < 16) { base = SCC; pitch = 1024; cbs = 256 * (t - 12); }
            else if (t < 20) { base = SCX; pitch = 1024; cbs = 256 * (t - 16); }
            else if (t < 32) { base = Q; pitch = 3072; cbs = 256 * (t - 20); }
            else if (t < 34) { base = KVLAT; pitch = 512; cbs = 256 * (t - 32); act = 3; }
            else if (t < 58) { base = GATES; pitch = 6144; cbs = 256 * (t - 34); act = 2; }
            else { base = KPE; pitch = 64; cbs = 0; act = 4; }
        } else { const int tg = QF8 ? 12 : 0;
            if (t < tg) { base = Q; pitch = 3072; cbs = 256 * t; }
            else { base = GATES; pitch = 6144; cbs = 256 * (t - tg) + ((G1_BF16 && t >= tg + 8) ? 2048 : 0); act = 2; }
        }
        const float dsc = MODE == 1 ? wsc[0] : (MODE == 2 ? (1.0f / 64.0f) : 1.0f);
        const int row0 = u.pm * BM + wr * 64 + fr;
        bf16_t* p0 = base + (size_t)row0 * pitch + cbs + wc * 32 + 8 * fq;
        const size_t rstep = (size_t)16 * pitch;
        const int* cbp = cb + (size_t)(u.pm >> 3) * cbstride + (MODE == 1 ? (QF8 ? (G1_BF16 ? 7936 : 5888) : 8960) : 0) + u.pn * BM + wc * 32 + 8 * fq;
        if (act == 4) {
            if (wc < 2) { f32x4 cv[1][2]; cv[0][0] = cb_ld4(cbp); cv[0][1] = cb_ld4(cbp + 4);
#pragma unroll
                for (int ai = 0; ai < 2; ++ai)
#pragma unroll
                    for (int m = 0; m < 4; ++m) { const float ri = __builtin_amdgcn_rsqf(ssq_dec(ssqn[row0 + ai * HALF + m * 16]) * (1.0f / 2048.0f) + eps) * dsc;
                        *(u32x4*)(p0 + (size_t)(ai * 8 + m) * rstep) = pack8_bf16(acc[ai][0][m][0] * ri + cv[0][0], acc[ai][0][m][1] * ri + cv[0][1]); }
            }
            return;
        }
        f32x4 cv[2][2];
#pragma unroll
        for (int bj = 0; bj < 2; ++bj)
#pragma unroll
            for (int n = 0; n < 2; ++n) cv[bj][n] = cb_ld4(cbp + bj * HALF + 4 * n);
#pragma unroll
        for (int ai = 0; ai < 2; ++ai)
#pragma unroll
            for (int m = 0; m < 4; ++m) { bf16_t* rowp = p0 + (size_t)(ai * 8 + m) * rstep;
                float ri = __builtin_amdgcn_rsqf(ssq_dec(ssqn[row0 + ai * HALF + m * 16]) * (1.0f / 2048.0f) + eps) * dsc;
                if (MODE == 1) { ri *= a8_scale(ssqp[row0 + ai * HALF + m * 16]);
#pragma unroll
                    for (int bj = 0; bj < 2; ++bj)
#pragma unroll
                        for (int n = 0; n < 2; ++n) acc[ai][bj][m][n] = i2f(acc[ai][bj][m][n]); }
                f32x4 v[2][2];
#pragma unroll
                for (int bj = 0; bj < 2; ++bj)
#pragma unroll
                    for (int n = 0; n < 2; ++n) v[bj][n] = acc[ai][bj][m][n] * ri + cv[bj][n];
                if (act == 1) {
#pragma unroll
                    for (int bj = 0; bj < 2; ++bj)
#pragma unroll
                        for (int n = 0; n < 2; ++n)
#pragma unroll
                            for (int e = 0; e < 4; ++e) v[bj][n][e] = gelu_tanh(v[bj][n][e]);
                } else if (act == 2) {
#pragma unroll
                    for (int bj = 0; bj < 2; ++bj)
#pragma unroll
                        for (int n = 0; n < 2; ++n)
#pragma unroll
                            for (int e = 0; e < 4; ++e) v[bj][n][e] = fast_sigmoid(v[bj][n][e]);
                } else if (act == 3) { float s = 0.f;
#pragma unroll
                    for (int bj = 0; bj < 2; ++bj)
#pragma unroll
                        for (int n = 0; n < 2; ++n) { const f32x4 x = v[bj][n]; s += (x[0] * x[0] + x[1] * x[1]) + (x[2] * x[2] + x[3] * x[3]); }
                    s += __shfl_xor(s, 16); s += __shfl_xor(s, 32);
                    if (fq == 0) ssq_add(ssq + row0 + ai * HALF + m * 16, s); }
                if (GATES_U8 && act == 2) { unsigned char* r8 = (unsigned char*)base + (size_t)(row0 + ai * HALF + m * 16) * pitch + cbs + wc * 32 + 8 * fq;
#pragma unroll
                    for (int bj = 0; bj < 2; ++bj) { unsigned w0 = 0u, w1 = 0u;
#pragma unroll
                        for (int e = 0; e < 4; ++e) { w0 = __builtin_amdgcn_cvt_pk_u8_f32(v[bj][0][e] * 255.0f, e, w0); w1 = __builtin_amdgcn_cvt_pk_u8_f32(v[bj][1][e] * 255.0f, e, w1); }
                        *(u32x2*)(r8 + bj * HALF) = (u32x2){w0, w1}; } }
                else { *(u32x4*)rowp = pack8_bf16(v[0][0], v[0][1]); *(u32x4*)(rowp + HALF) = pack8_bf16(v[1][0], v[1][1]); }
                asm volatile("" ::: "memory"); }
    }
};
struct EpiKV {
    static constexpr bool PERM = true, AFTER_DRAIN = false;
    bf16_t *KN, *V; const ssq_t* ssq; float eps;
    __device__ __forceinline__ void operator()(f32x4 (&acc)[2][2][4][2], const Unit& u, int wr, int wc, int fr, int fq) const {
        const int row0 = u.pm * BM + wr * 64 + fr, col0 = u.pn * HALF + wc * 32 + 8 * fq;
#pragma unroll
        for (int ai = 0; ai < 2; ++ai)
#pragma unroll
            for (int m = 0; m < 4; ++m) { const int row = row0 + ai * HALF + m * 16; const float ri = __builtin_amdgcn_rsqf(ssq_dec(ssq[row]) * (1.0f / 512.0f) + eps);
                *(u32x4*)(KN + (size_t)row * 2048 + col0) = pack8_bf16(acc[ai][0][m][0] * ri, acc[ai][0][m][1] * ri);
                *(u32x4*)(V + (size_t)row * 2048 + col0) = pack8_bf16(acc[ai][1][m][0] * ri, acc[ai][1][m][1] * ri); }
    }
};
struct EpiMerge3 {
    static constexpr bool PERM = true, AFTER_DRAIN = false;
    bf16_t* Mg; const unsigned char* G; int gp;
    static __device__ __forceinline__ void un8(const u32x2 w, f32x4& a, f32x4& b) {
        a[0] = __builtin_fmaxf((float)(w[0] & 0xffu), 0.00390625f); a[1] = __builtin_fmaxf((float)((w[0] >> 8) & 0xffu), 0.00390625f); a[2] = __builtin_fmaxf((float)((w[0] >> 16) & 0xffu), 0.00390625f); a[3] = __builtin_fmaxf((float)(w[0] >> 24), 0.00390625f);
        b[0] = __builtin_fmaxf((float)(w[1] & 0xffu), 0.00390625f); b[1] = __builtin_fmaxf((float)((w[1] >> 8) & 0xffu), 0.00390625f); b[2] = __builtin_fmaxf((float)((w[1] >> 16) & 0xffu), 0.00390625f); b[3] = __builtin_fmaxf((float)(w[1] >> 24), 0.00390625f); }
    static __device__ __forceinline__ f32x4 rcp4(f32x4 g) { f32x4 r; r[0] = __builtin_amdgcn_rcpf(g[0]); r[1] = __builtin_amdgcn_rcpf(g[1]); r[2] = __builtin_amdgcn_rcpf(g[2]); r[3] = __builtin_amdgcn_rcpf(g[3]); return r; }
    __device__ __forceinline__ bool mid_at(int t) const { return t == 16 || t == 32; }
    __device__ __forceinline__ void mid(f32x4 (&acc)[2][2][4][2], const Unit& u, int wr, int wc, int fr, int fq, int t) const {
        const int row0 = u.pm * BM + wr * 64 + fr, col0 = u.pn * BM + wc * 32 + 8 * fq + (t == 16 ? 0 : 2048);
        const unsigned char* g0p = G + (size_t)row0 * gp + col0;
#pragma unroll
        for (int ai = 0; ai < 2; ++ai) { u32x2 nw[4][2], dw[4][2];
#pragma unroll
            for (int m = 0; m < 4; ++m)
#pragma unroll
                for (int bj = 0; bj < 2; ++bj) { const size_t ro = (size_t)(ai * HALF + m * 16);
                    nw[m][bj] = *(const u32x2*)(g0p + ro * gp + bj * HALF); dw[m][bj] = *(const u32x2*)(g0p + ro * gp + bj * HALF + 2048); }
#pragma unroll
            for (int m = 0; m < 4; ++m)
#pragma unroll
                for (int bj = 0; bj < 2; ++bj) { f32x4 n0, n1, d0, d1; un8(nw[m][bj], n0, n1); un8(dw[m][bj], d0, d1);
                    acc[ai][bj][m][0] *= n0 * rcp4(d0); acc[ai][bj][m][1] *= n1 * rcp4(d1); }
            asm volatile("" ::: "memory"); }
    }
    __device__ __forceinline__ void operator()(f32x4 (&acc)[2][2][4][2], const Unit& u, int wr, int wc, int fr, int fq) const {
        const int row0 = u.pm * BM + wr * 64 + fr, col0 = u.pn * BM + wc * 32 + 8 * fq;
        const unsigned char* g0p = G + (size_t)row0 * gp + col0 + 4096; bf16_t* m0p = Mg + (size_t)row0 * 2048 + col0;
#pragma unroll
        for (int ai = 0; ai < 2; ++ai) { u32x2 gw[4][2];
#pragma unroll
            for (int m = 0; m < 4; ++m)
#pragma unroll
                for (int bj = 0; bj < 2; ++bj) gw[m][bj] = *(const u32x2*)(g0p + (size_t)(ai * HALF + m * 16) * gp + bj * HALF);
#pragma unroll
            for (int m = 0; m < 4; ++m)
#pragma unroll
                for (int bj = 0; bj < 2; ++bj) { f32x4 g0, g1; un8(gw[m][bj], g0, g1);
                    *(u32x4*)(m0p + (size_t)(ai * HALF + m * 16) * 2048 + bj * HALF) = pack8_bf16(acc[ai][bj][m][0] * (g0 * (1.0f / 255.0f)), acc[ai][bj][m][1] * (g1 * (1.0f / 255.0f))); }
            asm volatile("" ::: "memory"); }
    }
};
template <> struct has_mid<EpiMerge3> { static constexpr bool value = true; };
template <bool FIRST> struct EpiMerge {
    static constexpr bool PERM = true, AFTER_DRAIN = false;
    bf16_t* Mg; const bf16_t* G; int gp;
    __device__ __forceinline__ void operator()(f32x4 (&acc)[2][2][4][2], const Unit& u, int wr, int wc, int fr, int fq) const {
        const int row0 = u.pm * BM + wr * 64 + fr, col0 = u.pn * BM + wc * 32 + 8 * fq;
        const bf16_t* g0p = G + (size_t)row0 * gp + col0; bf16_t* m0p = Mg + (size_t)row0 * 2048 + col0;
#pragma unroll
        for (int ai = 0; ai < 2; ++ai) { u32x4 gw[4][2], mw[4][2];
#pragma unroll
            for (int m = 0; m < 4; ++m)
#pragma unroll
                for (int bj = 0; bj < 2; ++bj) { const size_t ro = (size_t)(ai * HALF + m * 16);
                    gw[m][bj] = *(const u32x4*)(g0p + ro * gp + bj * HALF); if (!FIRST) mw[m][bj] = *(const u32x4*)(m0p + ro * 2048 + bj * HALF); }
#pragma unroll
            for (int m = 0; m < 4; ++m)
#pragma unroll
                for (int bj = 0; bj < 2; ++bj) { const size_t ro = (size_t)(ai * HALF + m * 16);
                    f32x4 g0, g1; unpack8_bf16(gw[m][bj], g0, g1); f32x4 v0 = acc[ai][bj][m][0] * g0, v1 = acc[ai][bj][m][1] * g1;
                    if (!FIRST) { f32x4 m0, m1; unpack8_bf16(mw[m][bj], m0, m1); v0 += m0; v1 += m1; }
                    *(u32x4*)(m0p + ro * 2048 + bj * HALF) = pack8_bf16(v0, v1); }
            asm volatile("" ::: "memory"); }
    }
};
template <bool F> struct FragA_ { bf16x8 v[4][2]; }; template <> struct FragA_<true> { v8i_t v[4]; };
template <bool F> struct FragB_ { bf16x8 v[2][2]; }; template <> struct FragB_<true> { v8i_t v[2]; };
template <class Epi, class Sched, bool ALIGN_EPI = false, bool SP2 = false, bool REVK = false, bool ATILED = false, bool BTILED = false, bool FP8 = false, bool I8 = false>
__device__ __forceinline__ void gemm_phase(PG8_LAS unsigned char* lds, const Gemm g, const Sched S, const Epi E, int wave_id) {
    unsigned m1_ = ~0u; asm volatile("" : "+s"(m1_)); int tid_ = wave_id * 64 + (int)__builtin_amdgcn_mbcnt_hi(m1_, __builtin_amdgcn_mbcnt_lo(m1_, 0u)); asm volatile("" : "+v"(tid_));
    const int tid = tid_, wid = __builtin_amdgcn_readfirstlane(tid >> 6), lane = tid & 63, wr = wid >> 2, wc = wid & 3, fr = lane & 15, fq = lane >> 4;
    const int K = g.K, nt = K / BK, LD = g.ld ? g.ld : K;
    unsigned voffA[2], voffB[2];
#pragma unroll
    for (int i = 0; i < 2; ++i) { int R, C; stage_rc(tid * 16 + i * 8192, R, C); const int Rb = Epi::PERM ? ((R & ~31) + perm32(R & 31)) : R;
        voffA[i] = ATILED ? (unsigned)(R * BK + C) * 2u : (unsigned)(R * LD + C) * 2u; voffB[i] = BTILED ? (unsigned)(Rb * BK + C) * 2u : (unsigned)(Rb * LD + C) * 2u; }
    const size_t kstep = REVK ? (size_t)0 - (size_t)(BK * 2) : (size_t)(BK * 2), kbase = REVK ? (size_t)(K - BK) * 2 : (size_t)0;
    const size_t hstep = (size_t)HALF * LD * 2;
    const size_t kstepB = BTILED ? (size_t)(BM * BK * 2) : kstep, hstepB = BTILED ? (size_t)(HALF * BK * 2) : hstep;
    const size_t kstepA = ATILED ? (size_t)(BM * BK * 2) : kstep, hstepA = ATILED ? (size_t)(HALF * BK * 2) : hstep;
    const size_t tstep = 2 * hstep;
    const unsigned ldsw = (unsigned)wid * 1024u;
    const int aoff = lds_byte(wr * 64 + fr, fq * 8), boff = lds_byte(wc * 32 + fr, fq * 8);
#define PG8_SA(b, h) (((b) * 2 + (h)) * HTB)
#define PG8_SB(b, h) ((4 + (b) * 2 + (h)) * HTB)
#define PG8_STAGE(bufoff, gbase, voff) do { _Pragma("unroll") for (int _i = 0; _i < 2; ++_i) \
        __builtin_amdgcn_global_load_lds((const unsigned*)((const char*)(gbase) + (voff)[_i]), (PG8_LAS unsigned*)(lds + (bufoff) + ldsw + _i * 8192), 16, 0, 0); } while (0)
#define PG8_LDA(dst, b, h) do { if constexpr (FP8) { _Pragma("unroll") for (int m = 0; m < 4; ++m) { const v4i_t lo_ = *(const PG8_LAS v4i_t*)(lds + PG8_SA(b, h) + aoff + m * 2048), hi_ = *(const PG8_LAS v4i_t*)(lds + PG8_SA(b, h) + aoff + m * 2048 + 1024); dst.v[m] = __builtin_shufflevector(lo_, hi_, 0, 1, 2, 3, 4, 5, 6, 7); } } \
        else { _Pragma("unroll") for (int m = 0; m < 4; ++m) _Pragma("unroll") for (int k = 0; k < 2; ++k) dst.v[m][k] = *(const PG8_LAS bf16x8*)(lds + PG8_SA(b, h) + aoff + m * 2048 + k * 1024); } } while (0)
#define PG8_LDB(dst, b, h) do { if constexpr (FP8) { _Pragma("unroll") for (int n = 0; n < 2; ++n) { const v4i_t lo_ = *(const PG8_LAS v4i_t*)(lds + PG8_SB(b, h) + boff + n * 2048), hi_ = *(const PG8_LAS v4i_t*)(lds + PG8_SB(b, h) + boff + n * 2048 + 1024); dst.v[n] = __builtin_shufflevector(lo_, hi_, 0, 1, 2, 3, 4, 5, 6, 7); } } \
        else { _Pragma("unroll") for (int n = 0; n < 2; ++n) _Pragma("unroll") for (int k = 0; k < 2; ++k) dst.v[n][k] = *(const PG8_LAS bf16x8*)(lds + PG8_SB(b, h) + boff + n * 2048 + k * 1024); } } while (0)
#define PG8_MMA(ai, bj, At, Bt) do { __builtin_amdgcn_s_setprio(1); \
        if constexpr (FP8) { _Pragma("unroll") for (int m = 0; m < 4; ++m) _Pragma("unroll") for (int n = 0; n < 2; ++n) \
            asm volatile("v_mfma_scale_f32_16x16x128_f8f6f4 %0, %1, %2, %0, %3, %3 op_sel_hi:[0,0,0]" : "+v"(acc[ai][bj][m][n]) : "v"(Bt.v[n]), "v"(At.v[m]), "v"(sc_one)); } \
        else { _Pragma("unroll") for (int m = 0; m < 4; ++m) _Pragma("unroll") for (int n = 0; n < 2; ++n) _Pragma("unroll") for (int k = 0; k < 2; ++k) \
            { if constexpr (I8) acc[ai][bj][m][n] = __builtin_bit_cast(f32x4, __builtin_amdgcn_mfma_i32_16x16x64_i8(__builtin_bit_cast(v4i_t, Bt.v[n][k]), __builtin_bit_cast(v4i_t, At.v[m][k]), __builtin_bit_cast(v4i_t, acc[ai][bj][m][n]), 0, 0, 0)); \
              else acc[ai][bj][m][n] = __builtin_amdgcn_mfma_f32_16x16x32_bf16(Bt.v[n][k], At.v[m][k], acc[ai][bj][m][n], 0, 0, 0); } } \
        __builtin_amdgcn_s_setprio(0); } while (0)
#define PG8_WAIT_V(n) asm volatile("s_waitcnt vmcnt(" #n ")" ::: "memory")
#define PG8_WAIT_L(n) asm volatile("s_waitcnt lgkmcnt(" #n ")" ::: "memory")
#define PG8_BAR __builtin_amdgcn_s_barrier()
#define PG8_SCHED __builtin_amdgcn_sched_barrier(0)
    Unit cur, nxt; int ui = 0;
    if (!S.next(0, cur)) return;
    f32x4 acc[2][2][4][2];
#pragma unroll
    for (int a = 0; a < 2; ++a)
#pragma unroll
        for (int b = 0; b < 2; ++b)
#pragma unroll
            for (int m = 0; m < 4; ++m)
#pragma unroll
                for (int n = 0; n < 2; ++n) acc[a][b][m][n] = (f32x4){0.f, 0.f, 0.f, 0.f};
    int sc_one = 0x7f7f7f7f; asm volatile("" : "+v"(sc_one));
    FragA_<FP8> At; FragB_<FP8> B0, B1;
    const char* cA = (const char*)g.A + (size_t)cur.pm * tstep + kbase; const char* cB = (const char*)g.Bt + (size_t)cur.pn * tstep + kbase;
    S.a_ready(cur);
    if constexpr (SP2) {
        PG8_STAGE(PG8_SB(0, 0), cB, voffB); PG8_STAGE(PG8_SB(0, 1), cB + hstepB, voffB); PG8_STAGE(PG8_SA(0, 0), cA, voffA); PG8_STAGE(PG8_SA(0, 1), cA + hstepA, voffA);
        if (wr == 1) PG8_BAR;
        PG8_WAIT_V(2); PG8_BAR;
        PG8_STAGE(PG8_SB(1, 0), cB + kstepB, voffB); PG8_STAGE(PG8_SA(1, 0), cA + kstepA, voffA); PG8_STAGE(PG8_SB(1, 1), cB + hstepB + kstepB, voffB);
        PG8_WAIT_V(6); PG8_BAR;
    } else {
        PG8_STAGE(PG8_SB(0, 0), cB, voffB); PG8_STAGE(PG8_SA(0, 0), cA, voffA); PG8_STAGE(PG8_SB(0, 1), cB + hstepB, voffB); PG8_STAGE(PG8_SA(0, 1), cA + hstepA, voffA);
        if (wr == 1) PG8_BAR;
        PG8_WAIT_V(4); PG8_BAR;
        PG8_STAGE(PG8_SB(1, 0), cB + kstepB, voffB); PG8_STAGE(PG8_SA(1, 0), cA + kstepA, voffA); PG8_STAGE(PG8_SB(1, 1), cB + hstepB + kstepB, voffB);
        PG8_WAIT_V(6); PG8_BAR;
    }
    for (;;) {
        const bool has_next = S.next(ui + 1, nxt);
        const char* nA = has_next ? (const char*)g.A + (size_t)nxt.pm * tstep + kbase : cA; const char* nB = has_next ? (const char*)g.Bt + (size_t)nxt.pn * tstep + kbase : cB;
        for (int t = 0; t < nt; t += 2) {
            if constexpr (has_mid<Epi>::value) { if (E.mid_at(t)) { int fr_m = fr, fq_m = fq; asm volatile("" : "+v"(fr_m), "+v"(fq_m)); E.mid(acc, cur, wr, wc, fr_m, fq_m, t); } }
            const bool last = (t == nt - 2);
            const char* a1 = cA + (size_t)(t + 1) * kstepA;
            const char* a2 = last ? nA : cA + (size_t)(t + 2) * kstepA; const char* b2 = last ? nB : cB + (size_t)(t + 2) * kstepB;
            const char* a3 = a2 + kstepA; const char* b3 = b2 + kstepB;
            if (last && has_next) S.a_ready(nxt);
            if constexpr (SP2) {
            PG8_LDB(B0, 0, 0); PG8_LDB(B1, 0, 1); PG8_SCHED; PG8_LDA(At, 0, 0); PG8_STAGE(PG8_SA(1, 1), a1 + hstepA, voffA);
            PG8_WAIT_V(8); PG8_WAIT_L(0); PG8_BAR; PG8_MMA(0, 0, At, B0); PG8_MMA(0, 1, At, B1); PG8_BAR; PG8_SCHED;
            PG8_LDA(At, 0, 1); PG8_STAGE(PG8_SB(0, 0), b2, voffB); PG8_STAGE(PG8_SB(0, 1), b2 + hstepB, voffB); PG8_STAGE(PG8_SA(0, 0), a2, voffA);
            PG8_WAIT_V(8); PG8_WAIT_L(0); PG8_BAR; PG8_MMA(1, 0, At, B0); PG8_MMA(1, 1, At, B1); PG8_BAR; PG8_SCHED;
            PG8_LDB(B0, 1, 0); PG8_LDB(B1, 1, 1); PG8_SCHED; PG8_LDA(At, 1, 0); PG8_STAGE(PG8_SA(0, 1), a2 + hstepA, voffA);
            PG8_WAIT_V(8); PG8_WAIT_L(0); PG8_BAR; PG8_MMA(0, 0, At, B0); PG8_MMA(0, 1, At, B1); PG8_BAR; PG8_SCHED;
            PG8_LDA(At, 1, 1); PG8_STAGE(PG8_SB(1, 0), b3, voffB); PG8_STAGE(PG8_SB(1, 1), b3 + hstepB, voffB); PG8_STAGE(PG8_SA(1, 0), a3, voffA);
            PG8_WAIT_V(8); PG8_WAIT_L(0); PG8_BAR; PG8_MMA(1, 0, At, B0); PG8_MMA(1, 1, At, B1); PG8_BAR; PG8_SCHED;
            } else {
            PG8_LDB(B0, 0, 0); PG8_SCHED; PG8_LDA(At, 0, 0); PG8_STAGE(PG8_SA(1, 1), a1 + hstepA, voffA);
            PG8_WAIT_L(8); PG8_BAR; PG8_WAIT_L(0); PG8_MMA(0, 0, At, B0); PG8_BAR; PG8_SCHED;
            PG8_LDB(B1, 0, 1); PG8_STAGE(PG8_SB(0, 0), b2, voffB);
            PG8_BAR; PG8_WAIT_L(0); PG8_MMA(0, 1, At, B1); PG8_BAR;
            PG8_LDA(At, 0, 1); PG8_STAGE(PG8_SA(0, 0), a2, voffA);
            PG8_BAR; PG8_WAIT_L(0); PG8_MMA(1, 0, At, B0); PG8_BAR; PG8_SCHED;
            PG8_STAGE(PG8_SB(0, 1), b2 + hstepB, voffB);
            PG8_WAIT_V(6); PG8_BAR; PG8_MMA(1, 1, At, B1); PG8_BAR;
            PG8_LDB(B0, 1, 0); PG8_SCHED; PG8_LDA(At, 1, 0); PG8_STAGE(PG8_SA(0, 1), a2 + hstepA, voffA);
            PG8_WAIT_L(8); PG8_BAR; PG8_WAIT_L(0); PG8_MMA(0, 0, At, B0); PG8_BAR; PG8_SCHED;
            PG8_LDB(B1, 1, 1); PG8_STAGE(PG8_SB(1, 0), b3, voffB);
            PG8_BAR; PG8_WAIT_L(0); PG8_MMA(0, 1, At, B1); PG8_BAR;
            PG8_LDA(At, 1, 1); PG8_STAGE(PG8_SA(1, 0), a3, voffA);
            PG8_BAR; PG8_WAIT_L(0); PG8_MMA(1, 0, At, B0); PG8_BAR; PG8_SCHED;
            PG8_STAGE(PG8_SB(1, 1), b3 + hstepB, voffB);
            PG8_WAIT_V(6); PG8_BAR; PG8_MMA(1, 1, At, B1); PG8_BAR;
            }
        }
        if constexpr (FP8) { asm volatile("s_nop 15\n\ts_nop 15\n\ts_nop 15\n\ts_nop 15\n\ts_nop 15" ::: "memory"); }
        if constexpr (ALIGN_EPI) { if (wr == 0) PG8_BAR; }
        if constexpr (!Epi::AFTER_DRAIN) { int fr_e = fr, fq_e = fq; asm volatile("" : "+v"(fr_e), "+v"(fq_e));
            E(acc, cur, wr, wc, fr_e, fq_e); S.done(cur); }
        if (!has_next) break;
#pragma unroll
        for (int a = 0; a < 2; ++a)
#pragma unroll
            for (int b = 0; b < 2; ++b)
#pragma unroll
                for (int m = 0; m < 4; ++m)
#pragma unroll
                    for (int n = 0; n < 2; ++n) acc[a][b][m][n] = (f32x4){0.f, 0.f, 0.f, 0.f};
        cur = nxt; cA = nA; cB = nB; ++ui;
        if constexpr (ALIGN_EPI) { if (wr == 1) PG8_BAR; }
    }
    PG8_WAIT_V(0);
    if constexpr (!ALIGN_EPI) { if (wr == 0) PG8_BAR; }
    PG8_BAR;
    if constexpr (Epi::AFTER_DRAIN) { E.fused(acc, cur, wr, wc, fr, fq, lds, wid, lane); S.done(cur); }
#undef PG8_SA
#undef PG8_SB
#undef PG8_STAGE
#undef PG8_LDA
#undef PG8_LDB
#undef PG8_MMA
#undef PG8_WAIT_V
#undef PG8_WAIT_L
#undef PG8_BAR
#undef PG8_SCHED
}
}
namespace att {
#define ATT_LAS __attribute__((address_space(3)))
typedef unsigned short bf16;
typedef short bf16x8 __attribute__((ext_vector_type(8)));
typedef short s16x4 __attribute__((ext_vector_type(4)));
typedef float f32x16 __attribute__((ext_vector_type(16)));
typedef float f32x4 __attribute__((ext_vector_type(4)));
typedef unsigned u32x4 __attribute__((ext_vector_type(4)));
constexpr int NW = 8, QBLK = 32, KVBLK = 64, QB = NW * QBLK;
constexpr int SEQ = 2048, NH = 16, QPITCH = 3072, KPITCH = 2048, PEPITCH = 64, OPITCH = 4096  , QHEAD = 192;
constexpr float SCALE = 0.07216878364870322f;
constexpr float THR = 8.f;
constexpr int SHM_V = 16384, SHM_KN = 16384, SHM_KP = 8192;
constexpr int OFF_V = 0, OFF_KN = 3 * SHM_V, OFF_KP = OFF_KN + 2 * SHM_KN, OFF_WS = OFF_KP + 2 * SHM_KP, LDS_BYTES = OFF_WS + NW * 64 * 4;
#define ATT_KSWZ(row, colB) ((row) * 256 + ((colB) ^ (((row) & 7) << 4)))
#define ATT_KPSWZ(row, ch) ((row) * 128 + ((((ch) ^ (((row) >> 1) & 7))) << 4))
#define ATT_SBAR() __builtin_amdgcn_sched_barrier(0)
__device__ __forceinline__ int v_st(int k, int c) { const int kk = (k & ~0xC) | ((k & 4) << 1) | ((k & 8) >> 1); return ((kk >> 3) * 4 + (c >> 5)) * 512 + ((kk & 7) * 32 + (c & 31)) * 2; }
__device__ __forceinline__ int v_rd_base(int lane) { return ((lane & 3) << 3) | (((lane >> 2) & 3) << 6) | (((lane >> 4) & 1) << 5) | (((lane >> 5) & 1) << 8); }
constexpr int v_rd_off(int d0, int ks, int half) { return d0 * 512 + ks * 4096 + half * 2048; }
__device__ __forceinline__ int crow(int r, int hi) { return (r & 3) + 8 * (r >> 2) + 4 * hi; }
__device__ __forceinline__ unsigned cvtpk(float lo, float hi) { unsigned r; asm volatile("v_cvt_pk_bf16_f32 %0, %1, %2" : "=v"(r) : "v"(lo), "v"(hi)); return r; }
__device__ __forceinline__ void mask_tile(f32x16& p0, f32x16& p1, int dq) {
    const float NEG = -__builtin_inff();
#pragma unroll
    for (int r = 0; r < 16; ++r) { const int c = (r & 3) + 8 * (r >> 2); if (dq - c < 0) p0[r] = NEG; if (dq - c - 32 < 0) p1[r] = NEG; }
}
__device__ __forceinline__ void partialSM(f32x16& p0, f32x16& p1, float& m_reg, float& mn, float& alpha) {
    float pmax = p0[0];
#pragma unroll
    for (int r = 1; r < 16; ++r) pmax = fmaxf(pmax, p0[r]);
#pragma unroll
    for (int r = 0; r < 16; ++r) pmax = fmaxf(pmax, p1[r]);
    { auto rr = __builtin_amdgcn_permlane32_swap(__float_as_uint(pmax), __float_as_uint(pmax), false, false); pmax = fmaxf(__uint_as_float(rr[0]), __uint_as_float(rr[1])); }
    constexpr float C2 = 1.4426950408889634f * SCALE;
    if (__builtin_expect(__all((pmax - m_reg) * SCALE <= THR), 1)) { mn = m_reg; alpha = 1.f; }
    else { mn = fmaxf(m_reg, pmax); alpha = __builtin_amdgcn_exp2f((m_reg - mn) * C2); m_reg = mn; }
    const float mnL = -mn * C2;
#pragma unroll
    for (int r = 0; r < 16; ++r) p0[r] = fmaf(p0[r], C2, mnL);
#pragma unroll
    for (int r = 0; r < 16; ++r) p1[r] = fmaf(p1[r], C2, mnL);
#pragma unroll
    for (int r = 0; r < 16; ++r) p0[r] = __builtin_amdgcn_exp2f(p0[r]);
}
__device__ __forceinline__ void finishSM(f32x16& p0, f32x16& p1, float alpha, float& l_reg, bf16x8& pa0, bf16x8& pa1, bf16x8& pa2, bf16x8& pa3) {
#pragma unroll
    for (int r = 0; r < 16; ++r) p1[r] = __builtin_amdgcn_exp2f(p1[r]);
    float ps = 0;
#pragma unroll
    for (int r = 0; r < 16; ++r) ps += p0[r];
#pragma unroll
    for (int r = 0; r < 16; ++r) ps += p1[r];
    { auto rr = __builtin_amdgcn_permlane32_swap(__float_as_uint(ps), __float_as_uint(ps), false, false); ps = __uint_as_float(rr[0]) + __uint_as_float(rr[1]); }
    l_reg = l_reg * alpha + ps;
#define ATT_PK4(P, B_, OUT) do { unsigned a0 = cvtpk(P[B_+0], P[B_+1]), a1 = cvtpk(P[B_+2], P[B_+3]);                          \
        unsigned b0 = cvtpk(P[B_+4], P[B_+5]), b1 = cvtpk(P[B_+6], P[B_+7]);                                             \
        auto r0 = __builtin_amdgcn_permlane32_swap(a0, b0, false, false); auto r1 = __builtin_amdgcn_permlane32_swap(a1, b1, false, false); \
        u32x4 w = {r0[0], r1[0], r0[1], r1[1]}; OUT = __builtin_bit_cast(bf16x8, w); } while (0)
    ATT_PK4(p0, 0, pa0); ATT_PK4(p0, 8, pa1); ATT_PK4(p1, 0, pa2); ATT_PK4(p1, 8, pa3);
#undef ATT_PK4
}
__device__ __forceinline__ void qkt(f32x16& p0, f32x16& p1, ATT_LAS const char* lds, int kbuf, int r32, int hi, const bf16x8* qr) {
    p0 = f32x16{}; p1 = f32x16{};
    ATT_LAS const char* kb[4];
#pragma unroll
    for (int dd = 0; dd < 4; ++dd) kb[dd] = lds + OFF_KN + kbuf * SHM_KN + ATT_KSWZ(r32, (dd * 16 + hi * 8) * 2);
#pragma unroll
    for (int d0 = 0; d0 < 8; ++d0) { ATT_LAS const char* a = kb[d0 & 3] + (d0 >> 2) * 128;
        const bf16x8 b0 = *(ATT_LAS const bf16x8*)a;
        const bf16x8 b1 = *(ATT_LAS const bf16x8*)(a + 32 * 256);
        p0 = __builtin_amdgcn_mfma_f32_32x32x16_bf16(b0, qr[d0], p0, 0, 0, 0);
        p1 = __builtin_amdgcn_mfma_f32_32x32x16_bf16(b1, qr[d0], p1, 0, 0, 0); }
#pragma unroll
    for (int d1 = 0; d1 < 4; ++d1) { ATT_LAS const char* a = lds + OFF_KP + kbuf * SHM_KP + ATT_KPSWZ(r32, 2 * d1 + hi);
        const bf16x8 b0 = *(ATT_LAS const bf16x8*)a;
        const bf16x8 b1 = *(ATT_LAS const bf16x8*)(a + 32 * 128);
        p0 = __builtin_amdgcn_mfma_f32_32x32x16_bf16(b0, qr[8 + d1], p0, 0, 0, 0);
        p1 = __builtin_amdgcn_mfma_f32_32x32x16_bf16(b1, qr[8 + d1], p1, 0, 0, 0); }
}
__device__ __forceinline__ void pv_tile(f32x16* o, int vb0, bf16x8 pa0, bf16x8 pa1, bf16x8 pa2, bf16x8 pa3) {
#define ATT_TRRD(dst, off) asm volatile("ds_read_b64_tr_b16 %0, %1 offset:%2" : "=&v"(dst) : "v"(vb0), "i"(off) : "memory")
#define ATT_PV_RD(S, d0) do { constexpr int b_ = OFF_V + v_rd_off(d0, 0, 0); \
        ATT_TRRD(S##l0, b_); ATT_TRRD(S##h0, b_ + 2048); ATT_TRRD(S##l1, b_ + 4096); ATT_TRRD(S##h1, b_ + 6144); ATT_TRRD(S##l2, b_ + 8192); ATT_TRRD(S##h2, b_ + 10240); ATT_TRRD(S##l3, b_ + 12288); ATT_TRRD(S##h3, b_ + 14336); } while (0)
#define ATT_PV_MM(S, d0) do { \
        o[d0] = __builtin_amdgcn_mfma_f32_32x32x16_bf16(pa0, (bf16x8){S##l0[0], S##l0[1], S##l0[2], S##l0[3], S##h0[0], S##h0[1], S##h0[2], S##h0[3]}, o[d0], 0, 0, 0);   \
        o[d0] = __builtin_amdgcn_mfma_f32_32x32x16_bf16(pa1, (bf16x8){S##l1[0], S##l1[1], S##l1[2], S##l1[3], S##h1[0], S##h1[1], S##h1[2], S##h1[3]}, o[d0], 0, 0, 0);   \
        o[d0] = __builtin_amdgcn_mfma_f32_32x32x16_bf16(pa2, (bf16x8){S##l2[0], S##l2[1], S##l2[2], S##l2[3], S##h2[0], S##h2[1], S##h2[2], S##h2[3]}, o[d0], 0, 0, 0);   \
        o[d0] = __builtin_amdgcn_mfma_f32_32x32x16_bf16(pa3, (bf16x8){S##l3[0], S##l3[1], S##l3[2], S##l3[3], S##h3[0], S##h3[1], S##h3[2], S##h3[3]}, o[d0], 0, 0, 0); } while (0)
#define ATT_LGK(n) do { asm volatile("s_waitcnt lgkmcnt(" #n ")" ::: "memory"); ATT_SBAR(); } while (0)
    s16x4 Al0, Al1, Al2, Al3, Ah0, Ah1, Ah2, Ah3, Bl0, Bl1, Bl2, Bl3, Bh0, Bh1, Bh2, Bh3;
    ATT_PV_RD(A, 0);
    ATT_PV_RD(B, 1); ATT_LGK(8); ATT_PV_MM(A, 0); ATT_SBAR();
    ATT_PV_RD(A, 2); ATT_LGK(8); ATT_PV_MM(B, 1); ATT_SBAR();
    ATT_PV_RD(B, 3); ATT_LGK(8); ATT_PV_MM(A, 2); ATT_SBAR();
    ATT_LGK(0); ATT_PV_MM(B, 3);
#undef ATT_LGK
#undef ATT_PV_MM
#undef ATT_PV_RD
#undef ATT_TRRD
}
__device__ __forceinline__ void attn_unit(int b, int h, int qb, const bf16* __restrict__ Q, const bf16* __restrict__ KN, const bf16* __restrict__ KPE, const bf16* __restrict__ V, bf16* __restrict__ O, ATT_LAS char* lds, int wave_id) {
    unsigned m1_ = ~0u; asm volatile("" : "+s"(m1_)); int tid_ = wave_id * 64 + (int)__builtin_amdgcn_mbcnt_hi(m1_, __builtin_amdgcn_mbcnt_lo(m1_, 0u)); asm volatile("" : "+v"(tid_));
    const int tid = tid_, wid = __builtin_amdgcn_readfirstlane(tid >> 6), lane = tid & 63, r32 = lane & 31, hi = lane >> 5;
    const size_t rowbase = (size_t)b * SEQ; const int q0 = qb * QB, NT = (q0 + QB) / KVBLK;
    const int qlo = q0 + wid * QBLK, qm = qlo + r32 - 4 * hi;
    ATT_LAS float* ws = (ATT_LAS float*)(lds + OFF_WS) + wid * 64; ATT_LAS float* li_l = ws; ATT_LAS float* al_l = ws + 32;
    const int sr = tid >> 4, sc = (tid & 15) * 8, vst0 = v_st(sr, sc), vst1 = v_st(32 + sr, sc), kws = ATT_KSWZ(sr, sc * 2);
    const int pr = tid >> 3, pc = tid & 7, kpw = ATT_KPSWZ(pr, pc);
    const bf16* gK = KN + (rowbase + sr) * KPITCH + h * 128 + sc;
    const bf16* gV = V + (rowbase + sr) * KPITCH + h * 128 + sc;
    const bf16* gP = KPE + (rowbase + pr) * PEPITCH + pc * 8;
    const int vb0 = (int)(uintptr_t)lds + v_rd_base(lane);
    bf16x8 st_k0, st_k1, st_v0, st_v1, st_p;
#define ATT_SLOAD(t) do { const size_t ko_ = (size_t)(t) * KVBLK; st_v0 = *(const bf16x8*)(gV + ko_ * KPITCH); st_v1 = *(const bf16x8*)(gV + (ko_ + 32) * KPITCH); \
        st_k0 = *(const bf16x8*)(gK + ko_ * KPITCH); st_k1 = *(const bf16x8*)(gK + (ko_ + 32) * KPITCH); st_p = *(const bf16x8*)(gP + ko_ * PEPITCH); } while (0)
#define ATT_SWRITE(kbf, vbf) do { *(ATT_LAS bf16x8*)(lds + OFF_V + (vbf) * SHM_V + vst0) = st_v0; *(ATT_LAS bf16x8*)(lds + OFF_V + (vbf) * SHM_V + vst1) = st_v1; \
        *(ATT_LAS bf16x8*)(lds + OFF_KN + (kbf) * SHM_KN + kws) = st_k0; *(ATT_LAS bf16x8*)(lds + OFF_KN + (kbf) * SHM_KN + kws + 32 * 256) = st_k1; \
        *(ATT_LAS bf16x8*)(lds + OFF_KP + (kbf) * SHM_KP + kpw) = st_p; } while (0)
#define ATT_VMW() asm volatile("s_waitcnt vmcnt(0)" ::: "memory")
    bf16x8 qr[12];
    { const bf16* Qw = Q + (rowbase + qlo + r32) * QPITCH + h * QHEAD + hi * 8;
#pragma unroll
      for (int d0 = 0; d0 < 12; ++d0) qr[d0] = *(const bf16x8*)(Qw + d0 * 16); }
    ATT_SLOAD(0); ATT_VMW(); ATT_SWRITE(0, 0); __syncthreads();
    float m_reg = -1e30f, l_reg = 0.f; f32x16 o[4] = {};
#define ATT_RESC(a) do { if (__any((a) < 1.f)) { if (hi == 0) al_l[r32] = (a); asm volatile("s_waitcnt lgkmcnt(0)" ::: "memory");              \
        _Pragma("unroll") for (int d_ = 0; d_ < 4; ++d_) _Pragma("unroll") for (int r = 0; r < 16; ++r) o[d_][r] *= al_l[crow(r, hi)]; } } while (0)
    const bool grpB = wid >= 4;
    bf16x8 pa0 = {}, pa1 = {}, pa2 = {}, pa3 = {};
    bool act_prev = false; int kbuf = 0, vbuf = 0, vprev = 0;
    for (int t = 0; t < NT; ++t) {
        const int vnext = (vbuf == 2) ? 0 : vbuf + 1;
        if (t + 1 < NT) ATT_SLOAD(t + 1);
        ATT_SBAR();
        const int kb_ = t * KVBLK; const bool act = kb_ <= qlo + QBLK - 1;
        if (grpB && act_prev) { pv_tile(o, vb0 + vprev * SHM_V, pa0, pa1, pa2, pa3); ATT_SBAR(); }
        if (act) {
            f32x16 p0, p1; qkt(p0, p1, lds, kbuf, r32, hi, qr);
            if (kb_ + KVBLK - 1 > qlo) mask_tile(p0, p1, qm - kb_);
            float mn, alpha; partialSM(p0, p1, m_reg, mn, alpha);
            ATT_RESC(alpha);
            finishSM(p0, p1, alpha, l_reg, pa0, pa1, pa2, pa3); ATT_SBAR();
            if (!grpB) pv_tile(o, vb0 + vbuf * SHM_V, pa0, pa1, pa2, pa3); }
        ATT_SBAR();
        if (t + 1 < NT) { ATT_VMW(); ATT_SWRITE(kbuf ^ 1, vnext); }
        __syncthreads();
        act_prev = act; vprev = vbuf; vbuf = vnext; kbuf ^= 1;
    }
    if (grpB && act_prev) pv_tile(o, vb0 + vprev * SHM_V, pa0, pa1, pa2, pa3);
    if (hi == 0) li_l[r32] = l_reg; asm volatile("s_waitcnt lgkmcnt(0)" ::: "memory");
    float rli[16];
#pragma unroll
    for (int r = 0; r < 16; ++r) rli[r] = __builtin_amdgcn_rcpf(li_l[crow(r, hi)]);
    bf16* Ow = O + (rowbase + qlo) * OPITCH + h * 128;
#pragma unroll
    for (int r = 0; r < 16; ++r) { const int orow = crow(r, hi);
#pragma unroll
        for (int d0 = 0; d0 < 4; ++d0) { const float v = o[d0][r] * rli[r]; const float vn = __shfl_xor(v, 1);
            if ((r32 & 1) == 0) *(unsigned*)(Ow + (size_t)orow * OPITCH + d0 * 32 + r32) = cvtpk(v, vn); } }
    __syncthreads();
#undef ATT_SLOAD
#undef ATT_SWRITE
#undef ATT_VMW
#undef ATT_RESC
}
}
#ifndef MK_N_LAUNCHES
#define MK_N_LAUNCHES 1
#endif
constexpr int NWAVES = 8;
constexpr int NB = 8, SEQ = 2048, M = NB * SEQ, D = 2048, DFF = 5632, LW = 1024, NHD = 16, KVR = 512, INW = 14912, INWP = 15104, MODW = 9 * 2048, NL = 2;
constexpr float EPS = 1e-6f;
constexpr int PPL = 9, N_PHASES = 3 + PPL * NL;
constexpr int CBW = 15104;
constexpr size_t MiB = 1u << 20;
constexpr size_t WS_CTL = 0, CTL_ZERO_BYTES = 4 * MiB;
constexpr size_t WS_SSQ = 12 * MiB + 768 * 1024;
constexpr size_t WS_SSQN = 12 * MiB;
constexpr size_t WS_WSC = 32768;
constexpr size_t WS_CB = 1 * MiB;
constexpr size_t WS_MOD = 4 * MiB;
constexpr size_t WS_COS = 6 * MiB, WS_SIN = 8 * MiB;
constexpr size_t WS_AGG = 10 * MiB;
constexpr size_t WS_WAX = 11 * MiB;
constexpr size_t WS_W = 16 * MiB, W_LAYER = 219 * MiB;
#ifndef FP8_Q
#define FP8_Q 1
#endif
#ifndef FP8_ALL
#define FP8_ALL 0
#endif
#ifndef FP8_DN
#define FP8_DN 15
#endif
constexpr bool fp8_dn(int l, int f) { return ((FP8_DN >> (2 * l + f)) & 1) != 0; }
#ifndef FP8_G4
#define FP8_G4 0
#endif
#ifndef G1_BF16
#define G1_BF16 1
#endif
constexpr int WIN_QF8 = FP8_Q, WINB_REAL = FP8_ALL ? 0 : (WIN_QF8 ? 5696 : 8768), WINB_PADEND = FP8_ALL ? 0 : (WIN_QF8 ? 5888 : 8960), WINB_ROWS = G1_BF16 ? 7936 : WINB_PADEND, WINF_ROWS = FP8_ALL ? 15104 : (WIN_QF8 ? (G1_BF16 ? 7168 : 9216) : 6144);
static_assert(!G1_BF16 || (FP8_Q && !FP8_ALL), "G1_BF16 needs the q + gates fp8 split");
constexpr size_t WO_WIN8 = FP8_ALL ? 132 * MiB : 168 * MiB;
constexpr size_t WO_W13 = 0, WO_W2 = 88 * MiB, WO_WIN = 132 * MiB, WO_WCAT = 191 * MiB  , WO_LRUO = WO_WCAT, WO_SCO = WO_WCAT + 1024 * 2, WO_MLAO = WO_WCAT + 2048 * 2, WO_UKV = 207 * MiB, WO_WO = 211 * MiB;
constexpr int YP = 4096;
constexpr size_t WS_HN = 456 * MiB;
constexpr size_t WS_LRUX = 520 * MiB, WS_LRUG = 552 * MiB, WS_SCB = 584 * MiB, WS_SCC = 616 * MiB, WS_SCX = 648 * MiB, WS_Q = 680 * MiB, WS_KVLAT = 776 * MiB, WS_GATES = 792 * MiB, WS_KPE = 984 * MiB;
constexpr size_t WS_ACT = 520 * MiB;
constexpr size_t WS_KN = 986 * MiB, WS_V = 1050 * MiB;
constexpr size_t WS_R = 456 * MiB, WS_GX = 488 * MiB;
constexpr size_t WS_YCAT = 1114 * MiB, WS_YLRU = WS_YCAT, WS_YSC = WS_YCAT + 1024 * 2, WS_ATT = WS_YCAT + 2048 * 2;
constexpr size_t WS_MERGED = 520 * MiB;
constexpr size_t WS_XH = 1242 * MiB;
constexpr size_t WS_A8 = 1306 * MiB;
constexpr size_t WS_END = 1338 * MiB;
static_assert(WS_W + NL * W_LAYER <= WS_HN && WS_ACT + (size_t)M * DFF * 2 <= WS_KN && WS_KPE + (size_t)M * 64 * 2 <= WS_KN && WS_YCAT + (size_t)M * YP * 2 <= WS_XH && WS_GX + (size_t)M * LW * 2 <= WS_LRUX && WS_XH + (size_t)M * D * 2 <= WS_A8 && WS_A8 + (size_t)M * D <= WS_END, "d_ws map");
static_assert(WS_SSQN + (size_t)NL * 3 * M * 8 <= WS_SSQ && WS_SSQ + (size_t)NL * M * 8 <= WS_W && WS_WAX + (size_t)NL * 2 * 8 * 16384 * 2 <= WS_SSQN && WS_CB + (size_t)NL * 3 * NB * CBW * 4 <= CTL_ZERO_BYTES && WS_MOD + (size_t)NL * NB * MODW * 4 <= WS_COS, "zeroed region map");
constexpr int CW_TMO = 0, CW_CODE = 1, CW_BAR = 4096;
constexpr int RING_OFF = 0, RING_BYTES = 131072;
constexpr int LDSCTL_OFF = RING_BYTES, MISC_OFF = LDSCTL_OFF + 320;
constexpr int LDS_BYTES = 147456;
#define GAS __attribute__((address_space(1)))
#define LAS __attribute__((address_space(3)))
typedef unsigned short bf16;
typedef unsigned v4u __attribute__((ext_vector_type(4)));
typedef unsigned v2u __attribute__((ext_vector_type(2)));
typedef float f32x4 __attribute__((ext_vector_type(4)));
typedef short bf16x8 __attribute__((ext_vector_type(8)));
typedef GAS unsigned gu32;
#define RLX_AGENT __ATOMIC_RELAXED, __HIP_MEMORY_SCOPE_AGENT
#define LDS_WAIT() asm volatile("s_waitcnt lgkmcnt(0)" ::: "memory")
#define VM_WAIT() asm volatile("s_waitcnt vmcnt(0)" ::: "memory")
__device__ __forceinline__ unsigned f2bf(float f) { unsigned u = __builtin_bit_cast(unsigned, f); return (u + 0x7fffu + ((u >> 16) & 1u)) >> 16; }
__device__ __forceinline__ unsigned pk2(float lo, float hi) { return f2bf(lo) | (f2bf(hi) << 16); }
__device__ __forceinline__ float bf2f(unsigned short b) { return __uint_as_float((unsigned)b << 16); }
__device__ __forceinline__ void unpack8(const v4u w, float (&f)[8]) {
    f[0] = __uint_as_float(w.x << 16); f[1] = __uint_as_float(w.x & 0xffff0000u); f[2] = __uint_as_float(w.y << 16); f[3] = __uint_as_float(w.y & 0xffff0000u);
    f[4] = __uint_as_float(w.z << 16); f[5] = __uint_as_float(w.z & 0xffff0000u); f[6] = __uint_as_float(w.w << 16); f[7] = __uint_as_float(w.w & 0xffff0000u); }
__device__ __forceinline__ v4u pack8(const float (&f)[8]) { v4u w; w.x = pk2(f[0], f[1]); w.y = pk2(f[2], f[3]); w.z = pk2(f[4], f[5]); w.w = pk2(f[6], f[7]); return w; }

#define XB_TMO      128
#define XB_XCNT(j)  (256  + 64 * (j))
#define XB_XSUB(j)  (1280 + 64 * (j))
#define XB_XGEN(j)  (2304 + 64 * (j))
#define XB_TOP      3328
#define XB_TOPGEN   3392
#define XCD_BAR_WORDS 3456
#define XB_SPIN_CAP (1u << 18)

__device__ __forceinline__ unsigned xb_ld(unsigned* p)              { return __hip_atomic_load(p, __ATOMIC_RELAXED, __HIP_MEMORY_SCOPE_AGENT); }
__device__ __forceinline__ unsigned xb_add(unsigned* p, unsigned v) { return __hip_atomic_fetch_add(p, v, __ATOMIC_RELAXED, __HIP_MEMORY_SCOPE_AGENT); }
__device__ __forceinline__ unsigned xb_xcc_id() { return (unsigned)__builtin_amdgcn_s_getreg((3 << 11) | 20) & 0xFu; }
#define XB_SPIN(cond, bar) do { unsigned _sp = 0; while (cond) { __builtin_amdgcn_s_sleep(1); \
    if ((++_sp & 255u) == 0u) { if (xb_ld(&(bar)[XB_TMO])) break; if (_sp > XB_SPIN_CAP) { atomicAdd(&(bar)[XB_TMO], 1u); break; } } } } while (0)

struct XcdBarrier {
    unsigned* bar; unsigned x;
    volatile LAS unsigned* st;
};

__device__ __forceinline__ XcdBarrier xcd_barrier_post(unsigned* bar, volatile LAS unsigned* st) {
    XcdBarrier b; b.bar = bar; b.x = xb_xcc_id(); b.st = st;
    if (threadIdx.x == 0) (void)xb_add(&bar[XB_XCNT(b.x)], 1u);
    return b;
}
__device__ __forceinline__ void xcd_barrier_complete(unsigned* bar, unsigned x, unsigned& nloc, unsigned& nx) {
    const unsigned G = gridDim.x * gridDim.y * gridDim.z;
    unsigned sum, cnt, mine, sp = 0u;
    for (;;) {
        sum = 0u; cnt = 0u; mine = 0u;
#pragma unroll
        for (unsigned j = 0; j < 16; ++j) { const unsigned c = xb_ld(&bar[XB_XCNT(j)]); sum += c; cnt += (c > 0u) ? 1u : 0u; mine = (j == x) ? c : mine; }
        if (sum == G) break;
        __builtin_amdgcn_s_sleep(1);
        if ((++sp & 255u) == 0u) { if (xb_ld(&bar[XB_TMO])) break; if (sp > XB_SPIN_CAP) { atomicAdd(&bar[XB_TMO], 1u); break; } }
    }
    nloc = mine > 0u ? mine : 1u; nx = cnt > 0u ? cnt : 1u;
}

__device__ __forceinline__ void xcd_barrier(const XcdBarrier& b) {
    asm volatile("s_waitcnt vmcnt(0)" ::: "memory");
    __syncthreads();
    if (threadIdx.x == 0) {
        unsigned* bar = b.bar;
        __builtin_amdgcn_s_waitcnt(0);
        unsigned nloc = b.st[0], nx = b.st[1];
        if (nloc == 0u) { xcd_barrier_complete(bar, b.x, nloc, nx); b.st[0] = nloc; b.st[1] = nx; }
        const unsigned old = xb_add(&bar[XB_XSUB(b.x)], 1u);
        const unsigned gen = old / nloc;
        if (old + 1u == (gen + 1u) * nloc) {
            __builtin_amdgcn_fence(__ATOMIC_RELEASE, "agent");
            asm volatile("s_waitcnt vmcnt(0)" ::: "memory");
            const unsigned og = xb_add(&bar[XB_TOP], 1u);
            const unsigned tg = og / nx;
            if (og + 1u == (tg + 1u) * nx) xb_add(&bar[XB_TOPGEN], 1u);
            else XB_SPIN(xb_ld(&bar[XB_TOPGEN]) == tg, bar);
            __builtin_amdgcn_fence(__ATOMIC_ACQUIRE, "agent");
            xb_add(&bar[XB_XGEN(b.x)], 1u);
            asm volatile("s_waitcnt vmcnt(0)" ::: "memory");
        } else {
            XB_SPIN(xb_ld(&bar[XB_XGEN(b.x)]) == gen, bar);
            __builtin_amdgcn_fence(__ATOMIC_ACQUIRE, "agent");
            asm volatile("s_waitcnt vmcnt(0)" ::: "memory");
        }
    }
    __syncthreads();
}
struct Frame {
    LAS unsigned char* lds; volatile LAS unsigned* MISC; gu32* ctl;
    int tid, lane, wave, vcu, G;
    GAS float* out; GAS unsigned char* ws;
};
typedef __attribute__((address_space(4))) const char* kaddr_t;
__device__ __forceinline__ const float* in_ptr(int i) { kaddr_t ka = (kaddr_t)__builtin_amdgcn_kernarg_segment_ptr(); asm volatile("" : "+s"(ka)); typedef GAS const float* cfp_t; typedef __attribute__((address_space(4))) const cfp_t* kpp_t; return (const float*)(*(kpp_t)(ka + 8 * i)); }
__device__ __forceinline__ GAS unsigned char* karg_ptr(int i) { kaddr_t ka = (kaddr_t)__builtin_amdgcn_kernarg_segment_ptr(); asm volatile("" : "+s"(ka)); typedef GAS unsigned char* gp_t; typedef __attribute__((address_space(4))) const gp_t* kpp_t; return *(kpp_t)(ka + 8 * i); }
enum { I_X = 0, I_C = 1, I_POS = 2, I_ADAW = 3, I_ADAB = 4, I_NORMG = 5, I_W13 = 6, I_W2 = 7, I_WIN = 8, I_LCW = 9, I_LCB = 10, I_LWA = 11, I_LBA = 12, I_LWX = 13, I_LBX = 14, I_LAM = 15,
       I_LOUT = 16, I_SCW = 17, I_SCOUT = 18, I_KVG = 19, I_UKV = 20, I_MLAO = 21, I_WO = 22, I_FING = 23 };
__device__ __forceinline__ float wave_sum(float v) {
#pragma unroll
    for (int o = 1; o < 64; o <<= 1) v += __shfl_xor(v, o);
    return v;
}
template <bool CB, bool F8 = false>
__device__ __forceinline__ void transpose_item(const float* W, int K, int N, bf16* WT, int dst_row0, int k0, int n0, const float* ks, LAS float* scr, int lane, const float* shp, float (&cbacc)[8], bool tiled = false, int ldk = 0) {
    float v[32];
    const GAS float* wp = (const GAS float*)W + (size_t)(k0 + (lane >> 5)) * N + n0 + (lane & 31);
#pragma unroll
    for (int i = 0; i < 32; ++i) { v[i] = *wp; wp += 2 * (size_t)N; asm volatile("" : "+v"(wp)); }
    if (CB) {
        LAS float* sht = scr + 64 * 33;
        float sv[8];
#pragma unroll
        for (int b = 0; b < 8; ++b) sv[b] = ((const GAS float*)shp)[(size_t)b * MODW + k0 + lane];
#pragma unroll
        for (int b = 0; b < 8; ++b) sht[(b * 2 + (lane & 1)) * 32 + (lane >> 1)] = sv[b];
        LDS_WAIT(); asm volatile("" ::: "memory");
#pragma unroll
        for (int b = 0; b < 8; ++b) { float a = 0.f;
#pragma unroll
            for (int i = 0; i < 32; ++i) a += sht[(b * 2 + (lane >> 5)) * 32 + i] * v[i];
            cbacc[b] += a; asm volatile("" ::: "memory"); }
    }
    if (ks) {
#pragma unroll
        for (int i = 0; i < 32; ++i) v[i] *= ks[k0 + 2 * i + (lane >> 5)]; }
#pragma unroll
    for (int i = 0; i < 32; ++i) scr[(2 * i + (lane >> 5)) * 33 + (lane & 31)] = v[i];
    LDS_WAIT(); asm volatile("" ::: "memory");
    const int c = lane & 7;
#pragma unroll
    for (int j = 0; j < 4; ++j) { const int n = (lane >> 3) + 8 * j; const LAS float* s = scr + (8 * c) * 33 + n;
        v4u o; o.x = pk2(s[0 * 33], s[1 * 33]); o.y = pk2(s[2 * 33], s[3 * 33]); o.z = pk2(s[4 * 33], s[5 * 33]); o.w = pk2(s[6 * 33], s[7 * 33]);
        const int rr = dst_row0 + n;
        if constexpr (F8) { unsigned w0 = 0, w1 = 0;
            w0 = __builtin_amdgcn_cvt_pk_fp8_f32(pg8::sat8(s[0 * 33] * 64.f), pg8::sat8(s[1 * 33] * 64.f), w0, false); w0 = __builtin_amdgcn_cvt_pk_fp8_f32(pg8::sat8(s[2 * 33] * 64.f), pg8::sat8(s[3 * 33] * 64.f), w0, true);
            w1 = __builtin_amdgcn_cvt_pk_fp8_f32(pg8::sat8(s[4 * 33] * 64.f), pg8::sat8(s[5 * 33] * 64.f), w1, false); w1 = __builtin_amdgcn_cvt_pk_fp8_f32(pg8::sat8(s[6 * 33] * 64.f), pg8::sat8(s[7 * 33] * 64.f), w1, true);
            *(GAS v2u*)((GAS unsigned char*)WT + (size_t)rr * (ldk ? ldk : K) + k0 + 8 * c) = (v2u){w0, w1}; } else {
        const size_t eo = tiled ? ((size_t)(rr >> 8) * (K >> 6) + (k0 >> 6)) * 16384 + (size_t)(rr & 255) * 64 + 8 * c : (size_t)rr * (ldk ? ldk : K) + k0 + 8 * c;
        *(GAS v4u*)(WT + eo) = o; } }
    LDS_WAIT(); asm volatile("" ::: "memory");
}
typedef float p0_f32x16 __attribute__((ext_vector_type(16)));
template <bool F8>
__device__ __forceinline__ void transpose_item_cb(const float* W, int K, int N, bf16* WT, int dst_row0, int k0, int n0, LAS unsigned* scr, int lane, const float* shp, p0_f32x16& acc, float isw = 0.f) {
    const int h = lane >> 5, n = lane & 31;
    float v[32];
    const GAS float* wp = (const GAS float*)W + (size_t)(k0 + 32 * h) * N + n0 + n;
#pragma unroll
    for (int i = 0; i < 32; ++i) { v[i] = *wp; wp += (size_t)N; asm volatile("" : "+v"(wp)); }
    const GAS float* sp = (const GAS float*)shp + (size_t)(n & 7) * MODW + k0 + 32 * h;
    f32x4 sa[8];
#pragma unroll
    for (int j = 0; j < 8; ++j) sa[j] = *(const GAS f32x4*)(sp + 4 * j);
    const float msk = n < 8 ? 1.0f : 0.0f;
    unsigned w[16];
#pragma unroll
    for (int t = 0; t < 16; ++t) w[t] = pg8::cvt_pk_bf16(v[2 * t], v[2 * t + 1]);
#pragma unroll
    for (int j = 0; j < 4; ++j) { const f32x4 s0 = sa[2 * j] * msk, s1 = sa[2 * j + 1] * msk;
        v4u a; a.x = pg8::cvt_pk_bf16(s0[0], s0[1]); a.y = pg8::cvt_pk_bf16(s0[2], s0[3]); a.z = pg8::cvt_pk_bf16(s1[0], s1[1]); a.w = pg8::cvt_pk_bf16(s1[2], s1[3]);
        v4u b; b.x = w[4 * j]; b.y = w[4 * j + 1]; b.z = w[4 * j + 2]; b.w = w[4 * j + 3];
        acc = __builtin_amdgcn_mfma_f32_32x32x16_bf16(__builtin_bit_cast(bf16x8, a), __builtin_bit_cast(bf16x8, b), acc, 0, 0, 0); }
    if constexpr (F8) {
#pragma unroll
        for (int t = 0; t < 8; ++t) scr[(8 * h + t) * 33 + n] = pg8::pk4_i8(v[4 * t] * isw, v[4 * t + 1] * isw, v[4 * t + 2] * isw, v[4 * t + 3] * isw);
        LDS_WAIT(); asm volatile("" ::: "memory");
        const int c = lane & 3;
#pragma unroll
        for (int jj = 0; jj < 2; ++jj) { const int nn = (lane >> 2) + 16 * jj; const LAS unsigned* s = scr + (4 * c) * 33 + nn;
            v4u o; o.x = s[0]; o.y = s[33]; o.z = s[66]; o.w = s[99];
            *(GAS v4u*)((GAS unsigned char*)WT + (size_t)(dst_row0 + nn) * K + k0 + 16 * c) = o; }
    } else {
#pragma unroll
        for (int t = 0; t < 16; ++t) scr[(16 * h + t) * 33 + n] = w[t];
        LDS_WAIT(); asm volatile("" ::: "memory");
        const int c = lane & 7;
#pragma unroll
        for (int jj = 0; jj < 4; ++jj) { const int nn = (lane >> 3) + 8 * jj; const LAS unsigned* s = scr + (4 * c) * 33 + nn;
            v4u o; o.x = s[0]; o.y = s[33]; o.z = s[66]; o.w = s[99];
            *(GAS v4u*)(WT + (size_t)(dst_row0 + nn) * K + k0 + 8 * c) = o; }
    }
    LDS_WAIT(); asm volatile("" ::: "memory");
}
#ifndef W2_TILED
#define W2_TILED false
#endif
constexpr int TI_W13 = (D / 64) * (2 * DFF / 32), TI_W2 = (DFF / 64) * (D / 32), TI_WIN = (D / 64) * (INW / 32), TI_LRUO = (LW / 64) * (D / 32), TI_UKV = (KVR / 64) * (4096 / 32), TI_DD = (D / 64) * (D / 32), TI_WAX = 8 * 2 * 4;
constexpr int TH_W13 = TI_W13 / 4, TH_WIN = TI_WIN / 4, TH_LAYER = 2 * TH_W13 + TH_WIN;
constexpr int TL_LAYER = 2 * TI_W2 + 2 * TI_LRUO + TI_UKV + 2 * TI_DD + 2 * TI_WAX, TU_LAYER = TH_LAYER + TL_LAYER;
__device__ __forceinline__ void p0_weights(const Frame& F, int parts, bool dummy_cb = false) {
    LAS float* scr = (LAS float*)(F.lds + RING_OFF + F.wave * 16384);
    const int gw = F.vcu * NWAVES + F.wave, NGW = F.G * NWAVES;
    if (parts & 1)
    for (int it = gw; it < NL * TH_LAYER; it += NGW) {
        const int l = it / TH_LAYER; int r = it - l * TH_LAYER;
        GAS unsigned char* wl = F.ws + WS_W + (size_t)l * W_LAYER;
        const float* W; bf16* WT; int N, mode, site;
        if (r < 2 * TH_W13) { const int f = r / TH_W13; r -= f * TH_W13; W = in_ptr(I_W13) + (size_t)(l * 2 + f) * D * 2 * DFF; N = 2 * DFF; WT = (bf16*)(wl + WO_W13 + (size_t)f * 44 * MiB); mode = 1; site = f ? 2 : 0; }
        else { r -= 2 * TH_W13; W = in_ptr(I_WIN) + (size_t)l * D * INW; N = INW; WT = (bf16*)(wl + WO_WIN); mode = 2; site = 1; }
        bool f8 = (mode == 1) && (site == 2) && ((FP8_G4 >> l) & 1); int cbi;
        const int nblk = N / 32, kq = r / nblk, nb = r - kq * nblk, n0 = 32 * nb; int dst = n0;
        if (mode == 1) { const int bj = n0 >= DFF ? 1 : 0, j = n0 - bj * DFF; dst = 256 * (j >> 7) + 128 * bj + (j & 127); }
        else {
            if (FP8_ALL) { dst = n0 < 8704 ? n0 : (n0 < 8768 ? 14848 + (n0 - 8704) : 8704 + (n0 - 8768)); f8 = true; }
            else if (WIN_QF8) { if (n0 < 5120) dst = n0; else if (n0 < 8192) { dst = n0 - 5120; f8 = true; } else if (n0 < 8704) dst = 5120 + (n0 - 8192); else if (n0 < 8768) dst = 5632 + (n0 - 8704); else if (G1_BF16 && n0 >= 8768 + 2048 && n0 < 8768 + 4096) dst = WINB_PADEND + (n0 - 8768 - 2048); else if (G1_BF16 && n0 >= 8768 + 4096) { dst = 5120 + (n0 - 8768 - 4096); f8 = true; } else { dst = 3072 + (n0 - 8768); f8 = true; } }
            else { if (n0 < 8768) dst = n0; else { dst = n0 - 8768; f8 = true; } }
            if (f8) WT = (bf16*)(wl + WO_WIN8); }
        cbi = (mode == 2 && f8) ? WINB_ROWS + dst : dst;
        const float* shp = (const float*)(F.ws + WS_MOD) + (size_t)l * NB * MODW + (site == 0 ? 0 : site == 1 ? 6144 : 12288);
        p0_f32x16 cbacc;
#pragma unroll
        for (int r4 = 0; r4 < 16; ++r4) cbacc[r4] = 0.f;
        if (f8) {
#pragma unroll 1
            for (int j = 0; j < 4; ++j) transpose_item_cb<true>(W, D, N, WT, dst, 64 * (4 * kq + j), n0, (LAS unsigned*)scr, F.lane, shp, cbacc, ((const GAS float*)(F.ws + WS_WSC))[(l * 2 + (mode == 1 ? 1 : 0)) * 2 + 1]);
        } else {
#pragma unroll 1
            for (int j = 0; j < 4; ++j) transpose_item_cb<false>(W, D, N, WT, dst, 64 * (4 * kq + j), n0, (LAS unsigned*)scr, F.lane, shp, cbacc); }
        int* cbp = (int*)(F.ws + (dummy_cb ? WS_KN : WS_CB)) + (size_t)((l * 3 + site) * NB + 4 * (F.lane >> 5)) * CBW + cbi + (F.lane & 31);
#pragma unroll
        for (int r4 = 0; r4 < 4; ++r4) atomicAdd(cbp + (size_t)r4 * CBW, (int)__builtin_rintf(cbacc[r4] * pg8::CB_ENC));
    }
    if (parts & 2)
    for (int it = gw; it < NL * TL_LAYER; it += NGW) {
        const int l = it / TL_LAYER; int r = it - l * TL_LAYER;
        GAS unsigned char* wl = F.ws + WS_W + (size_t)l * W_LAYER;
        const float* W; bf16* WT; const float* ks = nullptr; int K, N, ldk = 0; float dummy[8]; bool tiled = false;
        bool f8w = false;
        if (r < 2 * TI_W2) { tiled = W2_TILED; const int f = r / TI_W2; r -= f * TI_W2; W = in_ptr(I_W2) + (size_t)(l * 2 + f) * DFF * D; K = DFF; N = D; WT = (bf16*)(wl + WO_W2 + (size_t)f * 22 * MiB); f8w = ((FP8_DN >> (2 * l + f)) & 1) != 0; }
        else if ((r -= 2 * TI_W2) < TI_LRUO) { W = in_ptr(I_LOUT) + (size_t)l * LW * D; K = LW; N = D; WT = (bf16*)(wl + WO_LRUO); ldk = YP; }
        else if ((r -= TI_LRUO) < TI_LRUO) { W = in_ptr(I_SCOUT) + (size_t)l * LW * D; K = LW; N = D; WT = (bf16*)(wl + WO_SCO); ldk = YP; }
        else if ((r -= TI_LRUO) < TI_UKV) { W = in_ptr(I_UKV) + (size_t)l * KVR * 4096; K = KVR; N = 4096; WT = (bf16*)(wl + WO_UKV); ks = in_ptr(I_KVG) + l * KVR; }
        else if ((r -= TI_UKV) < TI_DD) { W = in_ptr(I_MLAO) + (size_t)l * D * D; K = D; N = D; WT = (bf16*)(wl + WO_MLAO); ldk = YP; }
        else if ((r -= TI_DD) < TI_DD) { W = in_ptr(I_WO) + (size_t)l * D * D; K = D; N = D; WT = (bf16*)(wl + WO_WO); }
        else { r -= TI_DD; const int which = r / TI_WAX; r -= which * TI_WAX; const int g = r >> 3; r &= 7;
               W = in_ptr(which ? I_LWX : I_LWA) + ((size_t)l * 8 + g) * 16384; K = 128; N = 128; WT = (bf16*)(F.ws + WS_WAX) + ((size_t)(l * 2 + which) * 8 + g) * 16384; }
        const int nblk = N / 32, kb = r / nblk, nb = r - kb * nblk, n0 = 32 * nb;
        if (FP8_DN != 0 && f8w) transpose_item<false, true>(W, K, N, WT, n0, 64 * kb, n0, nullptr, scr, F.lane, nullptr, dummy);
        else transpose_item<false>(W, K, N, WT, n0, 64 * kb, n0, ks, scr, F.lane, nullptr, dummy, tiled, ldk);
    }
    if (parts & 2) { const int gt = (F.vcu * NWAVES + F.wave) * 64 + F.lane, NT = F.G * NWAVES * 64; constexpr int per = FP8_ALL ? 192 * D / 16 : (WINB_PADEND - WINB_REAL) * D * 2 / 16; constexpr size_t pbase = FP8_ALL ? WO_WIN8 + (size_t)14912 * D : WO_WIN + (size_t)WINB_REAL * D * 2;
      for (int i = gt; i < NL * per; i += NT) { const int l = i / per, j = i - l * per; *(GAS v4u*)(F.ws + WS_W + (size_t)l * W_LAYER + pbase + (size_t)j * 16) = (v4u){0u, 0u, 0u, 0u}; } }
    if (parts & 2) { const int gt = (F.vcu * NWAVES + F.wave) * 64 + F.lane, NT = F.G * NWAVES * 64; const int* pos = (const int*)in_ptr(I_POS); float* COS = (float*)(F.ws + WS_COS); float* SIN = (float*)(F.ws + WS_SIN);
      for (int i = gt; i < M * 32; i += NT) { const int row = i >> 5, j = i & 31; const float inv = __builtin_amdgcn_exp2f(-(float)j * (13.287712379549449f / 32.0f)); const float ang = (float)pos[row] * inv;
          const double t = (double)ang * 0.15915494309189535; const float fr = (float)(t - __builtin_rint(t)); COS[i] = __builtin_amdgcn_cosf(fr); SIN[i] = __builtin_amdgcn_sinf(fr); } }
}
__device__ __forceinline__ void p0_wscale(const Frame& F) {
    if ((int)blockIdx.x < NL * 2 && F.wave == 0) { const int l = (int)blockIdx.x >> 1, which = (int)blockIdx.x & 1;
        const float* W = which ? in_ptr(I_W13) + (size_t)(l * 2 + 1) * D * 2 * DFF : in_ptr(I_WIN) + (size_t)l * D * INW;
        float s = 0.f;
#pragma unroll 8
        for (int i = 0; i < 64; ++i) { const float w = W[i * 64 + F.lane]; s += w * w; }
        s = wave_sum(s);
        if (F.lane == 0) { const float sw = 4.0f * sqrtf(s * (1.0f / 4096.0f) + 1e-30f) * (1.0f / 127.0f); GAS float* o = (GAS float*)(F.ws + WS_WSC) + ((size_t)l * 2 + which) * 2; o[0] = sw; o[1] = 1.0f / sw; } }
}
__device__ __forceinline__ void p0_mod(const Frame& F) {
    LAS float* sc = (LAS float*)(F.lds + RING_OFF); LAS float* red = (LAS float*)(F.lds + RING_OFF + 65536);
    for (int i = F.tid; i < NB * D; i += NWAVES * 64) { const float c = in_ptr(I_C)[i]; sc[i] = c / (1.0f + __expf(-c)); }
    __syncthreads();
    float* MOD = (float*)(F.ws + WS_MOD);
    for (int task = blockIdx.x; task < NL * (MODW / 64); task += F.G) {
        const int l = task / (MODW / 64), cg = task - l * (MODW / 64);
        const float* Wp = in_ptr(I_ADAW) + ((size_t)l * D + 256 * F.wave) * MODW + 64 * cg + F.lane;
        float acc[8];
#pragma unroll
        for (int b = 0; b < 8; ++b) acc[b] = 0.f;
#pragma unroll 4
        for (int k4 = 0; k4 < 256; k4 += 4) {
            const float w0 = Wp[(size_t)(k4 + 0) * MODW], w1 = Wp[(size_t)(k4 + 1) * MODW], w2 = Wp[(size_t)(k4 + 2) * MODW], w3 = Wp[(size_t)(k4 + 3) * MODW];
#pragma unroll
            for (int b = 0; b < 8; ++b) { const f32x4 s4 = *(const LAS f32x4*)(sc + b * D + 256 * F.wave + k4); acc[b] += (s4[0] * w0 + s4[1] * w1) + (s4[2] * w2 + s4[3] * w3); }
        }
#pragma unroll
        for (int b = 0; b < 8; ++b) red[(F.wave * 8 + b) * 64 + F.lane] = acc[b];
        __syncthreads();
        { const int b = F.wave; float s = 0.f;
#pragma unroll
          for (int w = 0; w < 8; ++w) s += red[(w * 8 + b) * 64 + F.lane];
          MOD[((size_t)l * NB + b) * MODW + 64 * cg + F.lane] = s + in_ptr(I_ADAB)[(size_t)l * MODW + 64 * cg + F.lane]; }
        __syncthreads();
    }
}
__device__ __forceinline__ unsigned pk2h(float lo, float hi) { return pg8::pk2_f16(lo, hi); }
__device__ __forceinline__ void operand0_phase(const Frame& F, const float* xin, const float* g, const float* scale, bf16* out, pg8::ssq_t* ssq, bf16* xh) {
    const int gw = F.vcu * NWAVES + F.wave, NGW = F.G * NWAVES, rpw = (M + NGW - 1) / NGW;
    const int r0 = gw * rpw, r1 = (r0 + rpw < M) ? r0 + rpw : M;
    int curb = -1; f32x4 gp[8];
    for (int row = r0; row < r1; ++row) {
        const int b = row >> 11;
        if (b != curb) { curb = b;
#pragma unroll
            for (int j = 0; j < 8; ++j) { const f32x4 g4 = ((const f32x4*)g)[F.lane + 64 * j]; const f32x4 s4 = ((const f32x4*)(scale + (size_t)b * MODW))[F.lane + 64 * j]; gp[j] = g4 * (s4 + 1.0f); } }
        const f32x4* xr = (const f32x4*)(xin + (size_t)row * D) + F.lane;
        f32x4 v[8]; float ss = 0.f;
#pragma unroll
        for (int j = 0; j < 8; ++j) { v[j] = xr[64 * j]; ss += (v[j][0] * v[j][0] + v[j][1] * v[j][1]) + (v[j][2] * v[j][2] + v[j][3] * v[j][3]); }
        ss = wave_sum(ss); if (F.lane == 0) ssq[row] = pg8::ssq_enc(ss);
        unsigned long long* o8 = (unsigned long long*)(out + (size_t)row * D) + F.lane; unsigned long long* h8 = (unsigned long long*)(xh + (size_t)row * D) + F.lane;
#pragma unroll
        for (int j = 0; j < 8; ++j) { const f32x4 o = v[j] * gp[j]; o8[64 * j] = (unsigned long long)pk2(o[0], o[1]) | ((unsigned long long)pk2(o[2], o[3]) << 32);
            h8[64 * j] = (unsigned long long)pk2h(v[j][0], v[j][1]) | ((unsigned long long)pk2h(v[j][2], v[j][3]) << 32); }
    }
}
__device__ __forceinline__ void final_norm_phase(const Frame& F, const bf16* xh, float* out, const float* g) {
    const int gw = F.vcu * NWAVES + F.wave, NGW = F.G * NWAVES;
    f32x4 g4[8];
#pragma unroll
    for (int j = 0; j < 8; ++j) g4[j] = ((const f32x4*)g)[F.lane + 64 * j];
    for (int row = gw; row < M; row += NGW) {
        const unsigned long long* xr = (const unsigned long long*)(xh + (size_t)row * D) + F.lane; f32x4* orow = (f32x4*)(out + (size_t)row * D) + F.lane;
        f32x4 v[8]; float ss = 0.f;
#pragma unroll
        for (int j = 0; j < 8; ++j) { const unsigned long long hv = xr[64 * j]; const unsigned w0 = (unsigned)hv, w1 = (unsigned)(hv >> 32); v[j] = (f32x4){pg8::h_lo(w0), pg8::h_hi(w0), pg8::h_lo(w1), pg8::h_hi(w1)};
            ss += (v[j][0] * v[j][0] + v[j][1] * v[j][1]) + (v[j][2] * v[j][2] + v[j][3] * v[j][3]); }
        const float rinv = 1.0f / sqrtf(wave_sum(ss) * (1.0f / D) + EPS);
#pragma unroll
        for (int j = 0; j < 8; ++j) orow[64 * j] = v[j] * rinv * g4[j];
    }
}
__device__ __forceinline__ float softplus_f(float z) {
    const float zn = z > 0.f ? -z : z; const float x = __expf(zn); const float u = 1.0f + x; const float l1p = (u == 1.0f) ? x : __logf(u) * (x / (u - 1.0f));
    return (z > 0.f ? z : 0.f) + l1p; }
__device__ __forceinline__ void lru_unit(const Frame& F, int l, int gck, int g) {
    LAS unsigned char* xr = F.lds + RING_OFF;
    const bf16* X = (const bf16*)(F.ws + WS_LRUX);
    const size_t row0 = (size_t)gck * 128; const int ck = gck & 15;
    {
        const int c8 = F.tid & 15, tq = F.tid >> 4, ch0 = 128 * g + 8 * c8;
        float w[4][8], bias[8];
#pragma unroll
        for (int k = 0; k < 4; ++k) { const f32x4 a = *(const f32x4*)(in_ptr(I_LCW) + ((size_t)l * 4 + k) * LW + ch0), b = *(const f32x4*)(in_ptr(I_LCW) + ((size_t)l * 4 + k) * LW + ch0 + 4);
            w[k][0] = a[0]; w[k][1] = a[1]; w[k][2] = a[2]; w[k][3] = a[3]; w[k][4] = b[0]; w[k][5] = b[1]; w[k][6] = b[2]; w[k][7] = b[3]; }
        { const f32x4 a = *(const f32x4*)(in_ptr(I_LCB) + (size_t)l * LW + ch0), b = *(const f32x4*)(in_ptr(I_LCB) + (size_t)l * LW + ch0 + 4);
          bias[0] = a[0]; bias[1] = a[1]; bias[2] = a[2]; bias[3] = a[3]; bias[4] = b[0]; bias[5] = b[1]; bias[6] = b[2]; bias[7] = b[3]; }
        float xin[7][8];
#pragma unroll
        for (int i = 0; i < 7; ++i) { const int trow = 4 * tq + i - 3;
            if (128 * ck + trow >= 0) { const v4u raw = *(const GAS v4u*)(X + (size_t)((long)row0 + trow) * LW + ch0); unpack8(raw, xin[i]); }
            else {
#pragma unroll
                for (int e = 0; e < 8; ++e) xin[i][e] = 0.f; } }
#pragma unroll
        for (int j = 0; j < 4; ++j) { float o[8];
#pragma unroll
            for (int e = 0; e < 8; ++e) o[e] = bias[e] + (w[0][e] * xin[j][e] + w[1][e] * xin[j + 1][e]) + (w[2][e] * xin[j + 2][e] + w[3][e] * xin[j + 3][e]);
            *(LAS v4u*)(xr + (4 * tq + j) * 272 + 16 * c8) = pack8(o); }
    }
    __syncthreads();
    const int fr = F.lane & 15, fq = F.lane >> 4, ch = 16 * F.wave + fr, cg = 128 * g + ch;
    bf16x8 bwa[4], bwx[4];
    { const bf16* WA = (const bf16*)(F.ws + WS_WAX) + ((size_t)(l * 2 + 0) * 8 + g) * 16384 + (size_t)ch * 128 + 8 * fq;
      const bf16* WX = (const bf16*)(F.ws + WS_WAX) + ((size_t)(l * 2 + 1) * 8 + g) * 16384 + (size_t)ch * 128 + 8 * fq;
#pragma unroll
      for (int ks = 0; ks < 4; ++ks) { bwa[ks] = *(const bf16x8*)(WA + 32 * ks); bwx[ks] = *(const bf16x8*)(WX + 32 * ks); } }
    f32x4 accr[8], acci[8];
#pragma unroll
    for (int mt = 0; mt < 8; ++mt) { accr[mt] = (f32x4){0.f, 0.f, 0.f, 0.f}; acci[mt] = (f32x4){0.f, 0.f, 0.f, 0.f};
#pragma unroll
        for (int ks = 0; ks < 4; ++ks) { const bf16x8 a = *(const LAS bf16x8*)(xr + (16 * mt + fr) * 272 + (32 * ks + 8 * fq) * 2);
            accr[mt] = __builtin_amdgcn_mfma_f32_16x16x32_bf16(a, bwa[ks], accr[mt], 0, 0, 0);
            acci[mt] = __builtin_amdgcn_mfma_f32_16x16x32_bf16(a, bwx[ks], acci[mt], 0, 0, 0); } }
    const float ba = in_ptr(I_LBA)[(size_t)l * LW + cg], bx = in_ptr(I_LBX)[(size_t)l * LW + cg];
    const float Lc2 = -8.0f * 1.4426950408889634f * softplus_f(-in_ptr(I_LAM)[(size_t)l * LW + cg]);
    bf16* R = (bf16*)(F.ws + WS_R); bf16* GX = (bf16*)(F.ws + WS_GX);
    float At = 1.f, Bt = 0.f;
#pragma unroll
    for (int mt = 0; mt < 8; ++mt) { float A4 = 1.f, B4 = 0.f;
#pragma unroll
        for (int e = 0; e < 4; ++e) { const int tl = 16 * mt + 4 * fq + e;
            const float r = pg8::fast_sigmoid(accr[mt][e] + ba), ii = pg8::fast_sigmoid(acci[mt][e] + bx);
            const float xv = bf2f(*(const LAS unsigned short*)(xr + tl * 272 + ch * 2));
            const unsigned short rb = (unsigned short)f2bf(r), gb = (unsigned short)f2bf(ii * xv);
            R[(row0 + tl) * LW + cg] = rb; GX[(row0 + tl) * LW + cg] = gb;
            const float a = __builtin_amdgcn_exp2f(Lc2 * bf2f(rb)); const float bb = sqrtf(fmaxf(1.0f - a * a, 0.f)) * bf2f(gb);
            A4 = a * A4; B4 = a * B4 + bb; }
#pragma unroll
        for (int q = 0; q < 4; ++q) { const float Aq = __shfl(A4, fr + 16 * q), Bq = __shfl(B4, fr + 16 * q); Bt = Aq * Bt + Bq; At = Aq * At; } }
    if (fq == 0) { float* AGG = (float*)(F.ws + WS_AGG) + ((size_t)gck * LW + cg) * 2; AGG[0] = At; AGG[1] = Bt; }
    __syncthreads();
}
__device__ __forceinline__ void lru_scan_unit(const Frame& F, int l, int gck, int hf) {
    const int c = 512 * hf + F.tid, b = gck >> 4, ck = gck & 15;
    const float* AGG = (const float*)(F.ws + WS_AGG);
    float h = 0.f;
    for (int j = 0; j < ck; ++j) { const float2 ab = *(const float2*)(AGG + ((size_t)(b * 16 + j) * LW + c) * 2); h = ab.x * h + ab.y; }
    const float Lc2 = -8.0f * 1.4426950408889634f * softplus_f(-in_ptr(I_LAM)[(size_t)l * LW + c]);
    const bf16* R = (const bf16*)(F.ws + WS_R) + (size_t)gck * 128 * LW + c; const bf16* GX = (const bf16*)(F.ws + WS_GX) + (size_t)gck * 128 * LW + c;
    const bf16* GT = (const bf16*)(F.ws + WS_LRUG) + (size_t)gck * 128 * LW + c; bf16* Y = (bf16*)(F.ws + WS_YLRU) + (size_t)gck * 128 * YP + c;
    for (int t0 = 0; t0 < 128; t0 += 8) { unsigned short rr[8], gg[8], tt[8];
#pragma unroll
        for (int i = 0; i < 8; ++i) { rr[i] = R[(size_t)(t0 + i) * LW]; gg[i] = GX[(size_t)(t0 + i) * LW]; tt[i] = GT[(size_t)(t0 + i) * LW]; }
#pragma unroll
        for (int i = 0; i < 8; ++i) { const float a = __builtin_amdgcn_exp2f(Lc2 * bf2f(rr[i])); const float bb = sqrtf(fmaxf(1.0f - a * a, 0.f)) * bf2f(gg[i]); h = a * h + bb;
            Y[(size_t)(t0 + i) * YP] = (unsigned short)f2bf(h * bf2f(tt[i])); } }
}
__device__ __forceinline__ void sc_phase(const Frame& F, int l) {
    const int gt = (F.vcu * NWAVES + F.wave) * 64 + F.lane, NT = F.G * NWAVES * 64;
    const bf16* SB = (const bf16*)(F.ws + WS_SCB); const bf16* SC = (const bf16*)(F.ws + WS_SCC); const bf16* SX = (const bf16*)(F.ws + WS_SCX); bf16* Y = (bf16*)(F.ws + WS_YSC);
    for (int idx = gt; idx < (M / 8) * (LW / 8); idx += NT) {
        const int c8 = idx & 127, tg = idx >> 7, row0 = 8 * tg, s0 = row0 & (SEQ - 1), ch0 = 8 * c8;
        float w[3][8];
#pragma unroll
        for (int k = 0; k < 3; ++k) { const f32x4 a = *(const f32x4*)(in_ptr(I_SCW) + ((size_t)l * 3 + k) * LW + ch0), b = *(const f32x4*)(in_ptr(I_SCW) + ((size_t)l * 3 + k) * LW + ch0 + 4);
            w[k][0] = a[0]; w[k][1] = a[1]; w[k][2] = a[2]; w[k][3] = a[3]; w[k][4] = b[0]; w[k][5] = b[1]; w[k][6] = b[2]; w[k][7] = b[3]; }
        float cx[10][8];
#pragma unroll
        for (int i = 0; i < 10; ++i) {
            if (s0 + i - 2 >= 0) { float a[8], b[8]; unpack8(*(const GAS v4u*)(SC + (size_t)(row0 + i - 2) * LW + ch0), a); unpack8(*(const GAS v4u*)(SX + (size_t)(row0 + i - 2) * LW + ch0), b);
#pragma unroll
                for (int e = 0; e < 8; ++e) cx[i][e] = a[e] * b[e]; }
            else {
#pragma unroll
                for (int e = 0; e < 8; ++e) cx[i][e] = 0.f; } }
#pragma unroll
        for (int j = 0; j < 8; ++j) { float bb[8], o[8]; unpack8(*(const GAS v4u*)(SB + (size_t)(row0 + j) * LW + ch0), bb);
#pragma unroll
            for (int e = 0; e < 8; ++e) o[e] = bb[e] * ((w[0][e] * cx[j][e] + w[1][e] * cx[j + 1][e]) + w[2][e] * cx[j + 2][e]);
            *(GAS v4u*)(Y + (size_t)(row0 + j) * YP + ch0) = pack8(o); }
    }
}
__device__ __forceinline__ void rope8(bf16* p, const float* cs, const float* sn) {
    float x1[8], x2[8], o1[8], o2[8]; unpack8(*(const GAS v4u*)p, x1); unpack8(*(const GAS v4u*)(p + 32), x2);
    const f32x4 c0 = *(const f32x4*)cs, c1 = *(const f32x4*)(cs + 4), s0 = *(const f32x4*)sn, s1 = *(const f32x4*)(sn + 4);
#pragma unroll
    for (int e = 0; e < 8; ++e) { const float c = e < 4 ? c0[e & 3] : c1[e & 3], s = e < 4 ? s0[e & 3] : s1[e & 3]; o1[e] = x1[e] * c - x2[e] * s; o2[e] = x2[e] * c + x1[e] * s; }
    *(GAS v4u*)p = pack8(o1); *(GAS v4u*)(p + 32) = pack8(o2);
}
__device__ __forceinline__ void rope_phase(const Frame& F) {
    const int gt = (F.vcu * NWAVES + F.wave) * 64 + F.lane, NT = F.G * NWAVES * 64;
    const float* COS = (const float*)(F.ws + WS_COS); const float* SIN = (const float*)(F.ws + WS_SIN);
    bf16* Q = (bf16*)(F.ws + WS_Q); bf16* KP = (bf16*)(F.ws + WS_KPE);
    for (int idx = gt; idx < M * 16 * 4; idx += NT) { const int row = idx >> 6, hh = (idx >> 2) & 15, j = idx & 3;
        rope8(Q + (size_t)row * 3072 + hh * 192 + 128 + 8 * j, COS + (size_t)row * 32 + 8 * j, SIN + (size_t)row * 32 + 8 * j); }
    for (int idx = gt; idx < M * 4; idx += NT) { const int row = idx >> 2, j = idx & 3;
        rope8(KP + (size_t)row * 64 + 8 * j, COS + (size_t)row * 32 + 8 * j, SIN + (size_t)row * 32 + 8 * j); }
}
struct Args { const float* in[24]; float* out; unsigned char* ws; int ph_lo, ph_hi; };
#ifndef P0P
#define P0P 3
#endif
#ifndef REP_G2
#define REP_G2 1
#endif
#ifndef REP_G5
#define REP_G5 1
#endif
#ifndef REP_PRO
#define REP_PRO 1
#endif
#ifndef REVK_FFN
#define REVK_FFN false
#endif
#ifndef ACT_TILED
#define ACT_TILED false
#endif
#ifndef G3P
#define G3P 3
#endif
#ifndef REP_ATT
#define REP_ATT 1
#endif
#ifndef REP_BAR
#define REP_BAR 1
#endif
#ifndef PH_MASK
#define PH_MASK 0xFFFFu
#endif
#define EN(j) (((PH_MASK) >> (j)) & 1u)
__global__ void __launch_bounds__(NWAVES * 64, 2) hybrid_fwd(Args args) {
    extern __shared__ __attribute__((aligned(16))) unsigned char lds[];
    Frame F;
    F.lds = (LAS unsigned char*)lds;
    F.MISC = (volatile LAS unsigned*)(F.lds + MISC_OFF);
    F.tid = threadIdx.x; F.lane = F.tid & 63; F.wave = __builtin_amdgcn_readfirstlane(F.tid >> 6);
    F.G = gridDim.x; { const int bx = blockIdx.x; F.vcu = (F.G % 8 == 0) ? (bx % 8) * (F.G / 8) + bx / 8 : bx; }
    F.out = nullptr; F.ws = nullptr; F.ctl = (gu32*)(args.ws + WS_CTL);
    for (int u = F.tid; u < (LDS_BYTES - LDSCTL_OFF) / 4; u += NWAVES * 64) ((LAS unsigned*)(F.lds + LDSCTL_OFF))[u] = 0u;
    __syncthreads();
    XcdBarrier bar; bar.bar = (unsigned*)(F.ctl + CW_BAR); bar.x = 0; bar.st = nullptr;
    if (MK_N_LAUNCHES == 1) bar = xcd_barrier_post((unsigned*)(F.ctl + CW_BAR), F.MISC + 8);
    const int lo = args.ph_lo, hi = args.ph_hi;
#define IN(k) (lo <= (k) && (k) < hi)
#define PHASE_FRAME() Frame P = F; { unsigned m1_ = ~0u; asm volatile("" : "+s"(m1_)); int t_ = F.wave * 64 + (int)__builtin_amdgcn_mbcnt_hi(m1_, __builtin_amdgcn_mbcnt_lo(m1_, 0u)); asm volatile("" : "+v"(t_)); P.tid = t_; P.lane = t_ & 63; P.out = (GAS float*)karg_ptr(24); P.ws = karg_ptr(25); }
#define SEAM(k) do { if (IN(k) && IN((k) + 1)) { if (MK_N_LAUNCHES == 1) { for (int rb_ = 0; rb_ < REP_BAR; ++rb_) { XcdBarrier b_ = bar; GAS unsigned* bp_ = (GAS unsigned*)bar.bar; asm volatile("" : "+s"(bp_)); b_.bar = (unsigned*)bp_; xcd_barrier(b_); } }     } } while (0)
#define HN ((bf16*)(P.ws + WS_HN))
#define XH ((bf16*)(P.ws + WS_XH))
#define A8 ((unsigned char*)(P.ws + WS_A8))
#define ACT ((bf16*)(P.ws + WS_ACT))
#define MERGED ((bf16*)(P.ws + WS_MERGED))
#define ring (F.lds + RING_OFF)
#define MODL(l_) ((const float*)(P.ws + WS_MOD) + (size_t)(l_) * NB * MODW)
#define NORMG(l_, s_) (in_ptr(I_NORMG) + ((size_t)(l_) * 3 + (s_)) * D)
#define SSQN(l_, s_) ((pg8::ssq_t*)(P.ws + WS_SSQN) + ((size_t)(l_) * 3 + (s_)) * M)
#define WSCP(l_, w_) ((const float*)(P.ws + WS_WSC) + ((size_t)(l_) * 2 + (w_)) * 2)
#define CBV(l_, s_) ((const int*)(P.ws + WS_CB) + ((size_t)(l_) * 3 + (s_)) * NB * CBW)

    if (EN(12) && IN(0)) { PHASE_FRAME(); p0_wscale(P); p0_mod(P); p0_weights(P, 2);
        for (int i = P.vcu * (NWAVES * 64) + P.tid; i < NL * 4 * M; i += P.G * (NWAVES * 64)) ((GAS pg8::ssq_t*)(P.ws + WS_SSQN))[i] = 0ull;
        SEAM(0); }
    if (EN(13) && IN(1)) { PHASE_FRAME(); if (P0P & 1) for (int rep_ = 0; rep_ < REP_PRO; ++rep_) { p0_weights(P, 1, rep_ + 1 < REP_PRO); __syncthreads(); } if (P0P & 2) operand0_phase(P, in_ptr(I_X), NORMG(0, 0), MODL(0) + 2048, HN, SSQN(0, 0), XH); SEAM(1); }

    for (int l = 0; l < NL; ++l) {
        const int pb = 2 + PPL * l;
#define wl (P.ws + WS_W + (size_t)l * W_LAYER)
#define mod MODL(l)
#define xin0 ((l == 0) ? in_ptr(I_X) : (const float*)P.out)
#define ssq ((pg8::ssq_t*)(P.ws + WS_SSQ) + (size_t)l * M)
#define UP_CALL(F8IN, O8, Wp, SITE) do { pg8::Gemm g{(F8IN) ? (const bf16*)A8 : (const bf16*)HN, (const bf16*)(Wp), M, 2 * DFF, (F8IN) ? D / 2 : D}; \
            pg8::EpiSwiglu<ACT_TILED, (O8), (F8IN)> E{ACT, DFF, SSQN(l, SITE), CBV(l, SITE), CBW, EPS, 1.0f, SSQN(l, (SITE) - 1 < 0 ? 0 : (SITE) - 1), WSCP(l, 1)};     \
            pg8::gemm_phase<pg8::EpiSwiglu<ACT_TILED, (O8), (F8IN)>, pg8::StaticOrder, true, true, false, false, false, false, (F8IN)>(ring, g, S, E, P.wave); } while (0)
        if (EN(0) && IN(pb + 0)) { PHASE_FRAME(); pg8::StaticOrder S; S.init(M, 2 * DFF, P.G, (int)blockIdx.x);
            constexpr bool o0 = fp8_dn(0, 0), o1 = fp8_dn(1, 0);
            if (o0 == o1) UP_CALL(false, o0, wl + WO_W13, 0); else if (l == 0) UP_CALL(false, o0, wl + WO_W13, 0); else UP_CALL(false, o1, wl + WO_W13, 0);
            SEAM(pb + 0); }
#define DN_SC(F8) ((F8) ? 1.0f / (64.0f * pg8::ACT8_SC) : 1.0f)
#define G2_CALL(F8) do { pg8::Gemm g{ACT, (const bf16*)(wl + WO_W2), M, D, (F8) ? DFF / 2 : DFF}; pg8::EpiResid<true, true> E{XH, mod + 4096, HN, NORMG(l, 1), mod + 8192, SSQN(l, 1), A8, MODW, 0.5f * DN_SC(F8), SSQN(l, 0)}; \
            pg8::gemm_phase<pg8::EpiResid<true, true>, pg8::PanelOrder, true, true, false, false, false, (F8)>(ring, g, S, E, P.wave); } while (0)
        if (EN(1) && IN(pb + 1)) { PHASE_FRAME(); pg8::PanelOrder S; S.init(P.G, (int)blockIdx.x);
            constexpr bool d0 = fp8_dn(0, 0), d1 = fp8_dn(1, 0);
            if (d0 == d1) G2_CALL(d0); else if (l == 0) G2_CALL(d0); else G2_CALL(d1);
            SEAM(pb + 1); }
        if (EN(2) && IN(pb + 2)) { PHASE_FRAME();
            if (G3P & 1) {
                pg8::Gemm g{(const bf16*)A8, (const bf16*)(wl + WO_WIN8), M, WINF_ROWS, D / 2}; pg8::StaticOrder S; S.init(M, WINF_ROWS, P.G, (int)blockIdx.x);
                pg8::EpiWin<(FP8_ALL ? 2 : 1), (bool)WIN_QF8> E{(bf16*)(P.ws + WS_LRUX), (bf16*)(P.ws + WS_LRUG), (bf16*)(P.ws + WS_SCB), (bf16*)(P.ws + WS_SCC), (bf16*)(P.ws + WS_SCX), (bf16*)(P.ws + WS_Q), (bf16*)(P.ws + WS_KVLAT), (bf16*)(P.ws + WS_GATES), (bf16*)(P.ws + WS_KPE), ssq, SSQN(l, 1), CBV(l, 1), CBW, EPS, SSQN(l, 0), WSCP(l, 0)};
                pg8::gemm_phase<pg8::EpiWin<(FP8_ALL ? 2 : 1), (bool)WIN_QF8>, pg8::StaticOrder, true, true, false, false, false, false, true>(ring, g, S, E, P.wave); }
            if ((G3P & 2) && !FP8_ALL) {
                pg8::Gemm g{HN, (const bf16*)(wl + WO_WIN), M, WINB_ROWS, D}; pg8::StaticOrder S; S.init(M, WINB_ROWS, P.G, (int)blockIdx.x);
                pg8::EpiWin<0, (bool)WIN_QF8> E{(bf16*)(P.ws + WS_LRUX), (bf16*)(P.ws + WS_LRUG), (bf16*)(P.ws + WS_SCB), (bf16*)(P.ws + WS_SCC), (bf16*)(P.ws + WS_SCX), (bf16*)(P.ws + WS_Q), (bf16*)(P.ws + WS_KVLAT), (bf16*)(P.ws + WS_GATES), (bf16*)(P.ws + WS_KPE), ssq, SSQN(l, 1), CBV(l, 1), CBW, EPS, nullptr, nullptr};
                pg8::gemm_phase<pg8::EpiWin<0, (bool)WIN_QF8>, pg8::StaticOrder, true, true>(ring, g, S, E, P.wave); }
            SEAM(pb + 2); }
        if (EN(3) && IN(pb + 3)) { PHASE_FRAME();
            for (int u = P.vcu; u < 128 * 8; u += P.G) lru_unit(P, l, u >> 3, u & 7);
            sc_phase(P, l);
            rope_phase(P);
            { pg8::Gemm g{(const bf16*)(P.ws + WS_KVLAT), (const bf16*)(wl + WO_UKV), M, 4096, KVR}; pg8::StaticOrder S; S.init(M, 4096, P.G, (int)blockIdx.x);
              pg8::EpiKV E{(bf16*)(P.ws + WS_KN), (bf16*)(P.ws + WS_V), ssq, EPS}; pg8::gemm_phase<pg8::EpiKV, pg8::StaticOrder, true, true>(ring, g, S, E, P.wave); }
            SEAM(pb + 3);
        }
        if (EN(4) && IN(pb + 4)) { PHASE_FRAME();
            for (int u = P.vcu; u < 128 * 2; u += P.G) lru_scan_unit(P, l, u >> 1, u & 1);
            for (int rep_ = 0; rep_ < REP_ATT; ++rep_)
            for (int item = P.vcu; item < 256; item += P.G) { const int bh = item >> 1, s = item & 1;
#pragma unroll 1
                for (int i = 0; i < 4; ++i) { const int base = 2 * s + (i >> 1), qb = (i & 1) ? 7 - base : base;
                    att::attn_unit(bh >> 4, bh & 15, qb, (const bf16*)(P.ws + WS_Q), (const bf16*)(P.ws + WS_KN), (const bf16*)(P.ws + WS_KPE), (const bf16*)(P.ws + WS_V), (bf16*)(P.ws + WS_ATT), (LAS char*)ring, P.wave); } }
            __syncthreads();
            SEAM(pb + 4);
        }
        if (EN(5) && IN(pb + 5)) { PHASE_FRAME();
            pg8::PanelOrder S; S.init(P.G, (int)blockIdx.x); const bf16* GT = (const bf16*)(P.ws + WS_GATES);
#ifndef MERGE3
#define MERGE3 1
#endif
            if (MERGE3) { pg8::Gemm g{(const bf16*)(P.ws + WS_YCAT), (const bf16*)(wl + WO_WCAT), M, D, YP}; pg8::EpiMerge3 E{MERGED, (const unsigned char*)GT, 6144}; static_assert(GATES_U8 && MERGE3, "the u8 gate store is read by the fused merge GEMM only"); pg8::gemm_phase<pg8::EpiMerge3, pg8::PanelOrder, true, true>(ring, g, S, E, P.wave); }
            else {
            { pg8::Gemm g{(const bf16*)(P.ws + WS_YLRU), (const bf16*)(wl + WO_LRUO), M, D, LW, YP}; pg8::EpiMerge<true> E{MERGED, GT, 6144}; pg8::gemm_phase<pg8::EpiMerge<true>, pg8::PanelOrder, true, true>(ring, g, S, E, P.wave); }
            { pg8::Gemm g{(const bf16*)(P.ws + WS_YSC), (const bf16*)(wl + WO_SCO), M, D, LW, YP}; pg8::EpiMerge<false> E{MERGED, GT + 2048, 6144}; pg8::gemm_phase<pg8::EpiMerge<false>, pg8::PanelOrder, true, true>(ring, g, S, E, P.wave); }
            { pg8::Gemm g{(const bf16*)(P.ws + WS_ATT), (const bf16*)(wl + WO_MLAO), M, D, D, YP}; pg8::EpiMerge<false> E{MERGED, GT + 4096, 6144}; pg8::gemm_phase<pg8::EpiMerge<false>, pg8::PanelOrder, true, true>(ring, g, S, E, P.wave); }
            }
            SEAM(pb + 5);
        }
        if (EN(6) && IN(pb + 6)) { PHASE_FRAME(); pg8::Gemm g{MERGED, (const bf16*)(wl + WO_WO), M, D, D}; pg8::PanelOrder S; S.init(P.G, (int)blockIdx.x);
            pg8::EpiResid<true, (FP8_G4 != 0)> E{XH, mod + 10240, HN, NORMG(l, 2), mod + 14336, SSQN(l, 2), A8, MODW, 1.0f, SSQN(l, 1)}; pg8::gemm_phase<pg8::EpiResid<true, (FP8_G4 != 0)>, pg8::PanelOrder, true, true>(ring, g, S, E, P.wave); SEAM(pb + 6); }
        if (EN(7) && IN(pb + 7)) { PHASE_FRAME(); pg8::StaticOrder S; S.init(M, 2 * DFF, P.G, (int)blockIdx.x);
            constexpr bool u0 = (FP8_G4 & 1) != 0, u1 = (FP8_G4 & 2) != 0, o0 = fp8_dn(0, 1), o1 = fp8_dn(1, 1);
            if (u0 == u1 && o0 == o1) UP_CALL(u0, o0, wl + WO_W13 + 44 * MiB, 2); else if (l == 0) UP_CALL(u0, o0, wl + WO_W13 + 44 * MiB, 2); else UP_CALL(u1, o1, wl + WO_W13 + 44 * MiB, 2);
            SEAM(pb + 7); }
        if (EN(8) && IN(pb + 8)) { PHASE_FRAME(); pg8::PanelOrder S; S.init(P.G, (int)blockIdx.x); static_assert(NL == 2, "per-layer fp8 flags are written out for two layers");
            if (l + 1 < NL) { constexpr bool f8 = fp8_dn(0, 1); pg8::Gemm g{ACT, (const bf16*)(wl + WO_W2 + 22 * MiB), M, D, f8 ? DFF / 2 : DFF};
                pg8::EpiResid<true> E{XH, mod + 16384, HN, NORMG(l + 1, 0), MODL(l + 1) + 2048, SSQN(l + 1, 0), nullptr, MODW, 0.5f * DN_SC(f8), nullptr}; pg8::gemm_phase<pg8::EpiResid<true>, pg8::PanelOrder, true, true, false, false, false, f8>(ring, g, S, E, P.wave); }
            else { constexpr bool f8 = fp8_dn(1, 1); pg8::Gemm g{ACT, (const bf16*)(wl + WO_W2 + 22 * MiB), M, D, f8 ? DFF / 2 : DFF};
                if (REP_G5 > 1) { pg8::EpiNull E0{(float*)(P.ws + WS_AGG)}; pg8::gemm_phase<pg8::EpiNull, pg8::PanelOrder, true, true, false, false, false, f8>(ring, g, S, E0, P.wave); }
                pg8::EpiResid<false> E{XH, mod + 16384, nullptr, nullptr, nullptr, nullptr, nullptr, MODW, 0.5f * DN_SC(f8), nullptr}; pg8::gemm_phase<pg8::EpiResid<false>, pg8::PanelOrder, true, true, false, false, false, f8>(ring, g, S, E, P.wave); }
            SEAM(pb + 8); }
    }
    if (EN(14) && IN(N_PHASES - 1)) { PHASE_FRAME(); final_norm_phase(P, XH, (float*)P.out, in_ptr(I_FING)); }
#undef IN
#undef SEAM
#undef HN
#undef XH
#undef A8
#undef ACT
#undef MERGED
#undef ring
#undef wl
#undef mod
#undef xin0
#undef ssq
}

extern "C" void kernel_launch(void* const* d_in, const int* in_sizes, int n_in, void* d_out, int out_size, void* d_ws, size_t ws_size, hipStream_t stream) {
    static int grid = 0;
    if (grid == 0) {
        if (n_in != 24 || in_sizes[0] != M * D || out_size != M * D || ws_size < WS_END) { fprintf(stderr, "kernel_launch: shape/workspace mismatch (n_in %d, in0 %d, out %d, ws %zu < %zu); nothing launched\n", n_in, n_in > 0 ? in_sizes[0] : -1, out_size, ws_size, (size_t)WS_END); grid = -1; return; }
        int dev = 0, cus = 0, per_cu = 0;
        if (hipGetDevice(&dev) != hipSuccess || hipDeviceGetAttribute(&cus, hipDeviceAttributeMultiprocessorCount, dev) != hipSuccess) { fprintf(stderr, "kernel_launch: device query failed\n"); grid = -1; return; }
        if (hipFuncSetAttribute((const void*)hybrid_fwd, hipFuncAttributeMaxDynamicSharedMemorySize, LDS_BYTES) != hipSuccess) { fprintf(stderr, "kernel_launch: hipFuncSetAttribute failed\n"); grid = -1; return; }
        if (hipOccupancyMaxActiveBlocksPerMultiprocessor(&per_cu, (const void*)hybrid_fwd, NWAVES * 64, LDS_BYTES) != hipSuccess || per_cu < 1) fprintf(stderr, "kernel_launch: note: occupancy query reports %d workgroups per CU\n", per_cu);
        (void)hipGetLastError();
        grid = cus;
    }
    if (grid < 0) return;
    if (hipMemsetAsync((char*)d_ws + WS_CTL, 0, CTL_ZERO_BYTES, stream) != hipSuccess) { fprintf(stderr, "kernel_launch: hipMemsetAsync failed\n"); return; }
    Args a{};
    for (int i = 0; i < 24; ++i) a.in[i] = (const float*)d_in[i];
    a.out = (float*)d_out; a.ws = (unsigned char*)d_ws;
#if MK_N_LAUNCHES == 1
    a.ph_lo = 0; a.ph_hi = N_PHASES;
    hipLaunchKernelGGL(hybrid_fwd, dim3(grid), dim3(NWAVES * 64), LDS_BYTES, stream, a);
#else
    for (int p = 0; p < N_PHASES; ++p) { a.ph_lo = p; a.ph_hi = p + 1; hipLaunchKernelGGL(hybrid_fwd, dim3(grid), dim3(NWAVES * 64), LDS_BYTES, stream, a); }
#endif
    const hipError_t le = hipPeekAtLastError();
    if (le != hipSuccess) fprintf(stderr, "kernel_launch: launch failed: %s\n", hipGetErrorName(le));
}
```

```cpp
#include <hip/hip_runtime.h>
#include <cstdio>
#include <cstdint>
#define MK_N_LAUNCHES 1
#define G1_BF16 0
#define FP8_G4 3
#define FP8_G1 3
#define FP8_DN 14
#define A8_CLIP_V 7.0f
#ifndef G1_BF16
#define G1_BF16 1
#endif
#ifndef GATES_U8
#define GATES_U8 1
#endif
namespace pg8 {
#define PG8_LAS __attribute__((address_space(3)))
typedef unsigned short bf16_t;
typedef short bf16x8 __attribute__((ext_vector_type(8)));
typedef float f32x4 __attribute__((ext_vector_type(4)));
typedef unsigned u32x4 __attribute__((ext_vector_type(4)));
typedef int v4i_t __attribute__((ext_vector_type(4)));
typedef int v8i_t __attribute__((ext_vector_type(8)));
constexpr int BM = 256, BK = 64, HALF = 128, HTB = HALF * BK * 2  , STAGE_BYTES = 8 * HTB, NXCD = 8, WGM = 8;

__host__ __device__ __forceinline__ int lds_byte(int r, int c) { const int st = (r >> 4) * 2 + (c >> 5), rr = r & 15, cc = c & 31, ob = rr * 64 + cc * 2; return st * 1024 + (ob ^ (((ob >> 9) & 1) << 5)); }
__host__ __device__ __forceinline__ void stage_rc(int b, int& R, int& C) { const int st = b / 1024, sb = b % 1024, swz = sb ^ (((sb >> 9) & 1) << 5); R = (st >> 1) * 16 + swz / 64; C = (st & 1) * 32 + (swz % 64) / 2; }
__host__ __device__ __forceinline__ int perm32(int rho) { const int n = rho >> 4, i = rho & 15; return 8 * (i >> 2) + 4 * n + (i & 3); }

template <class E> struct has_mid { static constexpr bool value = false; };
struct Unit { int pm, pn; };
struct Gemm { const bf16_t* A; const bf16_t* Bt; int M, N, K; int ld = 0; };

struct StaticOrder {
    int nM, nN, nwg, G, c;
    __host__ __device__ void init(int M, int N, int G_, int c_) { nM = M / BM; nN = N / BM; nwg = nM * nN; G = G_; c = c_; }
    __host__ __device__ bool next(int i, Unit& u) const {
        const long L = (long)i * G + c; if (L >= nwg) return false;
        int wgid = (int)L; { const int q = nwg / NXCD, r = nwg % NXCD, xcd = wgid % NXCD, off = wgid / NXCD; wgid = (xcd < r ? xcd * (q + 1) : r * (q + 1) + (xcd - r) * q) + off; }
        const int nig = WGM * nN, gid = wgid / nig, fm = gid * WGM, gsz = (nM - fm) < WGM ? (nM - fm) : WGM;
        u.pm = fm + ((wgid % nig) % gsz); u.pn = (wgid % nig) / gsz; return true;
    }
    __device__ __forceinline__ void a_ready(const Unit&) const {}
    __device__ __forceinline__ void done(const Unit&) const {}
};

__device__ __forceinline__ unsigned cvt_pk_bf16(float lo, float hi) { unsigned r; asm volatile("v_cvt_pk_bf16_f32 %0, %1, %2" : "=v"(r) : "v"(lo), "v"(hi)); return r; }
typedef float f32x2 __attribute__((ext_vector_type(2)));
struct PanelOrder {
    int G, c;
    __host__ __device__ void init(int G_, int c_) { G = G_; c = c_; }
    __host__ __device__ bool next(int i, Unit& u) const { const long L = (long)i * G + c; if (L >= 512) return false; const int x = (int)(L & 7), j = (int)(L >> 3); u.pm = 8 * x + (j >> 3); u.pn = j & 7; return true; }
    __device__ __forceinline__ void a_ready(const Unit&) const {}
    __device__ __forceinline__ void done(const Unit&) const {}
};
typedef unsigned u32x2 __attribute__((ext_vector_type(2)));
__device__ __forceinline__ float fast_sigmoid(float x) { return __builtin_amdgcn_rcpf(1.0f + __builtin_amdgcn_exp2f(-1.4426950408889634f * x)); }
__device__ __forceinline__ float gelu_tanh(float x) { return x * fast_sigmoid(1.5957691216057308f * (x + 0.044715f * x * x * x)); }
__device__ __forceinline__ u32x4 pack8_bf16(const f32x4 a, const f32x4 b) { u32x4 w; w.x = cvt_pk_bf16(a[0], a[1]); w.y = cvt_pk_bf16(a[2], a[3]); w.z = cvt_pk_bf16(b[0], b[1]); w.w = cvt_pk_bf16(b[2], b[3]); return w; }
__device__ __forceinline__ void unpack8_bf16(const u32x4 w, f32x4& a, f32x4& b) {
    a[0] = __uint_as_float(w.x << 16); a[1] = __uint_as_float(w.x & 0xffff0000u); a[2] = __uint_as_float(w.y << 16); a[3] = __uint_as_float(w.y & 0xffff0000u);
    b[0] = __uint_as_float(w.z << 16); b[1] = __uint_as_float(w.z & 0xffff0000u); b[2] = __uint_as_float(w.w << 16); b[3] = __uint_as_float(w.w & 0xffff0000u); }

struct EpiNull {
    static constexpr bool PERM = true, AFTER_DRAIN = false; float* sink;
    __device__ __forceinline__ void operator()(f32x4 (&acc)[2][2][4][2], const Unit& u, int wr, int wc, int fr, int fq) const {
        float t = 0.f;
#pragma unroll
        for (int ai = 0; ai < 2; ++ai)
#pragma unroll
            for (int bj = 0; bj < 2; ++bj)
#pragma unroll
                for (int m = 0; m < 4; ++m)
#pragma unroll
                    for (int n = 0; n < 2; ++n) t += acc[ai][bj][m][n][0] + acc[ai][bj][m][n][3];
        if (t == 123456.75f) sink[0] = t; }
};
typedef unsigned long long ssq_t;
typedef int i32x4 __attribute__((ext_vector_type(4)));
__device__ __forceinline__ ssq_t ssq_enc(float t) { return (ssq_t)(t * 16777216.0f); }
__device__ __forceinline__ float ssq_dec(ssq_t v) { return (float)(unsigned)(v >> 32) * 256.0f + (float)(unsigned)v * (1.0f / 16777216.0f); }
__device__ __forceinline__ void ssq_add(ssq_t* p, float t) { atomicAdd(p, ssq_enc(t)); }
constexpr float CB_ENC = 1048576.0f, CB_DEC = 1.0f / 1048576.0f;
__device__ __forceinline__ f32x4 cb_ld4(const int* p) { return __builtin_convertvector(*(const i32x4*)p, f32x4) * CB_DEC; }
__device__ __forceinline__ float sat8(float x) { return __builtin_amdgcn_fmed3f(x, -448.0f, 448.0f); }
__device__ __forceinline__ u32x2 pack8_fp8(const f32x4 a, const f32x4 b) {
    unsigned w0 = 0, w1 = 0; w0 = __builtin_amdgcn_cvt_pk_fp8_f32(sat8(a[0]), sat8(a[1]), w0, false); w0 = __builtin_amdgcn_cvt_pk_fp8_f32(sat8(a[2]), sat8(a[3]), w0, true);
    w1 = __builtin_amdgcn_cvt_pk_fp8_f32(sat8(b[0]), sat8(b[1]), w1, false); w1 = __builtin_amdgcn_cvt_pk_fp8_f32(sat8(b[2]), sat8(b[3]), w1, true); return (u32x2){w0, w1}; }
#ifndef A8_CLIP_V
#define A8_CLIP_V 6.0f
#endif
constexpr float A8_CLIP = A8_CLIP_V;
__device__ __forceinline__ float a8_rms(ssq_t prev) { return __builtin_sqrtf(ssq_dec(prev) * (1.0f / 2048.0f) + 1e-20f); }
__device__ __forceinline__ float a8_scale(ssq_t prev) { return a8_rms(prev) * (A8_CLIP / 127.0f); }
__device__ __forceinline__ float a8_inv(ssq_t prev) { return (127.0f / A8_CLIP) * __builtin_amdgcn_rcpf(a8_rms(prev)); }
__device__ __forceinline__ unsigned pk4_i8(float a, float b, float c, float d) {
    unsigned w = 0u;
    w = __builtin_amdgcn_cvt_pk_u8_f32(__builtin_amdgcn_fmed3f(__builtin_rintf(a), -127.0f, 127.0f) + 128.0f, 0, w); w = __builtin_amdgcn_cvt_pk_u8_f32(__builtin_amdgcn_fmed3f(__builtin_rintf(b), -127.0f, 127.0f) + 128.0f, 1, w);
    w = __builtin_amdgcn_cvt_pk_u8_f32(__builtin_amdgcn_fmed3f(__builtin_rintf(c), -127.0f, 127.0f) + 128.0f, 2, w); w = __builtin_amdgcn_cvt_pk_u8_f32(__builtin_amdgcn_fmed3f(__builtin_rintf(d), -127.0f, 127.0f) + 128.0f, 3, w);
    return w ^ 0x80808080u; }
__device__ __forceinline__ u32x2 pack8_i8(const f32x4 a, const f32x4 b) { return (u32x2){pk4_i8(a[0], a[1], a[2], a[3]), pk4_i8(b[0], b[1], b[2], b[3])}; }
__device__ __forceinline__ f32x4 i2f(const f32x4 bits) { return __builtin_convertvector(__builtin_bit_cast(i32x4, bits), f32x4); }
constexpr float ACT8_SC = 8.0f;
template <bool TILED, bool O8 = false, bool I8IN = false> struct EpiSwiglu {
    static constexpr bool PERM = true, AFTER_DRAIN = false;
    bf16_t* O; int ldc; const ssq_t* ssq; const int* cb; int cbstride; float eps; float dsc; const ssq_t* ssqp; const float* wsc;
    __device__ __forceinline__ void operator()(f32x4 (&acc)[2][2][4][2], const Unit& u, int wr, int wc, int fr, int fq) const {
        const int row0 = u.pm * BM + wr * 64 + fr, lc = wc * 32 + 8 * fq, col0 = u.pn * HALF + lc;
        const int* cbp = cb + (size_t)(u.pm >> 3) * cbstride + u.pn * BM + lc;
        f32x4 cv[2][2];
#pragma unroll
        for (int bj = 0; bj < 2; ++bj)
#pragma unroll
            for (int n = 0; n < 2; ++n) cv[bj][n] = cb_ld4(cbp + bj * HALF + 4 * n);
#pragma unroll
        for (int ai = 0; ai < 2; ++ai)
#pragma unroll
            for (int m = 0; m < 4; ++m) { const int row = row0 + ai * HALF + m * 16;
                bf16_t* rowp = TILED ? O + ((size_t)u.pm * (ldc / 64) + 2 * u.pn + (wc >> 1)) * (BM * 64) + (size_t)(row - u.pm * BM) * 64 + (wc & 1) * 32 + 8 * fq
                                    : O + (size_t)row * ldc + col0;
                float ri = __builtin_amdgcn_rsqf(ssq_dec(ssq[row]) * (1.0f / 2048.0f) + eps) * dsc;
                if constexpr (I8IN) { ri *= a8_scale(ssqp[row]) * wsc[0];
#pragma unroll
                    for (int bj = 0; bj < 2; ++bj)
#pragma unroll
                        for (int n = 0; n < 2; ++n) acc[ai][bj][m][n] = i2f(acc[ai][bj][m][n]); }
                f32x4 r0, r1;
#pragma unroll
                for (int e = 0; e < 4; ++e) { const float g0 = acc[ai][0][m][0][e] * ri + cv[0][0][e], g1 = acc[ai][0][m][1][e] * ri + cv[0][1][e];
                    r0[e] = g0 * fast_sigmoid(g0) * (acc[ai][1][m][0][e] * ri + cv[1][0][e]); r1[e] = g1 * fast_sigmoid(g1) * (acc[ai][1][m][1][e] * ri + cv[1][1][e]); }
                if constexpr (O8) *(u32x2*)((unsigned char*)O + (size_t)row * ldc + col0) = pack8_fp8(r0 * ACT8_SC, r1 * ACT8_SC);
                else *(u32x4*)rowp = pack8_bf16(r0, r1); }
    }
};
typedef _Float16 f16_t;
__device__ __forceinline__ float h_lo(unsigned w) { return (float)__builtin_bit_cast(_Float16, (unsigned short)(w & 0xffffu)); }
__device__ __forceinline__ float h_hi(unsigned w) { return (float)__builtin_bit_cast(_Float16, (unsigned short)(w >> 16)); }
__device__ __forceinline__ void unpack8_f16(const u32x4 w, f32x4& a, f32x4& b) {
    const unsigned w0 = w[0], w1 = w[1], w2 = w[2], w3 = w[3];
    a[0] = h_lo(w0); a[1] = h_hi(w0); a[2] = h_lo(w1); a[3] = h_hi(w1); b[0] = h_lo(w2); b[1] = h_hi(w2); b[2] = h_lo(w3); b[3] = h_hi(w3); }
__device__ __forceinline__ unsigned pk2_f16(float lo, float hi) {
    const unsigned short l = __builtin_bit_cast(unsigned short, (_Float16)__builtin_fminf(__builtin_fmaxf(lo, -65504.f), 65504.f)), h = __builtin_bit_cast(unsigned short, (_Float16)__builtin_fminf(__builtin_fmaxf(hi, -65504.f), 65504.f));
    return (unsigned)l | ((unsigned)h << 16); }
__device__ __forceinline__ u32x4 pack8_f16(const f32x4 a, const f32x4 b) { u32x4 w; w[0] = pk2_f16(a[0], a[1]); w[1] = pk2_f16(a[2], a[3]); w[2] = pk2_f16(b[0], b[1]); w[3] = pk2_f16(b[2], b[3]); return w; }
template <bool NEXT, bool F8 = false> struct EpiResid {
    static constexpr bool PERM = true, AFTER_DRAIN = false;
    bf16_t* X; const float* gate; bf16_t* An; const float* gn; const float* scn; ssq_t* ssqn; unsigned char* A8; int gstride; float s; const ssq_t* ssqp;
    __device__ __forceinline__ void operator()(f32x4 (&acc)[2][2][4][2], const Unit& u, int wr, int wc, int fr, int fq) const {
        const int row0 = u.pm * BM + wr * 64 + fr, col0 = u.pn * BM + wc * 32 + 8 * fq;
        const unsigned cofs = (unsigned)((u.pm >> 3) * gstride + col0);
        const unsigned e0 = (unsigned)row0 * 2048u + (unsigned)col0;
#pragma unroll
        for (int ah = 0; ah < 4; ++ah) { const int ai = ah >> 1, mb = (ah & 1) * 2; u32x4 xw[2][2];
#pragma unroll
            for (int mm = 0; mm < 2; ++mm)
#pragma unroll
                for (int bj = 0; bj < 2; ++bj) xw[mm][bj] = *(const u32x4*)(X + (size_t)(e0 + (unsigned)(ai * HALF + (mb + mm) * 16) * 2048u + bj * HALF));
            float ss[2] = {0.f, 0.f}, qs[2] = {0.f, 0.f};
            if (NEXT && F8) {
#pragma unroll
                for (int mm = 0; mm < 2; ++mm) qs[mm] = a8_inv(ssqp[row0 + ai * HALF + (mb + mm) * 16]); }
#pragma unroll
            for (int bj = 0; bj < 2; ++bj) { f32x4 gv[2], nv[2];
#pragma unroll
                for (int n = 0; n < 2; ++n) { gv[n] = *(const f32x4*)(gate + (size_t)(cofs + bj * HALF + 4 * n)) * s;
                    if (NEXT) nv[n] = *(const f32x4*)(gn + (size_t)(unsigned)(col0 + bj * HALF + 4 * n)) * (*(const f32x4*)(scn + (size_t)(cofs + bj * HALF + 4 * n)) + 1.0f); }
#pragma unroll
                for (int mm = 0; mm < 2; ++mm) { const int m = mb + mm; const unsigned off = e0 + (unsigned)(ai * HALF + m * 16) * 2048u + bj * HALF;
                    f32x4 a, b; unpack8_f16(xw[mm][bj], a, b); a += gv[0] * acc[ai][bj][m][0]; b += gv[1] * acc[ai][bj][m][1];
                    *(u32x4*)(X + (size_t)off) = pack8_f16(a, b);
                    if (NEXT) { ss[mm] += ((a[0] * a[0] + a[1] * a[1]) + (a[2] * a[2] + a[3] * a[3])) + ((b[0] * b[0] + b[1] * b[1]) + (b[2] * b[2] + b[3] * b[3]));
                        const f32x4 an = a * nv[0], bn = b * nv[1]; *(u32x4*)(An + (size_t)off) = pack8_bf16(an, bn);
                        if (F8) *(u32x2*)(A8 + (size_t)off) = pack8_i8(an * qs[mm], bn * qs[mm]); } } }
            if (NEXT) {
#pragma unroll
                for (int mm = 0; mm < 2; ++mm) { float t = ss[mm]; t += __shfl_xor(t, 16); t += __shfl_xor(t, 32); if (fq == 0) ssq_add(ssqn + row0 + ai * HALF + (mb + mm) * 16, t); } }
            asm volatile("" ::: "memory"); }
    }
};
template <int MODE, bool QF8> struct EpiWin {
    static constexpr bool PERM = true, AFTER_DRAIN = false;
    bf16_t *LRUX, *LRUG, *SCB, *SCC, *SCX, *Q, *KVLAT, *GATES, *KPE; ssq_t* ssq; const ssq_t* ssqn; const int* cb; int cbstride; float eps; const ssq_t* ssqp; const float* wsc;
    __device__ __forceinline__ void operator()(f32x4 (&acc)[2][2][4][2], const Unit& u, int wr, int wc, int fr, int fq) const {
        const int t = u.pn; bf16_t* base; int pitch, cbs, act = 0;
        if (MODE == 0) { const int tq = QF8 ? 20 : 32;
            if (t < 4) { base = LRUX; pitch = 1024; cbs = 256 * t; }
            else if (t < 8) { base = LRUG; pitch = 1024; cbs = 256 * (t - 4); act = 1; }
            else if (t < 12) { base = SCB; pitch = 1024; cbs = 256 * (t - 8); }
            else if (t < 16) { base = SCC; pitch = 1024; cbs = 256 * (t - 12); }
            else if (t < 20) { base = SCX; pitch = 1024; cbs = 256 * (t - 16); }
            else if (t < tq) { base = Q; pitch = 3072; cbs = 256 * (t - 20); }
            else if (t < tq + 2) { base = KVLAT; pitch = 512; cbs = 256 * (t - tq); act = 3; }
            else if (!G1_BF16 || t == tq + 2) { base = KPE; pitch = 64; cbs = 0; act = 4; }
            else { base = GATES; pitch = 6144; cbs = 2048 + 256 * (t - (tq + 3)); act = 2; }
        } else if (MODE == 2) {
            if (t < 4) { base = LRUX; pitch = 1024; cbs = 256 * t; }
            else if (t < 8) { base = LRUG; pitch = 1024; cbs = 256 * (t - 4); act = 1; }
            else if (t < 12) { base = SCB; pitch = 1024; cbs = 256 * (t - 8); }
            else if (t < 16) { base = SCC; pitch = 1024; cbs = 256 * (t - 12); }
            else if (t < 20) { base = SCX; pitch = 1024; cbs = 256 * (t - 16); }
            else if (t < 32) { base = Q; pitch = 3072; cbs = 256 * (t - 20); }
            else if (t < 34) { base = KVLAT; pitch = 512; cbs = 256 * (t - 32); act = 3; }
            else if (t < 58) { base = GATES; pitch = 6144; cbs = 256 * (t - 34); act = 2; }
            else { base = KPE; pitch = 64; cbs = 0; act = 4; }
        } else { const int tg = QF8 ? 12 : 0;
            if (t < tg) { base = Q; pitch = 3072; cbs = 256 * t; }
            else { base = GATES; pitch = 6144; cbs = 256 * (t - tg) + ((G1_BF16 && t >= tg + 8) ? 2048 : 0); act = 2; }
        }
        const float dsc = MODE == 1 ? wsc[0] : (MODE == 2 ? (1.0f / 64.0f) : 1.0f);
        const int row0 = u.pm * BM + wr * 64 + fr;
        bf16_t* p0 = base + (size_t)row0 * pitch + cbs + wc * 32 + 8 * fq;
        const size_t rstep = (size_t)16 * pitch;
        const int* cbp = cb + (size_t)(u.pm >> 3) * cbstride + (MODE == 1 ? (QF8 ? (G1_BF16 ? 7936 : 5888) : 8960) : 0) + u.pn * BM + wc * 32 + 8 * fq;
        if (act == 4) {
            if (wc < 2) { f32x4 cv[1][2]; cv[0][0] = cb_ld4(cbp); cv[0][1] = cb_ld4(cbp + 4);
#pragma unroll
                for (int ai = 0; ai < 2; ++ai)
#pragma unroll
                    for (int m = 0; m < 4; ++m) { const float ri = __builtin_amdgcn_rsqf(ssq_dec(ssqn[row0 + ai * HALF + m * 16]) * (1.0f / 2048.0f) + eps) * dsc;
                        *(u32x4*)(p0 + (size_t)(ai * 8 + m) * rstep) = pack8_bf16(acc[ai][0][m][0] * ri + cv[0][0], acc[ai][0][m][1] * ri + cv[0][1]); }
            }
            return;
        }
        f32x4 cv[2][2];
#pragma unroll
        for (int bj = 0; bj < 2; ++bj)
#pragma unroll
            for (int n = 0; n < 2; ++n) cv[bj][n] = cb_ld4(cbp + bj * HALF + 4 * n);
#pragma unroll
        for (int ai = 0; ai < 2; ++ai)
#pragma unroll
            for (int m = 0; m < 4; ++m) { bf16_t* rowp = p0 + (size_t)(ai * 8 + m) * rstep;
                float ri = __builtin_amdgcn_rsqf(ssq_dec(ssqn[row0 + ai * HALF + m * 16]) * (1.0f / 2048.0f) + eps) * dsc;
                if (MODE == 1) { ri *= a8_scale(ssqp[row0 + ai * HALF + m * 16]);
#pragma unroll
                    for (int bj = 0; bj < 2; ++bj)
#pragma unroll
                        for (int n = 0; n < 2; ++n) acc[ai][bj][m][n] = i2f(acc[ai][bj][m][n]); }
                f32x4 v[2][2];
#pragma unroll
                for (int bj = 0; bj < 2; ++bj)
#pragma unroll
                    for (int n = 0; n < 2; ++n) v[bj][n] = acc[ai][bj][m][n] * ri + cv[bj][n];
                if (act == 1) {
#pragma unroll
                    for (int bj = 0; bj < 2; ++bj)
#pragma unroll
                        for (int n = 0; n < 2; ++n)
#pragma unroll
                            for (int e = 0; e < 4; ++e) v[bj][n][e] = gelu_tanh(v[bj][n][e]);
                } else if (act == 2) {
#pragma unroll
                    for (int bj = 0; bj < 2; ++bj)
#pragma unroll
                        for (int n = 0; n < 2; ++n)
#pragma unroll
                            for (int e = 0; e < 4; ++e) v[bj][n][e] = fast_sigmoid(v[bj][n][e]);
                } else if (act == 3) { float s = 0.f;
#pragma unroll
                    for (int bj = 0; bj < 2; ++bj)
#pragma unroll
                        for (int n = 0; n < 2; ++n) { const f32x4 x = v[bj][n]; s += (x[0] * x[0] + x[1] * x[1]) + (x[2] * x[2] + x[3] * x[3]); }
                    s += __shfl_xor(s, 16); s += __shfl_xor(s, 32);
                    if (fq == 0) ssq_add(ssq + row0 + ai * HALF + m * 16, s); }
                if (GATES_U8 && act == 2) { unsigned char* r8 = (unsigned char*)base + (size_t)(row0 + ai * HALF + m * 16) * pitch + cbs + wc * 32 + 8 * fq;
#pragma unroll
                    for (int bj = 0; bj < 2; ++bj) { unsigned w0 = 0u, w1 = 0u;
#pragma unroll
                        for (int e = 0; e < 4; ++e) { w0 = __builtin_amdgcn_cvt_pk_u8_f32(v[bj][0][e] * 255.0f, e, w0); w1 = __builtin_amdgcn_cvt_pk_u8_f32(v[bj][1][e] * 255.0f, e, w1); }
                        *(u32x2*)(r8 + bj * HALF) = (u32x2){w0, w1}; } }
                else { *(u32x4*)rowp = pack8_bf16(v[0][0], v[0][1]); *(u32x4*)(rowp + HALF) = pack8_bf16(v[1][0], v[1][1]); }
                asm volatile("" ::: "memory"); }
    }
};
struct EpiKV {
    static constexpr bool PERM = true, AFTER_DRAIN = false;
    bf16_t *KN, *V; const ssq_t* ssq; float eps;
    __device__ __forceinline__ void operator()(f32x4 (&acc)[2][2][4][2], const Unit& u, int wr, int wc, int fr, int fq) const {
        const int row0 = u.pm * BM + wr * 64 + fr, col0 = u.pn * HALF + wc * 32 + 8 * fq;
#pragma unroll
        for (int ai = 0; ai < 2; ++ai)
#pragma unroll
            for (int m = 0; m < 4; ++m) { const int row = row0 + ai * HALF + m * 16; const float ri = __builtin_amdgcn_rsqf(ssq_dec(ssq[row]) * (1.0f / 512.0f) + eps);
                *(u32x4*)(KN + (size_t)row * 2048 + col0) = pack8_bf16(acc[ai][0][m][0] * ri, acc[ai][0][m][1] * ri);
                *(u32x4*)(V + (size_t)row * 2048 + col0) = pack8_bf16(acc[ai][1][m][0] * ri, acc[ai][1][m][1] * ri); }
    }
};
struct EpiMerge3 {
    static constexpr bool PERM = true, AFTER_DRAIN = false;
    bf16_t* Mg; const unsigned char* G; int gp;
    static __device__ __forceinline__ void un8(const u32x2 w, f32x4& a, f32x4& b) {
        a[0] = __builtin_fmaxf((float)(w[0] & 0xffu), 0.00390625f); a[1] = __builtin_fmaxf((float)((w[0] >> 8) & 0xffu), 0.00390625f); a[2] = __builtin_fmaxf((float)((w[0] >> 16) & 0xffu), 0.00390625f); a[3] = __builtin_fmaxf((float)(w[0] >> 24), 0.00390625f);
        b[0] = __builtin_fmaxf((float)(w[1] & 0xffu), 0.00390625f); b[1] = __builtin_fmaxf((float)((w[1] >> 8) & 0xffu), 0.00390625f); b[2] = __builtin_fmaxf((float)((w[1] >> 16) & 0xffu), 0.00390625f); b[3] = __builtin_fmaxf((float)(w[1] >> 24), 0.00390625f); }
    static __device__ __forceinline__ f32x4 rcp4(f32x4 g) { f32x4 r; r[0] = __builtin_amdgcn_rcpf(g[0]); r[1] = __builtin_amdgcn_rcpf(g[1]); r[2] = __builtin_amdgcn_rcpf(g[2]); r[3] = __builtin_amdgcn_rcpf(g[3]); return r; }
    __device__ __forceinline__ bool mid_at(int t) const { return t == 16 || t == 32; }
    __device__ __forceinline__ void mid(f32x4 (&acc)[2][2][4][2], const Unit& u, int wr, int wc, int fr, int fq, int t) const {
        const int row0 = u.pm * BM + wr * 64 + fr, col0 = u.pn * BM + wc * 32 + 8 * fq + (t == 16 ? 0 : 2048);
        const unsigned char* g0p = G + (size_t)row0 * gp + col0;
#pragma unroll
        for (int ai = 0; ai < 2; ++ai) { u32x2 nw[4][2], dw[4][2];
#pragma unroll
            for (int m = 0; m < 4; ++m)
#pragma unroll
                for (int bj = 0; bj < 2; ++bj) { const size_t ro = (size_t)(ai * HALF + m * 16);
                    nw[m][bj] = *(const u32x2*)(g0p + ro * gp + bj * HALF); dw[m][bj] = *(const u32x2*)(g0p + ro * gp + bj * HALF + 2048); }
#pragma unroll
            for (int m = 0; m < 4; ++m)
#pragma unroll
                for (int bj = 0; bj < 2; ++bj) { f32x4 n0, n1, d0, d1; un8(nw[m][bj], n0, n1); un8(dw[m][bj], d0, d1);
                    acc[ai][bj][m][0] *= n0 * rcp4(d0); acc[ai][bj][m][1] *= n1 * rcp4(d1); }
            asm volatile("" ::: "memory"); }
    }
    __device__ __forceinline__ void operator()(f32x4 (&acc)[2][2][4][2], const Unit& u, int wr, int wc, int fr, int fq) const {
        const int row0 = u.pm * BM + wr * 64 + fr, col0 = u.pn * BM + wc * 32 + 8 * fq;
        const unsigned char* g0p = G + (size_t)row0 * gp + col0 + 4096; bf16_t* m0p = Mg + (size_t)row0 * 2048 + col0;
#pragma unroll
        for (int ai = 0; ai < 2; ++ai) { u32x2 gw[4][2];
#pragma unroll
            for (int m = 0; m < 4; ++m)
#pragma unroll
                for (int bj = 0; bj < 2; ++bj) gw[m][bj] = *(const u32x2*)(g0p + (size_t)(ai * HALF + m * 16) * gp + bj * HALF);
#pragma unroll
            for (int m = 0; m < 4; ++m)
#pragma unroll
                for (int bj = 0; bj < 2; ++bj) { f32x4 g0, g1; un8(gw[m][bj], g0, g1);
                    *(u32x4*)(m0p + (size_t)(ai * HALF + m * 16) * 2048 + bj * HALF) = pack8_bf16(acc[ai][bj][m][0] * (g0 * (1.0f / 255.0f)), acc[ai][bj][m][1] * (g1 * (1.0f / 255.0f))); }
            asm volatile("" ::: "memory"); }
    }
};
template <> struct has_mid<EpiMerge3> { static constexpr bool value = true; };
template <bool FIRST> struct EpiMerge {
    static constexpr bool PERM = true, AFTER_DRAIN = false;
    bf16_t* Mg; const bf16_t* G; int gp;
    __device__ __forceinline__ void operator()(f32x4 (&acc)[2][2][4][2], const Unit& u, int wr, int wc, int fr, int fq) const {
        const int row0 = u.pm * BM + wr * 64 + fr, col0 = u.pn * BM + wc * 32 + 8 * fq;
        const bf16_t* g0p = G + (size_t)row0 * gp + col0; bf16_t* m0p = Mg + (size_t)row0 * 2048 + col0;
#pragma unroll
        for (int ai = 0; ai < 2; ++ai) { u32x4 gw[4][2], mw[4][2];
#pragma unroll
            for (int m = 0; m < 4; ++m)
#pragma unroll
                for (int bj = 0; bj < 2; ++bj) { const size_t ro = (size_t)(ai * HALF + m * 16);
                    gw[m][bj] = *(const u32x4*)(g0p + ro * gp + bj * HALF); if (!FIRST) mw[m][bj] = *(const u32x4*)(m0p + ro * 2048 + bj * HALF); }
#pragma unroll
            for (int m = 0; m < 4; ++m)
#pragma unroll
                for (int bj = 0; bj < 2; ++bj) { const size_t ro = (size_t)(ai * HALF + m * 16);
                    f32x4 g0, g1; unpack8_bf16(gw[m][bj], g0, g1); f32x4 v0 = acc[ai][bj][m][0] * g0, v1 = acc[ai][bj][m][1] * g1;
                    if (!FIRST) { f32x4 m0, m1; unpack8_bf16(mw[m][bj], m0, m1); v0 += m0; v1 += m1; }
                    *(u32x4*)(m0p + ro * 2048 + bj * HALF) = pack8_bf16(v0, v1); }
            asm volatile("" ::: "memory"); }
    }
};
template <bool F> struct FragA_ { bf16x8 v[4][2]; }; template <> struct FragA_<true> { v8i_t v[4]; };
template <bool F> struct FragB_ { bf16x8 v[2][2]; }; template <> struct FragB_<true> { v8i_t v[2]; };
template <class Epi, class Sched, bool ALIGN_EPI = false, bool SP2 = false, bool REVK = false, bool ATILED = false, bool BTILED = false, bool FP8 = false, bool I8 = false>
__device__ __forceinline__ void gemm_phase(PG8_LAS unsigned char* lds, const Gemm g, const Sched S, const Epi E, int wave_id) {
    unsigned m1_ = ~0u; asm volatile("" : "+s"(m1_)); int tid_ = wave_id * 64 + (int)__builtin_amdgcn_mbcnt_hi(m1_, __builtin_amdgcn_mbcnt_lo(m1_, 0u)); asm volatile("" : "+v"(tid_));
    const int tid = tid_, wid = __builtin_amdgcn_readfirstlane(tid >> 6), lane = tid & 63, wr = wid >> 2, wc = wid & 3, fr = lane & 15, fq = lane >> 4;
    const int K = g.K, nt = K / BK, LD = g.ld ? g.ld : K;
    unsigned voffA[2], voffB[2];
#pragma unroll
    for (int i = 0; i < 2; ++i) { int R, C; stage_rc(tid * 16 + i * 8192, R, C); const int Rb = Epi::PERM ? ((R & ~31) + perm32(R & 31)) : R;
        voffA[i] = ATILED ? (unsigned)(R * BK + C) * 2u : (unsigned)(R * LD + C) * 2u; voffB[i] = BTILED ? (unsigned)(Rb * BK + C) * 2u : (unsigned)(Rb * LD + C) * 2u; }
    const size_t kstep = REVK ? (size_t)0 - (size_t)(BK * 2) : (size_t)(BK * 2), kbase = REVK ? (size_t)(K - BK) * 2 : (size_t)0;
    const size_t hstep = (size_t)HALF * LD * 2;
    const size_t kstepB = BTILED ? (size_t)(BM * BK * 2) : kstep, hstepB = BTILED ? (size_t)(HALF * BK * 2) : hstep;
    const size_t kstepA = ATILED ? (size_t)(BM * BK * 2) : kstep, hstepA = ATILED ? (size_t)(HALF * BK * 2) : hstep;
    const size_t tstep = 2 * hstep;
    const unsigned ldsw = (unsigned)wid * 1024u;
    const int aoff = lds_byte(wr * 64 + fr, fq * 8), boff = lds_byte(wc * 32 + fr, fq * 8);
#define PG8_SA(b, h) (((b) * 2 + (h)) * HTB)
#define PG8_SB(b, h) ((4 + (b) * 2 + (h)) * HTB)
#define PG8_STAGE(bufoff, gbase, voff) do { _Pragma("unroll") for (int _i = 0; _i < 2; ++_i) \
        __builtin_amdgcn_global_load_lds((const unsigned*)((const char*)(gbase) + (voff)[_i]), (PG8_LAS unsigned*)(lds + (bufoff) + ldsw + _i * 8192), 16, 0, 0); } while (0)
#define PG8_LDA(dst, b, h) do { if constexpr (FP8) { _Pragma("unroll") for (int m = 0; m < 4; ++m) { const v4i_t lo_ = *(const PG8_LAS v4i_t*)(lds + PG8_SA(b, h) + aoff + m * 2048), hi_ = *(const PG8_LAS v4i_t*)(lds + PG8_SA(b, h) + aoff + m * 2048 + 1024); dst.v[m] = __builtin_shufflevector(lo_, hi_, 0, 1, 2, 3, 4, 5, 6, 7); } } \
        else { _Pragma("unroll") for (int m = 0; m < 4; ++m) _Pragma("unroll") for (int k = 0; k < 2; ++k) dst.v[m][k] = *(const PG8_LAS bf16x8*)(lds + PG8_SA(b, h) + aoff + m * 2048 + k * 1024); } } while (0)
#define PG8_LDB(dst, b, h) do { if constexpr (FP8) { _Pragma("unroll") for (int n = 0; n < 2; ++n) { const v4i_t lo_ = *(const PG8_LAS v4i_t*)(lds + PG8_SB(b, h) + boff + n * 2048), hi_ = *(const PG8_LAS v4i_t*)(lds + PG8_SB(b, h) + boff + n * 2048 + 1024); dst.v[n] = __builtin_shufflevector(lo_, hi_, 0, 1, 2, 3, 4, 5, 6, 7); } } \
        else { _Pragma("unroll") for (int n = 0; n < 2; ++n) _Pragma("unroll") for (int k = 0; k < 2; ++k) dst.v[n][k] = *(const PG8_LAS bf16x8*)(lds + PG8_SB(b, h) + boff + n * 2048 + k * 1024); } } while (0)
#define PG8_MMA(ai, bj, At, Bt) do { __builtin_amdgcn_s_setprio(1); \
        if constexpr (FP8) { _Pragma("unroll") for (int m = 0; m < 4; ++m) _Pragma("unroll") for (int n = 0; n < 2; ++n) \
            asm volatile("v_mfma_scale_f32_16x16x128_f8f6f4 %0, %1, %2, %0, %3, %3 op_sel_hi:[0,0,0]" : "+v"(acc[ai][bj][m][n]) : "v"(Bt.v[n]), "v"(At.v[m]), "v"(sc_one)); } \
        else { _Pragma("unroll") for (int m = 0; m < 4; ++m) _Pragma("unroll") for (int n = 0; n < 2; ++n) _Pragma("unroll") for (int k = 0; k < 2; ++k) \
            { if constexpr (I8) acc[ai][bj][m][n] = __builtin_bit_cast(f32x4, __builtin_amdgcn_mfma_i32_16x16x64_i8(__builtin_bit_cast(v4i_t, Bt.v[n][k]), __builtin_bit_cast(v4i_t, At.v[m][k]), __builtin_bit_cast(v4i_t, acc[ai][bj][m][n]), 0, 0, 0)); \
              else acc[ai][bj][m][n] = __builtin_amdgcn_mfma_f32_16x16x32_bf16(Bt.v[n][k], At.v[m][k], acc[ai][bj][m][n], 0, 0, 0); } } \
        __builtin_amdgcn_s_setprio(0); } while (0)
#define PG8_WAIT_V(n) asm volatile("s_waitcnt vmcnt(" #n ")" ::: "memory")
#define PG8_WAIT_L(n) asm volatile("s_waitcnt lgkmcnt(" #n ")" ::: "memory")
#define PG8_BAR __builtin_amdgcn_s_barrier()
#define PG8_SCHED __builtin_amdgcn_sched_barrier(0)
    Unit cur, nxt; int ui = 0;
    if (!S.next(0, cur)) return;
    f32x4 acc[2][2][4][2];
#pragma unroll
    for (int a = 0; a < 2; ++a)
#pragma unroll
        for (int b = 0; b < 2; ++b)
#pragma unroll
            for (int m = 0; m < 4; ++m)
#pragma unroll
                for (int n = 0; n < 2; ++n) acc[a][b][m][n] = (f32x4){0.f, 0.f, 0.f, 0.f};
    int sc_one = 0x7f7f7f7f; asm volatile("" : "+v"(sc_one));
    FragA_<FP8> At; FragB_<FP8> B0, B1;
    const char* cA = (const char*)g.A + (size_t)cur.pm * tstep + kbase; const char* cB = (const char*)g.Bt + (size_t)cur.pn * tstep + kbase;
    S.a_ready(cur);
    if constexpr (SP2) {
        PG8_STAGE(PG8_SB(0, 0), cB, voffB); PG8_STAGE(PG8_SB(0, 1), cB + hstepB, voffB); PG8_STAGE(PG8_SA(0, 0), cA, voffA); PG8_STAGE(PG8_SA(0, 1), cA + hstepA, voffA);
        if (wr == 1) PG8_BAR;
        PG8_WAIT_V(2); PG8_BAR;
        PG8_STAGE(PG8_SB(1, 0), cB + kstepB, voffB); PG8_STAGE(PG8_SA(1, 0), cA + kstepA, voffA); PG8_STAGE(PG8_SB(1, 1), cB + hstepB + kstepB, voffB);
        PG8_WAIT_V(6); PG8_BAR;
    } else {
        PG8_STAGE(PG8_SB(0, 0), cB, voffB); PG8_STAGE(PG8_SA(0, 0), cA, voffA); PG8_STAGE(PG8_SB(0, 1), cB + hstepB, voffB); PG8_STAGE(PG8_SA(0, 1), cA + hstepA, voffA);
        if (wr == 1) PG8_BAR;
        PG8_WAIT_V(4); PG8_BAR;
        PG8_STAGE(PG8_SB(1, 0), cB + kstepB, voffB); PG8_STAGE(PG8_SA(1, 0), cA + kstepA, voffA); PG8_STAGE(PG8_SB(1, 1), cB + hstepB + kstepB, voffB);
        PG8_WAIT_V(6); PG8_BAR;
    }
    for (;;) {
        const bool has_next = S.next(ui + 1, nxt);
        const char* nA = has_next ? (const char*)g.A + (size_t)nxt.pm * tstep + kbase : cA; const char* nB = has_next ? (const char*)g.Bt + (size_t)nxt.pn * tstep + kbase : cB;
        for (int t = 0; t < nt; t += 2) {
            if constexpr (has_mid<Epi>::value) { if (E.mid_at(t)) { int fr_m = fr, fq_m = fq; asm volatile("" : "+v"(fr_m), "+v"(fq_m)); E.mid(acc, cur, wr, wc, fr_m, fq_m, t); } }
            const bool last = (t == nt - 2);
            const char* a1 = cA + (size_t)(t + 1) * kstepA;
            const char* a2 = last ? nA : cA + (size_t)(t + 2) * kstepA; const char* b2 = last ? nB : cB + (size_t)(t + 2) * kstepB;
            const char* a3 = a2 + kstepA; const char* b3 = b2 + kstepB;
            if (last && has_next) S.a_ready(nxt);
            if constexpr (SP2) {
            PG8_LDB(B0, 0, 0); PG8_LDB(B1, 0, 1); PG8_SCHED; PG8_LDA(At, 0, 0); PG8_STAGE(PG8_SA(1, 1), a1 + hstepA, voffA);
            PG8_WAIT_V(8); PG8_WAIT_L(0); PG8_BAR; PG8_MMA(0, 0, At, B0); PG8_MMA(0, 1, At, B1); PG8_BAR; PG8_SCHED;
            PG8_LDA(At, 0, 1); PG8_STAGE(PG8_SB(0, 0), b2, voffB); PG8_STAGE(PG8_SB(0, 1), b2 + hstepB, voffB); PG8_STAGE(PG8_SA(0, 0), a2, voffA);
            PG8_WAIT_V(8); PG8_WAIT_L(0); PG8_BAR; PG8_MMA(1, 0, At, B0); PG8_MMA(1, 1, At, B1); PG8_BAR; PG8_SCHED;
            PG8_LDB(B0, 1, 0); PG8_LDB(B1, 1, 1); PG8_SCHED; PG8_LDA(At, 1, 0); PG8_STAGE(PG8_SA(0, 1), a2 + hstepA, voffA);
            PG8_WAIT_V(8); PG8_WAIT_L(0); PG8_BAR; PG8_MMA(0, 0, At, B0); PG8_MMA(0, 1, At, B1); PG8_BAR; PG8_SCHED;
            PG8_LDA(At, 1, 1); PG8_STAGE(PG8_SB(1, 0), b3, voffB); PG8_STAGE(PG8_SB(1, 1), b3 + hstepB, voffB); PG8_STAGE(PG8_SA(1, 0), a3, voffA);
            PG8_WAIT_V(8); PG8_WAIT_L(0); PG8_BAR; PG8_MMA(1, 0, At, B0); PG8_MMA(1, 1, At, B1); PG8_BAR; PG8_SCHED;
            } else {
            PG8_LDB(B0, 0, 0); PG8_SCHED; PG8_LDA(At, 0, 0); PG8_STAGE(PG8_SA(1, 1), a1 + hstepA, voffA);
            PG8_WAIT_L(8); PG8_BAR; PG8_WAIT_L(0); PG8_MMA(0, 0, At, B0); PG8_BAR; PG8_SCHED;
            PG8_LDB(B1, 0, 1); PG8_STAGE(PG8_SB(0, 0), b2, voffB);
            PG8_BAR; PG8_WAIT_L(0); PG8_MMA(0, 1, At, B1); PG8_BAR;
            PG8_LDA(At, 0, 1); PG8_STAGE(PG8_SA(0, 0), a2, voffA);
            PG8_BAR; PG8_WAIT_L(0); PG8_MMA(1, 0, At, B0); PG8_BAR; PG8_SCHED;
            PG8_STAGE(PG8_SB(0, 1), b2 + hstepB, voffB);
            PG8_WAIT_V(6); PG8_BAR; PG8_MMA(1, 1, At, B1); PG8_BAR;
            PG8_LDB(B0, 1, 0); PG8_SCHED; PG8_LDA(At, 1, 0); PG8_STAGE(PG8_SA(0, 1), a2 + hstepA, voffA);
            PG8_WAIT_L(8); PG8_BAR; PG8_WAIT_L(0); PG8_MMA(0, 0, At, B0); PG8_BAR; PG8_SCHED;
            PG8_LDB(B1, 1, 1); PG8_STAGE(PG8_SB(1, 0), b3, voffB);
            PG8_BAR; PG8_WAIT_L(0); PG8_MMA(0, 1, At, B1); PG8_BAR;
            PG8_LDA(At, 1, 1); PG8_STAGE(PG8_SA(1, 0), a3, voffA);
            PG8_BAR; PG8_WAIT_L(0); PG8_MMA(1, 0, At, B0); PG8_BAR; PG8_SCHED;
            PG8_STAGE(PG8_SB(1, 1), b3 + hstepB, voffB);
            PG8_WAIT_V(6); PG8_BAR; PG8_MMA(1, 1, At, B1); PG8_BAR;
            }
        }
        if constexpr (FP8) { asm volatile("s_nop 15\n\ts_nop 15\n\ts_nop 15\n\ts_nop 15\n\ts_nop 15" ::: "memory"); }
        if constexpr (ALIGN_EPI) { if (wr == 0) PG8_BAR; }
        if constexpr (!Epi::AFTER_DRAIN) { int fr_e = fr, fq_e = fq; asm volatile("" : "+v"(fr_e), "+v"(fq_e));
            E(acc, cur, wr, wc, fr_e, fq_e); S.done(cur); }
        if (!has_next) break;
#pragma unroll
        for (int a = 0; a < 2; ++a)
#pragma unroll
            for (int b = 0; b < 2; ++b)
#pragma unroll
                for (int m = 0; m < 4; ++m)
#pragma unroll
                    for (int n = 0; n < 2; ++n) acc[a][b][m][n] = (f32x4){0.f, 0.f, 0.f, 0.f};
        cur = nxt; cA = nA; cB = nB; ++ui;
        if constexpr (ALIGN_EPI) { if (wr == 1) PG8_BAR; }
    }
    PG8_WAIT_V(0);
    if constexpr (!ALIGN_EPI) { if (wr == 0) PG8_BAR; }
    PG8_BAR;
    if constexpr (Epi::AFTER_DRAIN) { E.fused(acc, cur, wr, wc, fr, fq, lds, wid, lane); S.done(cur); }
#undef PG8_SA
#undef PG8_SB
#undef PG8_STAGE
#undef PG8_LDA
#undef PG8_LDB
#undef PG8_MMA
#undef PG8_WAIT_V
#undef PG8_WAIT_L
#undef PG8_BAR
#undef PG8_SCHED
}
}
namespace att {
#define ATT_LAS __attribute__((address_space(3)))
typedef unsigned short bf16;
typedef short bf16x8 __attribute__((ext_vector_type(8)));
typedef short s16x4 __attribute__((ext_vector_type(4)));
typedef float f32x16 __attribute__((ext_vector_type(16)));
typedef float f32x4 __attribute__((ext_vector_type(4)));
typedef unsigned u32x4 __attribute__((ext_vector_type(4)));
constexpr int NW = 8, QBLK = 32, KVBLK = 64, QB = NW * QBLK;
constexpr int SEQ = 2048, NH = 16, QPITCH = 3072, KPITCH = 2048, PEPITCH = 64, OPITCH = 4096  , QHEAD = 192;
constexpr float SCALE = 0.07216878364870322f;
constexpr float THR = 8.f;
constexpr int SHM_V = 16384, SHM_KN = 16384, SHM_KP = 8192;
constexpr int OFF_V = 0, OFF_KN = 3 * SHM_V, OFF_KP = OFF_KN + 2 * SHM_KN, OFF_WS = OFF_KP + 2 * SHM_KP, LDS_BYTES = OFF_WS + NW * 64 * 4;
#define ATT_KSWZ(row, colB) ((row) * 256 + ((colB) ^ (((row) & 7) << 4)))
#define ATT_KPSWZ(row, ch) ((row) * 128 + ((((ch) ^ (((row) >> 1) & 7))) << 4))
#define ATT_SBAR() __builtin_amdgcn_sched_barrier(0)
__device__ __forceinline__ int v_st(int k, int c) { const int kk = (k & ~0xC) | ((k & 4) << 1) | ((k & 8) >> 1); return ((kk >> 3) * 4 + (c >> 5)) * 512 + ((kk & 7) * 32 + (c & 31)) * 2; }
__device__ __forceinline__ int v_rd_base(int lane) { return ((lane & 3) << 3) | (((lane >> 2) & 3) << 6) | (((lane >> 4) & 1) << 5) | (((lane >> 5) & 1) << 8); }
constexpr int v_rd_off(int d0, int ks, int half) { return d0 * 512 + ks * 4096 + half * 2048; }
__device__ __forceinline__ int crow(int r, int hi) { return (r & 3) + 8 * (r >> 2) + 4 * hi; }
__device__ __forceinline__ unsigned cvtpk(float lo, float hi) { unsigned r; asm volatile("v_cvt_pk_bf16_f32 %0, %1, %2" : "=v"(r) : "v"(lo), "v"(hi)); return r; }
__device__ __forceinline__ void mask_tile(f32x16& p0, f32x16& p1, int dq) {
    const float NEG = -__builtin_inff();
#pragma unroll
    for (int r = 0; r < 16; ++r) { const int c = (r & 3) + 8 * (r >> 2); if (dq - c < 0) p0[r] = NEG; if (dq - c - 32 < 0) p1[r] = NEG; }
}
__device__ __forceinline__ void partialSM(f32x16& p0, f32x16& p1, float& m_reg, float& mn, float& alpha) {
    float pmax = p0[0];
#pragma unroll
    for (int r = 1; r < 16; ++r) pmax = fmaxf(pmax, p0[r]);
#pragma unroll
    for (int r = 0; r < 16; ++r) pmax = fmaxf(pmax, p1[r]);
    { auto rr = __builtin_amdgcn_permlane32_swap(__float_as_uint(pmax), __float_as_uint(pmax), false, false); pmax = fmaxf(__uint_as_float(rr[0]), __uint_as_float(rr[1])); }
    constexpr float C2 = 1.4426950408889634f * SCALE;
    if (__builtin_expect(__all((pmax - m_reg) * SCALE <= THR), 1)) { mn = m_reg; alpha = 1.f; }
    else { mn = fmaxf(m_reg, pmax); alpha = __builtin_amdgcn_exp2f((m_reg - mn) * C2); m_reg = mn; }
    const float mnL = -mn * C2;
#pragma unroll
    for (int r = 0; r < 16; ++r) p0[r] = fmaf(p0[r], C2, mnL);
#pragma unroll
    for (int r = 0; r < 16; ++r) p1[r] = fmaf(p1[r], C2, mnL);
#pragma unroll
    for (int r = 0; r < 16; ++r) p0[r] = __builtin_amdgcn_exp2f(p0[r]);
}
__device__ __forceinline__ void finishSM(f32x16& p0, f32x16& p1, float alpha, float& l_reg, bf16x8& pa0, bf16x8& pa1, bf16x8& pa2, bf16x8& pa3) {
#pragma unroll
    for (int r = 0; r < 16; ++r) p1[r] = __builtin_amdgcn_exp2f(p1[r]);
    float ps = 0;
#pragma unroll
    for (int r = 0; r < 16; ++r) ps += p0[r];
#pragma unroll
    for (int r = 0; r < 16; ++r) ps += p1[r];
    { auto rr = __builtin_amdgcn_permlane32_swap(__float_as_uint(ps), __float_as_uint(ps), false, false); ps = __uint_as_float(rr[0]) + __uint_as_float(rr[1]); }
    l_reg = l_reg * alpha + ps;
#define ATT_PK4(P, B_, OUT) do { unsigned a0 = cvtpk(P[B_+0], P[B_+1]), a1 = cvtpk(P[B_+2], P[B_+3]);                          \
        unsigned b0 = cvtpk(P[B_+4], P[B_+5]), b1 = cvtpk(P[B_+6], P[B_+7]);                                             \
        auto r0 = __builtin_amdgcn_permlane32_swap(a0, b0, false, false); auto r1 = __builtin_amdgcn_permlane32_swap(a1, b1, false, false); \
        u32x4 w = {r0[0], r1[0], r0[1], r1[1]}; OUT = __builtin_bit_cast(bf16x8, w); } while (0)
    ATT_PK4(p0, 0, pa0); ATT_PK4(p0, 8, pa1); ATT_PK4(p1, 0, pa2); ATT_PK4(p1, 8, pa3);
#undef ATT_PK4
}
__device__ __forceinline__ void qkt(f32x16& p0, f32x16& p1, ATT_LAS const char* lds, int kbuf, int r32, int hi, const bf16x8* qr) {
    p0 = f32x16{}; p1 = f32x16{};
    ATT_LAS const char* kb[4];
#pragma unroll
    for (int dd = 0; dd < 4; ++dd) kb[dd] = lds + OFF_KN + kbuf * SHM_KN + ATT_KSWZ(r32, (dd * 16 + hi * 8) * 2);
#pragma unroll
    for (int d0 = 0; d0 < 8; ++d0) { ATT_LAS const char* a = kb[d0 & 3] + (d0 >> 2) * 128;
        const bf16x8 b0 = *(ATT_LAS const bf16x8*)a;
        const bf16x8 b1 = *(ATT_LAS const bf16x8*)(a + 32 * 256);
        p0 = __builtin_amdgcn_mfma_f32_32x32x16_bf16(b0, qr[d0], p0, 0, 0, 0);
        p1 = __builtin_amdgcn_mfma_f32_32x32x16_bf16(b1, qr[d0], p1, 0, 0, 0); }
#pragma unroll
    for (int d1 = 0; d1 < 4; ++d1) { ATT_LAS const char* a = lds + OFF_KP + kbuf * SHM_KP + ATT_KPSWZ(r32, 2 * d1 + hi);
        const bf16x8 b0 = *(ATT_LAS const bf16x8*)a;
        const bf16x8 b1 = *(ATT_LAS const bf16x8*)(a + 32 * 128);
        p0 = __builtin_amdgcn_mfma_f32_32x32x16_bf16(b0, qr[8 + d1], p0, 0, 0, 0);
        p1 = __builtin_amdgcn_mfma_f32_32x32x16_bf16(b1, qr[8 + d1], p1, 0, 0, 0); }
}
__device__ __forceinline__ void pv_tile(f32x16* o, int vb0, bf16x8 pa0, bf16x8 pa1, bf16x8 pa2, bf16x8 pa3) {
#define ATT_TRRD(dst, off) asm volatile("ds_read_b64_tr_b16 %0, %1 offset:%2" : "=&v"(dst) : "v"(vb0), "i"(off) : "memory")
#define ATT_PV_RD(S, d0) do { constexpr int b_ = OFF_V + v_rd_off(d0, 0, 0); \
        ATT_TRRD(S##l0, b_); ATT_TRRD(S##h0, b_ + 2048); ATT_TRRD(S##l1, b_ + 4096); ATT_TRRD(S##h1, b_ + 6144); ATT_TRRD(S##l2, b_ + 8192); ATT_TRRD(S##h2, b_ + 10240); ATT_TRRD(S##l3, b_ + 12288); ATT_TRRD(S##h3, b_ + 14336); } while (0)
#define ATT_PV_MM(S, d0) do { \
        o[d0] = __builtin_amdgcn_mfma_f32_32x32x16_bf16(pa0, (bf16x8){S##l0[0], S##l0[1], S##l0[2], S##l0[3], S##h0[0], S##h0[1], S##h0[2], S##h0[3]}, o[d0], 0, 0, 0);   \
        o[d0] = __builtin_amdgcn_mfma_f32_32x32x16_bf16(pa1, (bf16x8){S##l1[0], S##l1[1], S##l1[2], S##l1[3], S##h1[0], S##h1[1], S##h1[2], S##h1[3]}, o[d0], 0, 0, 0);   \
        o[d0] = __builtin_amdgcn_mfma_f32_32x32x16_bf16(pa2, (bf16x8){S##l2[0], S##l2[1], S##l2[2], S##l2[3], S##h2[0], S##h2[1], S##h2[2], S##h2[3]}, o[d0], 0, 0, 0);   \
        o[d0] = __builtin_amdgcn_mfma_f32_32x32x16_bf16(pa3, (bf16x8){S##l3[0], S##l3[1], S##l3[2], S##l3[3], S##h3[0], S##h3[1], S##h3[2], S##h3[3]}, o[d0], 0, 0, 0); } while (0)
#define ATT_LGK(n) do { asm volatile("s_waitcnt lgkmcnt(" #n ")" ::: "memory"); ATT_SBAR(); } while (0)
    s16x4 Al0, Al1, Al2, Al3, Ah0, Ah1, Ah2, Ah3, Bl0, Bl1, Bl2, Bl3, Bh0, Bh1, Bh2, Bh3;
    ATT_PV_RD(A, 0);
    ATT_PV_RD(B, 1); ATT_LGK(8); ATT_PV_MM(A, 0); ATT_SBAR();
    ATT_PV_RD(A, 2); ATT_LGK(8); ATT_PV_MM(B, 1); ATT_SBAR();
    ATT_PV_RD(B, 3); ATT_LGK(8); ATT_PV_MM(A, 2); ATT_SBAR();
    ATT_LGK(0); ATT_PV_MM(B, 3);
#undef ATT_LGK
#undef ATT_PV_MM
#undef ATT_PV_RD
#undef ATT_TRRD
}
__device__ __forceinline__ void attn_unit(int b, int h, int qb, const bf16* __restrict__ Q, const bf16* __restrict__ KN, const bf16* __restrict__ KPE, const bf16* __restrict__ V, bf16* __restrict__ O, ATT_LAS char* lds, int wave_id) {
    unsigned m1_ = ~0u; asm volatile("" : "+s"(m1_)); int tid_ = wave_id * 64 + (int)__builtin_amdgcn_mbcnt_hi(m1_, __builtin_amdgcn_mbcnt_lo(m1_, 0u)); asm volatile("" : "+v"(tid_));
    const int tid = tid_, wid = __builtin_amdgcn_readfirstlane(tid >> 6), lane = tid & 63, r32 = lane & 31, hi = lane >> 5;
    const size_t rowbase = (size_t)b * SEQ; const int q0 = qb * QB, NT = (q0 + QB) / KVBLK;
    const int qlo = q0 + wid * QBLK, qm = qlo + r32 - 4 * hi;
    ATT_LAS float* ws = (ATT_LAS float*)(lds + OFF_WS) + wid * 64; ATT_LAS float* li_l = ws; ATT_LAS float* al_l = ws + 32;
    const int sr = tid >> 4, sc = (tid & 15) * 8, vst0 = v_st(sr, sc), vst1 = v_st(32 + sr, sc), kws = ATT_KSWZ(sr, sc * 2);
    const int pr = tid >> 3, pc = tid & 7, kpw = ATT_KPSWZ(pr, pc);
    const bf16* gK = KN + (rowbase + sr) * KPITCH + h * 128 + sc;
    const bf16* gV = V + (rowbase + sr) * KPITCH + h * 128 + sc;
    const bf16* gP = KPE + (rowbase + pr) * PEPITCH + pc * 8;
    const int vb0 = (int)(uintptr_t)lds + v_rd_base(lane);
    bf16x8 st_k0, st_k1, st_v0, st_v1, st_p;
#define ATT_SLOAD(t) do { const size_t ko_ = (size_t)(t) * KVBLK; st_v0 = *(const bf16x8*)(gV + ko_ * KPITCH); st_v1 = *(const bf16x8*)(gV + (ko_ + 32) * KPITCH); \
        st_k0 = *(const bf16x8*)(gK + ko_ * KPITCH); st_k1 = *(const bf16x8*)(gK + (ko_ + 32) * KPITCH); st_p = *(const bf16x8*)(gP + ko_ * PEPITCH); } while (0)
#define ATT_SWRITE(kbf, vbf) do { *(ATT_LAS bf16x8*)(lds + OFF_V + (vbf) * SHM_V + vst0) = st_v0; *(ATT_LAS bf16x8*)(lds + OFF_V + (vbf) * SHM_V + vst1) = st_v1; \
        *(ATT_LAS bf16x8*)(lds + OFF_KN + (kbf) * SHM_KN + kws) = st_k0; *(ATT_LAS bf16x8*)(lds + OFF_KN + (kbf) * SHM_KN + kws + 32 * 256) = st_k1; \
        *(ATT_LAS bf16x8*)(lds + OFF_KP + (kbf) * SHM_KP + kpw) = st_p; } while (0)
#define ATT_VMW() asm volatile("s_waitcnt vmcnt(0)" ::: "memory")
    bf16x8 qr[12];
    { const bf16* Qw = Q + (rowbase + qlo + r32) * QPITCH + h * QHEAD + hi * 8;
#pragma unroll
      for (int d0 = 0; d0 < 12; ++d0) qr[d0] = *(const bf16x8*)(Qw + d0 * 16); }
    ATT_SLOAD(0); ATT_VMW(); ATT_SWRITE(0, 0); __syncthreads();
    float m_reg = -1e30f, l_reg = 0.f; f32x16 o[4] = {};
#define ATT_RESC(a) do { if (__any((a) < 1.f)) { if (hi == 0) al_l[r32] = (a); asm volatile("s_waitcnt lgkmcnt(0)" ::: "memory");              \
        _Pragma("unroll") for (int d_ = 0; d_ < 4; ++d_) _Pragma("unroll") for (int r = 0; r < 16; ++r) o[d_][r] *= al_l[crow(r, hi)]; } } while (0)
    const bool grpB = wid >= 4;
    bf16x8 pa0 = {}, pa1 = {}, pa2 = {}, pa3 = {};
    bool act_prev = false; int kbuf = 0, vbuf = 0, vprev = 0;
    for (int t = 0; t < NT; ++t) {
        const int vnext = (vbuf == 2) ? 0 : vbuf + 1;
        if (t + 1 < NT) ATT_SLOAD(t + 1);
        ATT_SBAR();
        const int kb_ = t * KVBLK; const bool act = kb_ <= qlo + QBLK - 1;
        if (grpB && act_prev) { pv_tile(o, vb0 + vprev * SHM_V, pa0, pa1, pa2, pa3); ATT_SBAR(); }
        if (act) {
            f32x16 p0, p1; qkt(p0, p1, lds, kbuf, r32, hi, qr);
            if (kb_ + KVBLK - 1 > qlo) mask_tile(p0, p1, qm - kb_);
            float mn, alpha; partialSM(p0, p1, m_reg, mn, alpha);
            ATT_RESC(alpha);
            finishSM(p0, p1, alpha, l_reg, pa0, pa1, pa2, pa3); ATT_SBAR();
            if (!grpB) pv_tile(o, vb0 + vbuf * SHM_V, pa0, pa1, pa2, pa3); }
        ATT_SBAR();
        if (t + 1 < NT) { ATT_VMW(); ATT_SWRITE(kbuf ^ 1, vnext); }
        __syncthreads();
        act_prev = act; vprev = vbuf; vbuf = vnext; kbuf ^= 1;
    }
    if (grpB && act_prev) pv_tile(o, vb0 + vprev * SHM_V, pa0, pa1, pa2, pa3);
    if (hi == 0) li_l[r32] = l_reg; asm volatile("s_waitcnt lgkmcnt(0)" ::: "memory");
    float rli[16];
#pragma unroll
    for (int r = 0; r < 16; ++r) rli[r] = __builtin_amdgcn_rcpf(li_l[crow(r, hi)]);
    bf16* Ow = O + (rowbase + qlo) * OPITCH + h * 128;
#pragma unroll
    for (int r = 0; r < 16; ++r) { const int orow = crow(r, hi);
#pragma unroll
        for (int d0 = 0; d0 < 4; ++d0) { const float v = o[d0][r] * rli[r]; const float vn = __shfl_xor(v, 1);
            if ((r32 & 1) == 0) *(unsigned*)(Ow + (size_t)orow * OPITCH + d0 * 32 + r32) = cvtpk(v, vn); } }
    __syncthreads();
#undef ATT_SLOAD
#undef ATT_SWRITE
#undef ATT_VMW
#undef ATT_RESC
}
}
#ifndef MK_N_LAUNCHES
#define MK_N_LAUNCHES 1
#endif
constexpr int NWAVES = 8;
constexpr int NB = 8, SEQ = 2048, M = NB * SEQ, D = 2048, DFF = 5632, LW = 1024, NHD = 16, KVR = 512, INW = 14912, INWP = 15104, MODW = 9 * 2048, NL = 2;
constexpr float EPS = 1e-6f;
constexpr int PPL = 9, N_PHASES = 3 + PPL * NL;
constexpr int CBW = 15104;
constexpr size_t MiB = 1u << 20;
constexpr size_t WS_CTL = 0, CTL_ZERO_BYTES = 4 * MiB;
constexpr size_t WS_SSQ = 12 * MiB + 768 * 1024;
constexpr size_t WS_SSQN = 12 * MiB;
constexpr size_t WS_WSC = 32768;
constexpr size_t WS_CB = 1 * MiB;
constexpr size_t WS_MOD = 4 * MiB;
constexpr size_t WS_COS = 6 * MiB, WS_SIN = 8 * MiB;
constexpr size_t WS_AGG = 10 * MiB;
constexpr size_t WS_WAX = 11 * MiB;
constexpr size_t WS_W = 16 * MiB, W_LAYER = 219 * MiB;
#ifndef FP8_Q
#define FP8_Q 1
#endif
#ifndef FP8_ALL
#define FP8_ALL 0
#endif
#ifndef FP8_DN
#define FP8_DN 15
#endif
constexpr bool fp8_dn(int l, int f) { return ((FP8_DN >> (2 * l + f)) & 1) != 0; }
#ifndef FP8_G1
#define FP8_G1 0
#endif
#ifndef FP8_G4
#define FP8_G4 0
#endif
#ifndef G1_BF16
#define G1_BF16 1
#endif
constexpr int WIN_QF8 = FP8_Q, WINB_REAL = FP8_ALL ? 0 : (WIN_QF8 ? 5696 : 8768), WINB_PADEND = FP8_ALL ? 0 : (WIN_QF8 ? 5888 : 8960), WINB_ROWS = G1_BF16 ? 7936 : WINB_PADEND, WINF_ROWS = FP8_ALL ? 15104 : (WIN_QF8 ? (G1_BF16 ? 7168 : 9216) : 6144);
static_assert(!G1_BF16 || (FP8_Q && !FP8_ALL), "G1_BF16 needs the q + gates fp8 split");
constexpr size_t WO_WIN8 = FP8_ALL ? 132 * MiB : 168 * MiB;
constexpr size_t WO_W13 = 0, WO_W2 = 88 * MiB, WO_WIN = 132 * MiB, WO_WCAT = 191 * MiB  , WO_LRUO = WO_WCAT, WO_SCO = WO_WCAT + 1024 * 2, WO_MLAO = WO_WCAT + 2048 * 2, WO_UKV = 207 * MiB, WO_WO = 211 * MiB;
constexpr int YP = 4096;
constexpr size_t WS_HN = 456 * MiB;
constexpr size_t WS_LRUX = 520 * MiB, WS_LRUG = 552 * MiB, WS_SCB = 584 * MiB, WS_SCC = 616 * MiB, WS_SCX = 648 * MiB, WS_Q = 680 * MiB, WS_KVLAT = 776 * MiB, WS_GATES = 792 * MiB, WS_KPE = 984 * MiB;
constexpr size_t WS_ACT = 520 * MiB;
constexpr size_t WS_KN = 986 * MiB, WS_V = 1050 * MiB;
constexpr size_t WS_R = 456 * MiB, WS_GX = 488 * MiB;
constexpr size_t WS_YCAT = 1114 * MiB, WS_YLRU = WS_YCAT, WS_YSC = WS_YCAT + 1024 * 2, WS_ATT = WS_YCAT + 2048 * 2;
constexpr size_t WS_MERGED = 520 * MiB;
constexpr size_t WS_XH = 1242 * MiB;
constexpr size_t WS_A8 = 1306 * MiB;
constexpr size_t WS_END = 1338 * MiB;
static_assert(WS_W + NL * W_LAYER <= WS_HN && WS_ACT + (size_t)M * DFF * 2 <= WS_KN && WS_KPE + (size_t)M * 64 * 2 <= WS_KN && WS_YCAT + (size_t)M * YP * 2 <= WS_XH && WS_GX + (size_t)M * LW * 2 <= WS_LRUX && WS_XH + (size_t)M * D * 2 <= WS_A8 && WS_A8 + (size_t)M * D <= WS_END, "d_ws map");
static_assert(WS_SSQN + (size_t)NL * 3 * M * 8 <= WS_SSQ && WS_SSQ + (size_t)NL * M * 8 <= WS_W && WS_WAX + (size_t)NL * 2 * 8 * 16384 * 2 <= WS_SSQN && WS_CB + (size_t)NL * 3 * NB * CBW * 4 <= CTL_ZERO_BYTES && WS_MOD + (size_t)NL * NB * MODW * 4 <= WS_COS, "zeroed region map");
constexpr int CW_TMO = 0, CW_CODE = 1, CW_BAR = 4096;
constexpr int RING_OFF = 0, RING_BYTES = 131072;
constexpr int LDSCTL_OFF = RING_BYTES, MISC_OFF = LDSCTL_OFF + 320;
constexpr int LDS_BYTES = 147456;
#define GAS __attribute__((address_space(1)))
#define LAS __attribute__((address_space(3)))
typedef unsigned short bf16;
typedef unsigned v4u __attribute__((ext_vector_type(4)));
typedef unsigned v2u __attribute__((ext_vector_type(2)));
typedef float f32x4 __attribute__((ext_vector_type(4)));
typedef short bf16x8 __attribute__((ext_vector_type(8)));
typedef GAS unsigned gu32;
#define RLX_AGENT __ATOMIC_RELAXED, __HIP_MEMORY_SCOPE_AGENT
#define LDS_WAIT() asm volatile("s_waitcnt lgkmcnt(0)" ::: "memory")
#define VM_WAIT() asm volatile("s_waitcnt vmcnt(0)" ::: "memory")
__device__ __forceinline__ unsigned f2bf(float f) { unsigned u = __builtin_bit_cast(unsigned, f); return (u + 0x7fffu + ((u >> 16) & 1u)) >> 16; }
__device__ __forceinline__ unsigned pk2(float lo, float hi) { return f2bf(lo) | (f2bf(hi) << 16); }
__device__ __forceinline__ float bf2f(unsigned short b) { return __uint_as_float((unsigned)b << 16); }
__device__ __forceinline__ void unpack8(const v4u w, float (&f)[8]) {
    f[0] = __uint_as_float(w.x << 16); f[1] = __uint_as_float(w.x & 0xffff0000u); f[2] = __uint_as_float(w.y << 16); f[3] = __uint_as_float(w.y & 0xffff0000u);
    f[4] = __uint_as_float(w.z << 16); f[5] = __uint_as_float(w.z & 0xffff0000u); f[6] = __uint_as_float(w.w << 16); f[7] = __uint_as_float(w.w & 0xffff0000u); }
__device__ __forceinline__ v4u pack8(const float (&f)[8]) { v4u w; w.x = pk2(f[0], f[1]); w.y = pk2(f[2], f[3]); w.z = pk2(f[4], f[5]); w.w = pk2(f[6], f[7]); return w; }

#define XB_TMO      128
#define XB_XCNT(j)  (256  + 64 * (j))
#define XB_XSUB(j)  (1280 + 64 * (j))
#define XB_XGEN(j)  (2304 + 64 * (j))
#define XB_TOP      3328
#define XB_TOPGEN   3392
#define XCD_BAR_WORDS 3456
#define XB_SPIN_CAP (1u << 18)

__device__ __forceinline__ unsigned xb_ld(unsigned* p)              { return __hip_atomic_load(p, __ATOMIC_RELAXED, __HIP_MEMORY_SCOPE_AGENT); }
__device__ __forceinline__ unsigned xb_add(unsigned* p, unsigned v) { return __hip_atomic_fetch_add(p, v, __ATOMIC_RELAXED, __HIP_MEMORY_SCOPE_AGENT); }
__device__ __forceinline__ unsigned xb_xcc_id() { return (unsigned)__builtin_amdgcn_s_getreg((3 << 11) | 20) & 0xFu; }
#define XB_SPIN(cond, bar) do { unsigned _sp = 0; while (cond) { __builtin_amdgcn_s_sleep(1); \
    if ((++_sp & 255u) == 0u) { if (xb_ld(&(bar)[XB_TMO])) break; if (_sp > XB_SPIN_CAP) { atomicAdd(&(bar)[XB_TMO], 1u); break; } } } } while (0)

struct XcdBarrier {
    unsigned* bar; unsigned x;
    volatile LAS unsigned* st;
};

__device__ __forceinline__ XcdBarrier xcd_barrier_post(unsigned* bar, volatile LAS unsigned* st) {
    XcdBarrier b; b.bar = bar; b.x = xb_xcc_id(); b.st = st;
    if (threadIdx.x == 0) (void)xb_add(&bar[XB_XCNT(b.x)], 1u);
    return b;
}
__device__ __forceinline__ void xcd_barrier_complete(unsigned* bar, unsigned x, unsigned& nloc, unsigned& nx) {
    const unsigned G = gridDim.x * gridDim.y * gridDim.z;
    unsigned sum, cnt, mine, sp = 0u;
    for (;;) {
        sum = 0u; cnt = 0u; mine = 0u;
#pragma unroll
        for (unsigned j = 0; j < 16; ++j) { const unsigned c = xb_ld(&bar[XB_XCNT(j)]); sum += c; cnt += (c > 0u) ? 1u : 0u; mine = (j == x) ? c : mine; }
        if (sum == G) break;
        __builtin_amdgcn_s_sleep(1);
        if ((++sp & 255u) == 0u) { if (xb_ld(&bar[XB_TMO])) break; if (sp > XB_SPIN_CAP) { atomicAdd(&bar[XB_TMO], 1u); break; } }
    }
    nloc = mine > 0u ? mine : 1u; nx = cnt > 0u ? cnt : 1u;
}

__device__ __forceinline__ void xcd_barrier(const XcdBarrier& b) {
    asm volatile("s_waitcnt vmcnt(0)" ::: "memory");
    __syncthreads();
    if (threadIdx.x == 0) {
        unsigned* bar = b.bar;
        __builtin_amdgcn_s_waitcnt(0);
        unsigned nloc = b.st[0], nx = b.st[1];
        if (nloc == 0u) { xcd_barrier_complete(bar, b.x, nloc, nx); b.st[0] = nloc; b.st[1] = nx; }
        const unsigned old = xb_add(&bar[XB_XSUB(b.x)], 1u);
        const unsigned gen = old / nloc;
        if (old + 1u == (gen + 1u) * nloc) {
            __builtin_amdgcn_fence(__ATOMIC_RELEASE, "agent");
            asm volatile("s_waitcnt vmcnt(0)" ::: "memory");
            const unsigned og = xb_add(&bar[XB_TOP], 1u);
            const unsigned tg = og / nx;
            if (og + 1u == (tg + 1u) * nx) xb_add(&bar[XB_TOPGEN], 1u);
            else XB_SPIN(xb_ld(&bar[XB_TOPGEN]) == tg, bar);
            __builtin_amdgcn_fence(__ATOMIC_ACQUIRE, "agent");
            xb_add(&bar[XB_XGEN(b.x)], 1u);
            asm volatile("s_waitcnt vmcnt(0)" ::: "memory");
        } else {
            XB_SPIN(xb_ld(&bar[XB_XGEN(b.x)]) == gen, bar);
            __builtin_amdgcn_fence(__ATOMIC_ACQUIRE, "agent");
            asm volatile("s_waitcnt vmcnt(0)" ::: "memory");
        }
    }
    __syncthreads();
}
struct Frame {
    LAS unsigned char* lds; volatile LAS unsigned* MISC; gu32* ctl;
    int tid, lane, wave, vcu, G;
    GAS float* out; GAS unsigned char* ws;
};
typedef __attribute__((address_space(4))) const char* kaddr_t;
__device__ __forceinline__ const float* in_ptr(int i) { kaddr_t ka = (kaddr_t)__builtin_amdgcn_kernarg_segment_ptr(); asm volatile("" : "+s"(ka)); typedef GAS const float* cfp_t; typedef __attribute__((address_space(4))) const cfp_t* kpp_t; return (const float*)(*(kpp_t)(ka + 8 * i)); }
__device__ __forceinline__ GAS unsigned char* karg_ptr(int i) { kaddr_t ka = (kaddr_t)__builtin_amdgcn_kernarg_segment_ptr(); asm volatile("" : "+s"(ka)); typedef GAS unsigned char* gp_t; typedef __attribute__((address_space(4))) const gp_t* kpp_t; return *(kpp_t)(ka + 8 * i); }
enum { I_X = 0, I_C = 1, I_POS = 2, I_ADAW = 3, I_ADAB = 4, I_NORMG = 5, I_W13 = 6, I_W2 = 7, I_WIN = 8, I_LCW = 9, I_LCB = 10, I_LWA = 11, I_LBA = 12, I_LWX = 13, I_LBX = 14, I_LAM = 15,
       I_LOUT = 16, I_SCW = 17, I_SCOUT = 18, I_KVG = 19, I_UKV = 20, I_MLAO = 21, I_WO = 22, I_FING = 23 };
__device__ __forceinline__ float wave_sum(float v) {
#pragma unroll
    for (int o = 1; o < 64; o <<= 1) v += __shfl_xor(v, o);
    return v;
}
template <bool CB, bool F8 = false>
__device__ __forceinline__ void transpose_item(const float* W, int K, int N, bf16* WT, int dst_row0, int k0, int n0, const float* ks, LAS float* scr, int lane, const float* shp, float (&cbacc)[8], bool tiled = false, int ldk = 0) {
    float v[32];
    const GAS float* wp = (const GAS float*)W + (size_t)(k0 + (lane >> 5)) * N + n0 + (lane & 31);
#pragma unroll
    for (int i = 0; i < 32; ++i) { v[i] = *wp; wp += 2 * (size_t)N; asm volatile("" : "+v"(wp)); }
    if (CB) {
        LAS float* sht = scr + 64 * 33;
        float sv[8];
#pragma unroll
        for (int b = 0; b < 8; ++b) sv[b] = ((const GAS float*)shp)[(size_t)b * MODW + k0 + lane];
#pragma unroll
        for (int b = 0; b < 8; ++b) sht[(b * 2 + (lane & 1)) * 32 + (lane >> 1)] = sv[b];
        LDS_WAIT(); asm volatile("" ::: "memory");
#pragma unroll
        for (int b = 0; b < 8; ++b) { float a = 0.f;
#pragma unroll
            for (int i = 0; i < 32; ++i) a += sht[(b * 2 + (lane >> 5)) * 32 + i] * v[i];
            cbacc[b] += a; asm volatile("" ::: "memory"); }
    }
    if (ks) {
#pragma unroll
        for (int i = 0; i < 32; ++i) v[i] *= ks[k0 + 2 * i + (lane >> 5)]; }
#pragma unroll
    for (int i = 0; i < 32; ++i) scr[(2 * i + (lane >> 5)) * 33 + (lane & 31)] = v[i];
    LDS_WAIT(); asm volatile("" ::: "memory");
    const int c = lane & 7;
#pragma unroll
    for (int j = 0; j < 4; ++j) { const int n = (lane >> 3) + 8 * j; const LAS float* s = scr + (8 * c) * 33 + n;
        v4u o; o.x = pk2(s[0 * 33], s[1 * 33]); o.y = pk2(s[2 * 33], s[3 * 33]); o.z = pk2(s[4 * 33], s[5 * 33]); o.w = pk2(s[6 * 33], s[7 * 33]);
        const int rr = dst_row0 + n;
        if constexpr (F8) { unsigned w0 = 0, w1 = 0;
            w0 = __builtin_amdgcn_cvt_pk_fp8_f32(pg8::sat8(s[0 * 33] * 64.f), pg8::sat8(s[1 * 33] * 64.f), w0, false); w0 = __builtin_amdgcn_cvt_pk_fp8_f32(pg8::sat8(s[2 * 33] * 64.f), pg8::sat8(s[3 * 33] * 64.f), w0, true);
            w1 = __builtin_amdgcn_cvt_pk_fp8_f32(pg8::sat8(s[4 * 33] * 64.f), pg8::sat8(s[5 * 33] * 64.f), w1, false); w1 = __builtin_amdgcn_cvt_pk_fp8_f32(pg8::sat8(s[6 * 33] * 64.f), pg8::sat8(s[7 * 33] * 64.f), w1, true);
            *(GAS v2u*)((GAS unsigned char*)WT + (size_t)rr * (ldk ? ldk : K) + k0 + 8 * c) = (v2u){w0, w1}; } else {
        const size_t eo = tiled ? ((size_t)(rr >> 8) * (K >> 6) + (k0 >> 6)) * 16384 + (size_t)(rr & 255) * 64 + 8 * c : (size_t)rr * (ldk ? ldk : K) + k0 + 8 * c;
        *(GAS v4u*)(WT + eo) = o; } }
    LDS_WAIT(); asm volatile("" ::: "memory");
}
typedef float p0_f32x16 __attribute__((ext_vector_type(16)));
template <bool F8>
__device__ __forceinline__ void transpose_item_cb(const float* W, int K, int N, bf16* WT, int dst_row0, int k0, int n0, LAS unsigned* scr, int lane, const float* shp, p0_f32x16& acc, float isw = 0.f) {
    const int h = lane >> 5, n = lane & 31;
    float v[32];
    const GAS float* wp = (const GAS float*)W + (size_t)(k0 + 32 * h) * N + n0 + n;
#pragma unroll
    for (int i = 0; i < 32; ++i) { v[i] = *wp; wp += (size_t)N; asm volatile("" : "+v"(wp)); }
    const GAS float* sp = (const GAS float*)shp + (size_t)(n & 7) * MODW + k0 + 32 * h;
    f32x4 sa[8];
#pragma unroll
    for (int j = 0; j < 8; ++j) sa[j] = *(const GAS f32x4*)(sp + 4 * j);
    const float msk = n < 8 ? 1.0f : 0.0f;
    unsigned w[16];
#pragma unroll
    for (int t = 0; t < 16; ++t) w[t] = pg8::cvt_pk_bf16(v[2 * t], v[2 * t + 1]);
#pragma unroll
    for (int j = 0; j < 4; ++j) { const f32x4 s0 = sa[2 * j] * msk, s1 = sa[2 * j + 1] * msk;
        v4u a; a.x = pg8::cvt_pk_bf16(s0[0], s0[1]); a.y = pg8::cvt_pk_bf16(s0[2], s0[3]); a.z = pg8::cvt_pk_bf16(s1[0], s1[1]); a.w = pg8::cvt_pk_bf16(s1[2], s1[3]);
        v4u b; b.x = w[4 * j]; b.y = w[4 * j + 1]; b.z = w[4 * j + 2]; b.w = w[4 * j + 3];
        acc = __builtin_amdgcn_mfma_f32_32x32x16_bf16(__builtin_bit_cast(bf16x8, a), __builtin_bit_cast(bf16x8, b), acc, 0, 0, 0); }
    if constexpr (F8) {
#pragma unroll
        for (int t = 0; t < 8; ++t) scr[(8 * h + t) * 33 + n] = pg8::pk4_i8(v[4 * t] * isw, v[4 * t + 1] * isw, v[4 * t + 2] * isw, v[4 * t + 3] * isw);
        LDS_WAIT(); asm volatile("" ::: "memory");
        const int c = lane & 3;
#pragma unroll
        for (int jj = 0; jj < 2; ++jj) { const int nn = (lane >> 2) + 16 * jj; const LAS unsigned* s = scr + (4 * c) * 33 + nn;
            v4u o; o.x = s[0]; o.y = s[33]; o.z = s[66]; o.w = s[99];
            *(GAS v4u*)((GAS unsigned char*)WT + (size_t)(dst_row0 + nn) * K + k0 + 16 * c) = o; }
    } else {
#pragma unroll
        for (int t = 0; t < 16; ++t) scr[(16 * h + t) * 33 + n] = w[t];
        LDS_WAIT(); asm volatile("" ::: "memory");
        const int c = lane & 7;
#pragma unroll
        for (int jj = 0; jj < 4; ++jj) { const int nn = (lane >> 3) + 8 * jj; const LAS unsigned* s = scr + (4 * c) * 33 + nn;
            v4u o; o.x = s[0]; o.y = s[33]; o.z = s[66]; o.w = s[99];
            *(GAS v4u*)(WT + (size_t)(dst_row0 + nn) * K + k0 + 8 * c) = o; }
    }
    LDS_WAIT(); asm volatile("" ::: "memory");
}
#ifndef W2_TILED
#define W2_TILED false
#endif
constexpr int TI_W13 = (D / 64) * (2 * DFF / 32), TI_W2 = (DFF / 64) * (D / 32), TI_WIN = (D / 64) * (INW / 32), TI_LRUO = (LW / 64) * (D / 32), TI_UKV = (KVR / 64) * (4096 / 32), TI_DD = (D / 64) * (D / 32), TI_WAX = 8 * 2 * 4;
constexpr int TH_W13 = TI_W13 / 4, TH_WIN = TI_WIN / 4, TH_LAYER = 2 * TH_W13 + TH_WIN;
constexpr int TL_LAYER = 2 * TI_W2 + 2 * TI_LRUO + TI_UKV + 2 * TI_DD + 2 * TI_WAX, TU_LAYER = TH_LAYER + TL_LAYER;
__device__ __forceinline__ void p0_weights(const Frame& F, int parts, bool dummy_cb = false) {
    LAS float* scr = (LAS float*)(F.lds + RING_OFF + F.wave * 16384);
    const int gw = F.vcu * NWAVES + F.wave, NGW = F.G * NWAVES;
    if (parts & 1)
    for (int it = gw; it < NL * TH_LAYER; it += NGW) {
        const int l = it / TH_LAYER; int r = it - l * TH_LAYER;
        GAS unsigned char* wl = F.ws + WS_W + (size_t)l * W_LAYER;
        const float* W; bf16* WT; int N, mode, site;
        if (r < 2 * TH_W13) { const int f = r / TH_W13; r -= f * TH_W13; W = in_ptr(I_W13) + (size_t)(l * 2 + f) * D * 2 * DFF; N = 2 * DFF; WT = (bf16*)(wl + WO_W13 + (size_t)f * 44 * MiB); mode = 1; site = f ? 2 : 0; }
        else { r -= 2 * TH_W13; W = in_ptr(I_WIN) + (size_t)l * D * INW; N = INW; WT = (bf16*)(wl + WO_WIN); mode = 2; site = 1; }
        bool f8 = (mode == 1) && ((site == 2 && ((FP8_G4 >> l) & 1)) || (site == 0 && ((FP8_G1 >> l) & 1))); int cbi;
        const int nblk = N / 32, kq = r / nblk, nb = r - kq * nblk, n0 = 32 * nb; int dst = n0;
        if (mode == 1) { const int bj = n0 >= DFF ? 1 : 0, j = n0 - bj * DFF; dst = 256 * (j >> 7) + 128 * bj + (j & 127); }
        else {
            if (FP8_ALL) { dst = n0 < 8704 ? n0 : (n0 < 8768 ? 14848 + (n0 - 8704) : 8704 + (n0 - 8768)); f8 = true; }
            else if (WIN_QF8) { if (n0 < 5120) dst = n0; else if (n0 < 8192) { dst = n0 - 5120; f8 = true; } else if (n0 < 8704) dst = 5120 + (n0 - 8192); else if (n0 < 8768) dst = 5632 + (n0 - 8704); else if (G1_BF16 && n0 >= 8768 + 2048 && n0 < 8768 + 4096) dst = WINB_PADEND + (n0 - 8768 - 2048); else if (G1_BF16 && n0 >= 8768 + 4096) { dst = 5120 + (n0 - 8768 - 4096); f8 = true; } else { dst = 3072 + (n0 - 8768); f8 = true; } }
            else { if (n0 < 8768) dst = n0; else { dst = n0 - 8768; f8 = true; } }
            if (f8) WT = (bf16*)(wl + WO_WIN8); }
        cbi = (mode == 2 && f8) ? WINB_ROWS + dst : dst;
        const float* shp = (const float*)(F.ws + WS_MOD) + (size_t)l * NB * MODW + (site == 0 ? 0 : site == 1 ? 6144 : 12288);
        p0_f32x16 cbacc;
#pragma unroll
        for (int r4 = 0; r4 < 16; ++r4) cbacc[r4] = 0.f;
        if (f8) {
#pragma unroll 1
            for (int j = 0; j < 4; ++j) transpose_item_cb<true>(W, D, N, WT, dst, 64 * (4 * kq + j), n0, (LAS unsigned*)scr, F.lane, shp, cbacc, ((const GAS float*)(F.ws + WS_WSC))[(l * 2 + (mode == 1 ? 1 : 0)) * 2 + 1]);
        } else {
#pragma unroll 1
            for (int j = 0; j < 4; ++j) transpose_item_cb<false>(W, D, N, WT, dst, 64 * (4 * kq + j), n0, (LAS unsigned*)scr, F.lane, shp, cbacc); }
        int* cbp = (int*)(F.ws + (dummy_cb ? WS_KN : WS_CB)) + (size_t)((l * 3 + site) * NB + 4 * (F.lane >> 5)) * CBW + cbi + (F.lane & 31);
#pragma unroll
        for (int r4 = 0; r4 < 4; ++r4) atomicAdd(cbp + (size_t)r4 * CBW, (int)__builtin_rintf(cbacc[r4] * pg8::CB_ENC));
    }
    if (parts & 2)
    for (int it = gw; it < NL * TL_LAYER; it += NGW) {
        const int l = it / TL_LAYER; int r = it - l * TL_LAYER;
        GAS unsigned char* wl = F.ws + WS_W + (size_t)l * W_LAYER;
        const float* W; bf16* WT; const float* ks = nullptr; int K, N, ldk = 0; float dummy[8]; bool tiled = false;
        bool f8w = false;
        if (r < 2 * TI_W2) { tiled = W2_TILED; const int f = r / TI_W2; r -= f * TI_W2; W = in_ptr(I_W2) + (size_t)(l * 2 + f) * DFF * D; K = DFF; N = D; WT = (bf16*)(wl + WO_W2 + (size_t)f * 22 * MiB); f8w = ((FP8_DN >> (2 * l + f)) & 1) != 0; }
        else if ((r -= 2 * TI_W2) < TI_LRUO) { W = in_ptr(I_LOUT) + (size_t)l * LW * D; K = LW; N = D; WT = (bf16*)(wl + WO_LRUO); ldk = YP; }
        else if ((r -= TI_LRUO) < TI_LRUO) { W = in_ptr(I_SCOUT) + (size_t)l * LW * D; K = LW; N = D; WT = (bf16*)(wl + WO_SCO); ldk = YP; }
        else if ((r -= TI_LRUO) < TI_UKV) { W = in_ptr(I_UKV) + (size_t)l * KVR * 4096; K = KVR; N = 4096; WT = (bf16*)(wl + WO_UKV); ks = in_ptr(I_KVG) + l * KVR; }
        else if ((r -= TI_UKV) < TI_DD) { W = in_ptr(I_MLAO) + (size_t)l * D * D; K = D; N = D; WT = (bf16*)(wl + WO_MLAO); ldk = YP; }
        else if ((r -= TI_DD) < TI_DD) { W = in_ptr(I_WO) + (size_t)l * D * D; K = D; N = D; WT = (bf16*)(wl + WO_WO); }
        else { r -= TI_DD; const int which = r / TI_WAX; r -= which * TI_WAX; const int g = r >> 3; r &= 7;
               W = in_ptr(which ? I_LWX : I_LWA) + ((size_t)l * 8 + g) * 16384; K = 128; N = 128; WT = (bf16*)(F.ws + WS_WAX) + ((size_t)(l * 2 + which) * 8 + g) * 16384; }
        const int nblk = N / 32, kb = r / nblk, nb = r - kb * nblk, n0 = 32 * nb;
        if (FP8_DN != 0 && f8w) transpose_item<false, true>(W, K, N, WT, n0, 64 * kb, n0, nullptr, scr, F.lane, nullptr, dummy);
        else transpose_item<false>(W, K, N, WT, n0, 64 * kb, n0, ks, scr, F.lane, nullptr, dummy, tiled, ldk);
    }
    if (parts & 2) { const int gt = (F.vcu * NWAVES + F.wave) * 64 + F.lane, NT = F.G * NWAVES * 64; constexpr int per = FP8_ALL ? 192 * D / 16 : (WINB_PADEND - WINB_REAL) * D * 2 / 16; constexpr size_t pbase = FP8_ALL ? WO_WIN8 + (size_t)14912 * D : WO_WIN + (size_t)WINB_REAL * D * 2;
      for (int i = gt; i < NL * per; i += NT) { const int l = i / per, j = i - l * per; *(GAS v4u*)(F.ws + WS_W + (size_t)l * W_LAYER + pbase + (size_t)j * 16) = (v4u){0u, 0u, 0u, 0u}; } }
    if (parts & 2) { const int gt = (F.vcu * NWAVES + F.wave) * 64 + F.lane, NT = F.G * NWAVES * 64; const int* pos = (const int*)in_ptr(I_POS); float* COS = (float*)(F.ws + WS_COS); float* SIN = (float*)(F.ws + WS_SIN);
      for (int i = gt; i < M * 32; i += NT) { const int row = i >> 5, j = i & 31; const float inv = __builtin_amdgcn_exp2f(-(float)j * (13.287712379549449f / 32.0f)); const float ang = (float)pos[row] * inv;
          const double t = (double)ang * 0.15915494309189535; const float fr = (float)(t - __builtin_rint(t)); COS[i] = __builtin_amdgcn_cosf(fr); SIN[i] = __builtin_amdgcn_sinf(fr); } }
}
__device__ __forceinline__ void p0_wscale(const Frame& F) {
    if ((int)blockIdx.x < NL * 2 && F.wave == 0) { const int l = (int)blockIdx.x >> 1, which = (int)blockIdx.x & 1;
        const float* W = which ? in_ptr(I_W13) + (size_t)(l * 2 + 1) * D * 2 * DFF : in_ptr(I_WIN) + (size_t)l * D * INW;
        float s = 0.f;
#pragma unroll 8
        for (int i = 0; i < 64; ++i) { const float w = W[i * 64 + F.lane]; s += w * w; }
        s = wave_sum(s);
        if (F.lane == 0) { const float sw = 4.0f * sqrtf(s * (1.0f / 4096.0f) + 1e-30f) * (1.0f / 127.0f); GAS float* o = (GAS float*)(F.ws + WS_WSC) + ((size_t)l * 2 + which) * 2; o[0] = sw; o[1] = 1.0f / sw; } }
}
__device__ __forceinline__ void p0_mod(const Frame& F) {
    LAS float* sc = (LAS float*)(F.lds + RING_OFF); LAS float* red = (LAS float*)(F.lds + RING_OFF + 65536);
    for (int i = F.tid; i < NB * D; i += NWAVES * 64) { const float c = in_ptr(I_C)[i]; sc[i] = c / (1.0f + __expf(-c)); }
    __syncthreads();
    float* MOD = (float*)(F.ws + WS_MOD);
    for (int task = blockIdx.x; task < NL * (MODW / 64); task += F.G) {
        const int l = task / (MODW / 64), cg = task - l * (MODW / 64);
        const float* Wp = in_ptr(I_ADAW) + ((size_t)l * D + 256 * F.wave) * MODW + 64 * cg + F.lane;
        float acc[8];
#pragma unroll
        for (int b = 0; b < 8; ++b) acc[b] = 0.f;
#pragma unroll 4
        for (int k4 = 0; k4 < 256; k4 += 4) {
            const float w0 = Wp[(size_t)(k4 + 0) * MODW], w1 = Wp[(size_t)(k4 + 1) * MODW], w2 = Wp[(size_t)(k4 + 2) * MODW], w3 = Wp[(size_t)(k4 + 3) * MODW];
#pragma unroll
            for (int b = 0; b < 8; ++b) { const f32x4 s4 = *(const LAS f32x4*)(sc + b * D + 256 * F.wave + k4); acc[b] += (s4[0] * w0 + s4[1] * w1) + (s4[2] * w2 + s4[3] * w3); }
        }
#pragma unroll
        for (int b = 0; b < 8; ++b) red[(F.wave * 8 + b) * 64 + F.lane] = acc[b];
        __syncthreads();
        { const int b = F.wave; float s = 0.f;
#pragma unroll
          for (int w = 0; w < 8; ++w) s += red[(w * 8 + b) * 64 + F.lane];
          MOD[((size_t)l * NB + b) * MODW + 64 * cg + F.lane] = s + in_ptr(I_ADAB)[(size_t)l * MODW + 64 * cg + F.lane]; }
        __syncthreads();
    }
}
__device__ __forceinline__ unsigned pk2h(float lo, float hi) { return pg8::pk2_f16(lo, hi); }
__device__ __forceinline__ void operand0_phase(const Frame& F, const float* xin, const float* g, const float* scale, bf16* out, pg8::ssq_t* ssq, bf16* xh, unsigned char* a8) {
    const int gw = F.vcu * NWAVES + F.wave, NGW = F.G * NWAVES, rpw = (M + NGW - 1) / NGW;
    const int r0 = gw * rpw, r1 = (r0 + rpw < M) ? r0 + rpw : M;
    int curb = -1; f32x4 gp[8];
    for (int row = r0; row < r1; ++row) {
        const int b = row >> 11;
        if (b != curb) { curb = b;
#pragma unroll
            for (int j = 0; j < 8; ++j) { const f32x4 g4 = ((const f32x4*)g)[F.lane + 64 * j]; const f32x4 s4 = ((const f32x4*)(scale + (size_t)b * MODW))[F.lane + 64 * j]; gp[j] = g4 * (s4 + 1.0f); } }
        const f32x4* xr = (const f32x4*)(xin + (size_t)row * D) + F.lane;
        f32x4 v[8]; float ss = 0.f;
#pragma unroll
        for (int j = 0; j < 8; ++j) { v[j] = xr[64 * j]; ss += (v[j][0] * v[j][0] + v[j][1] * v[j][1]) + (v[j][2] * v[j][2] + v[j][3] * v[j][3]); }
        ss = wave_sum(ss); if (F.lane == 0) ssq[row] = pg8::ssq_enc(ss);
        const float qs = pg8::a8_inv(pg8::ssq_enc(ss));
        unsigned long long* o8 = (unsigned long long*)(out + (size_t)row * D) + F.lane; unsigned long long* h8 = (unsigned long long*)(xh + (size_t)row * D) + F.lane;
#pragma unroll
        for (int j = 0; j < 8; ++j) { const f32x4 o = v[j] * gp[j]; o8[64 * j] = (unsigned long long)pk2(o[0], o[1]) | ((unsigned long long)pk2(o[2], o[3]) << 32);
            h8[64 * j] = (unsigned long long)pk2h(v[j][0], v[j][1]) | ((unsigned long long)pk2h(v[j][2], v[j][3]) << 32);
            if (a8) ((GAS unsigned*)(a8 + (size_t)row * D))[F.lane + 64 * j] = pg8::pk4_i8(o[0] * qs, o[1] * qs, o[2] * qs, o[3] * qs); }
    }
}
__device__ __forceinline__ void final_norm_phase(const Frame& F, const bf16* xh, float* out, const float* g) {
    const int gw = F.vcu * NWAVES + F.wave, NGW = F.G * NWAVES;
    f32x4 g4[8];
#pragma unroll
    for (int j = 0; j < 8; ++j) g4[j] = ((const f32x4*)g)[F.lane + 64 * j];
    for (int row = gw; row < M; row += NGW) {
        const unsigned long long* xr = (const unsigned long long*)(xh + (size_t)row * D) + F.lane; f32x4* orow = (f32x4*)(out + (size_t)row * D) + F.lane;
        f32x4 v[8]; float ss = 0.f;
#pragma unroll
        for (int j = 0; j < 8; ++j) { const unsigned long long hv = xr[64 * j]; const unsigned w0 = (unsigned)hv, w1 = (unsigned)(hv >> 32); v[j] = (f32x4){pg8::h_lo(w0), pg8::h_hi(w0), pg8::h_lo(w1), pg8::h_hi(w1)};
            ss += (v[j][0] * v[j][0] + v[j][1] * v[j][1]) + (v[j][2] * v[j][2] + v[j][3] * v[j][3]); }
        const float rinv = 1.0f / sqrtf(wave_sum(ss) * (1.0f / D) + EPS);
#pragma unroll
        for (int j = 0; j < 8; ++j) orow[64 * j] = v[j] * rinv * g4[j];
    }
}
__device__ __forceinline__ float softplus_f(float z) {
    const float zn = z > 0.f ? -z : z; const float x = __expf(zn); const float u = 1.0f + x; const float l1p = (u == 1.0f) ? x : __logf(u) * (x / (u - 1.0f));
    return (z > 0.f ? z : 0.f) + l1p; }
__device__ __forceinline__ void lru_unit(const Frame& F, int l, int gck, int g) {
    LAS unsigned char* xr = F.lds + RING_OFF;
    const bf16* X = (const bf16*)(F.ws + WS_LRUX);
    const size_t row0 = (size_t)gck * 128; const int ck = gck & 15;
    {
        const int c8 = F.tid & 15, tq = F.tid >> 4, ch0 = 128 * g + 8 * c8;
        float w[4][8], bias[8];
#pragma unroll
        for (int k = 0; k < 4; ++k) { const f32x4 a = *(const f32x4*)(in_ptr(I_LCW) + ((size_t)l * 4 + k) * LW + ch0), b = *(const f32x4*)(in_ptr(I_LCW) + ((size_t)l * 4 + k) * LW + ch0 + 4);
            w[k][0] = a[0]; w[k][1] = a[1]; w[k][2] = a[2]; w[k][3] = a[3]; w[k][4] = b[0]; w[k][5] = b[1]; w[k][6] = b[2]; w[k][7] = b[3]; }
        { const f32x4 a = *(const f32x4*)(in_ptr(I_LCB) + (size_t)l * LW + ch0), b = *(const f32x4*)(in_ptr(I_LCB) + (size_t)l * LW + ch0 + 4);
          bias[0] = a[0]; bias[1] = a[1]; bias[2] = a[2]; bias[3] = a[3]; bias[4] = b[0]; bias[5] = b[1]; bias[6] = b[2]; bias[7] = b[3]; }
        float xin[7][8];
#pragma unroll
        for (int i = 0; i < 7; ++i) { const int trow = 4 * tq + i - 3;
            if (128 * ck + trow >= 0) { const v4u raw = *(const GAS v4u*)(X + (size_t)((long)row0 + trow) * LW + ch0); unpack8(raw, xin[i]); }
            else {
#pragma unroll
                for (int e = 0; e < 8; ++e) xin[i][e] = 0.f; } }
#pragma unroll
        for (int j = 0; j < 4; ++j) { float o[8];
#pragma unroll
            for (int e = 0; e < 8; ++e) o[e] = bias[e] + (w[0][e] * xin[j][e] + w[1][e] * xin[j + 1][e]) + (w[2][e] * xin[j + 2][e] + w[3][e] * xin[j + 3][e]);
            *(LAS v4u*)(xr + (4 * tq + j) * 272 + 16 * c8) = pack8(o); }
    }
    __syncthreads();
    const int fr = F.lane & 15, fq = F.lane >> 4, ch = 16 * F.wave + fr, cg = 128 * g + ch;
    bf16x8 bwa[4], bwx[4];
    { const bf16* WA = (const bf16*)(F.ws + WS_WAX) + ((size_t)(l * 2 + 0) * 8 + g) * 16384 + (size_t)ch * 128 + 8 * fq;
      const bf16* WX = (const bf16*)(F.ws + WS_WAX) + ((size_t)(l * 2 + 1) * 8 + g) * 16384 + (size_t)ch * 128 + 8 * fq;
#pragma unroll
      for (int ks = 0; ks < 4; ++ks) { bwa[ks] = *(const bf16x8*)(WA + 32 * ks); bwx[ks] = *(const bf16x8*)(WX + 32 * ks); } }
    f32x4 accr[8], acci[8];
#pragma unroll
    for (int mt = 0; mt < 8; ++mt) { accr[mt] = (f32x4){0.f, 0.f, 0.f, 0.f}; acci[mt] = (f32x4){0.f, 0.f, 0.f, 0.f};
#pragma unroll
        for (int ks = 0; ks < 4; ++ks) { const bf16x8 a = *(const LAS bf16x8*)(xr + (16 * mt + fr) * 272 + (32 * ks + 8 * fq) * 2);
            accr[mt] = __builtin_amdgcn_mfma_f32_16x16x32_bf16(a, bwa[ks], accr[mt], 0, 0, 0);
            acci[mt] = __builtin_amdgcn_mfma_f32_16x16x32_bf16(a, bwx[ks], acci[mt], 0, 0, 0); } }
    const float ba = in_ptr(I_LBA)[(size_t)l * LW + cg], bx = in_ptr(I_LBX)[(size_t)l * LW + cg];
    const float Lc2 = -8.0f * 1.4426950408889634f * softplus_f(-in_ptr(I_LAM)[(size_t)l * LW + cg]);
    bf16* R = (bf16*)(F.ws + WS_R); bf16* GX = (bf16*)(F.ws + WS_GX);
    float At = 1.f, Bt = 0.f;
#pragma unroll
    for (int mt = 0; mt < 8; ++mt) { float A4 = 1.f, B4 = 0.f;
#pragma unroll
        for (int e = 0; e < 4; ++e) { const int tl = 16 * mt + 4 * fq + e;
            const float r = pg8::fast_sigmoid(accr[mt][e] + ba), ii = pg8::fast_sigmoid(acci[mt][e] + bx);
            const float xv = bf2f(*(const LAS unsigned short*)(xr + tl * 272 + ch * 2));
            const unsigned short rb = (unsigned short)f2bf(r), gb = (unsigned short)f2bf(ii * xv);
            R[(row0 + tl) * LW + cg] = rb; GX[(row0 + tl) * LW + cg] = gb;
            const float a = __builtin_amdgcn_exp2f(Lc2 * bf2f(rb)); const float bb = sqrtf(fmaxf(1.0f - a * a, 0.f)) * bf2f(gb);
            A4 = a * A4; B4 = a * B4 + bb; }
#pragma unroll
        for (int q = 0; q < 4; ++q) { const float Aq = __shfl(A4, fr + 16 * q), Bq = __shfl(B4, fr + 16 * q); Bt = Aq * Bt + Bq; At = Aq * At; } }
    if (fq == 0) { float* AGG = (float*)(F.ws + WS_AGG) + ((size_t)gck * LW + cg) * 2; AGG[0] = At; AGG[1] = Bt; }
    __syncthreads();
}
__device__ __forceinline__ void lru_scan_unit(const Frame& F, int l, int gck, int hf) {
    const int c = 512 * hf + F.tid, b = gck >> 4, ck = gck & 15;
    const float* AGG = (const float*)(F.ws + WS_AGG);
    float h = 0.f;
    for (int j = 0; j < ck; ++j) { const float2 ab = *(const float2*)(AGG + ((size_t)(b * 16 + j) * LW + c) * 2); h = ab.x * h + ab.y; }
    const float Lc2 = -8.0f * 1.4426950408889634f * softplus_f(-in_ptr(I_LAM)[(size_t)l * LW + c]);
    const bf16* R = (const bf16*)(F.ws + WS_R) + (size_t)gck * 128 * LW + c; const bf16* GX = (const bf16*)(F.ws + WS_GX) + (size_t)gck * 128 * LW + c;
    const bf16* GT = (const bf16*)(F.ws + WS_LRUG) + (size_t)gck * 128 * LW + c; bf16* Y = (bf16*)(F.ws + WS_YLRU) + (size_t)gck * 128 * YP + c;
    for (int t0 = 0; t0 < 128; t0 += 8) { unsigned short rr[8], gg[8], tt[8];
#pragma unroll
        for (int i = 0; i < 8; ++i) { rr[i] = R[(size_t)(t0 + i) * LW]; gg[i] = GX[(size_t)(t0 + i) * LW]; tt[i] = GT[(size_t)(t0 + i) * LW]; }
#pragma unroll
        for (int i = 0; i < 8; ++i) { const float a = __builtin_amdgcn_exp2f(Lc2 * bf2f(rr[i])); const float bb = sqrtf(fmaxf(1.0f - a * a, 0.f)) * bf2f(gg[i]); h = a * h + bb;
            Y[(size_t)(t0 + i) * YP] = (unsigned short)f2bf(h * bf2f(tt[i])); } }
}
__device__ __forceinline__ void sc_phase(const Frame& F, int l) {
    const int gt = (F.vcu * NWAVES + F.wave) * 64 + F.lane, NT = F.G * NWAVES * 64;
    const bf16* SB = (const bf16*)(F.ws + WS_SCB); const bf16* SC = (const bf16*)(F.ws + WS_SCC); const bf16* SX = (const bf16*)(F.ws + WS_SCX); bf16* Y = (bf16*)(F.ws + WS_YSC);
    for (int idx = gt; idx < (M / 8) * (LW / 8); idx += NT) {
        const int c8 = idx & 127, tg = idx >> 7, row0 = 8 * tg, s0 = row0 & (SEQ - 1), ch0 = 8 * c8;
        float w[3][8];
#pragma unroll
        for (int k = 0; k < 3; ++k) { const f32x4 a = *(const f32x4*)(in_ptr(I_SCW) + ((size_t)l * 3 + k) * LW + ch0), b = *(const f32x4*)(in_ptr(I_SCW) + ((size_t)l * 3 + k) * LW + ch0 + 4);
            w[k][0] = a[0]; w[k][1] = a[1]; w[k][2] = a[2]; w[k][3] = a[3]; w[k][4] = b[0]; w[k][5] = b[1]; w[k][6] = b[2]; w[k][7] = b[3]; }
        float cx[10][8];
#pragma unroll
        for (int i = 0; i < 10; ++i) {
            if (s0 + i - 2 >= 0) { float a[8], b[8]; unpack8(*(const GAS v4u*)(SC + (size_t)(row0 + i - 2) * LW + ch0), a); unpack8(*(const GAS v4u*)(SX + (size_t)(row0 + i - 2) * LW + ch0), b);
#pragma unroll
                for (int e = 0; e < 8; ++e) cx[i][e] = a[e] * b[e]; }
            else {
#pragma unroll
                for (int e = 0; e < 8; ++e) cx[i][e] = 0.f; } }
#pragma unroll
        for (int j = 0; j < 8; ++j) { float bb[8], o[8]; unpack8(*(const GAS v4u*)(SB + (size_t)(row0 + j) * LW + ch0), bb);
#pragma unroll
            for (int e = 0; e < 8; ++e) o[e] = bb[e] * ((w[0][e] * cx[j][e] + w[1][e] * cx[j + 1][e]) + w[2][e] * cx[j + 2][e]);
            *(GAS v4u*)(Y + (size_t)(row0 + j) * YP + ch0) = pack8(o); }
    }
}
__device__ __forceinline__ void rope8(bf16* p, const float* cs, const float* sn) {
    float x1[8], x2[8], o1[8], o2[8]; unpack8(*(const GAS v4u*)p, x1); unpack8(*(const GAS v4u*)(p + 32), x2);
    const f32x4 c0 = *(const f32x4*)cs, c1 = *(const f32x4*)(cs + 4), s0 = *(const f32x4*)sn, s1 = *(const f32x4*)(sn + 4);
#pragma unroll
    for (int e = 0; e < 8; ++e) { const float c = e < 4 ? c0[e & 3] : c1[e & 3], s = e < 4 ? s0[e & 3] : s1[e & 3]; o1[e] = x1[e] * c - x2[e] * s; o2[e] = x2[e] * c + x1[e] * s; }
    *(GAS v4u*)p = pack8(o1); *(GAS v4u*)(p + 32) = pack8(o2);
}
__device__ __forceinline__ void rope_phase(const Frame& F) {
    const int gt = (F.vcu * NWAVES + F.wave) * 64 + F.lane, NT = F.G * NWAVES * 64;
    const float* COS = (const float*)(F.ws + WS_COS); const float* SIN = (const float*)(F.ws + WS_SIN);
    bf16* Q = (bf16*)(F.ws + WS_Q); bf16* KP = (bf16*)(F.ws + WS_KPE);
    for (int idx = gt; idx < M * 16 * 4; idx += NT) { const int row = idx >> 6, hh = (idx >> 2) & 15, j = idx & 3;
        rope8(Q + (size_t)row * 3072 + hh * 192 + 128 + 8 * j, COS + (size_t)row * 32 + 8 * j, SIN + (size_t)row * 32 + 8 * j); }
    for (int idx = gt; idx < M * 4; idx += NT) { const int row = idx >> 2, j = idx & 3;
        rope8(KP + (size_t)row * 64 + 8 * j, COS + (size_t)row * 32 + 8 * j, SIN + (size_t)row * 32 + 8 * j); }
}
struct Args { const float* in[24]; float* out; unsigned char* ws; int ph_lo, ph_hi; };
#ifndef P0P
#define P0P 3
#endif
#ifndef REP_G2
#define REP_G2 1
#endif
#ifndef REP_G5
#define REP_G5 1
#endif
#ifndef REP_PRO
#define REP_PRO 1
#endif
#ifndef REVK_FFN
#define REVK_FFN false
#endif
#ifndef ACT_TILED
#define ACT_TILED false
#endif
#ifndef G3P
#define G3P 3
#endif
#ifndef REP_ATT
#define REP_ATT 1
#endif
#ifndef REP_BAR
#define REP_BAR 1
#endif
#ifndef PH_MASK
#define PH_MASK 0xFFFFu
#endif
#define EN(j) (((PH_MASK) >> (j)) & 1u)
__global__ void __launch_bounds__(NWAVES * 64, 2) hybrid_fwd(Args args) {
    extern __shared__ __attribute__((aligned(16))) unsigned char lds[];
    Frame F;
    F.lds = (LAS unsigned char*)lds;
    F.MISC = (volatile LAS unsigned*)(F.lds + MISC_OFF);
    F.tid = threadIdx.x; F.lane = F.tid & 63; F.wave = __builtin_amdgcn_readfirstlane(F.tid >> 6);
    F.G = gridDim.x; { const int bx = blockIdx.x; F.vcu = (F.G % 8 == 0) ? (bx % 8) * (F.G / 8) + bx / 8 : bx; }
    F.out = nullptr; F.ws = nullptr; F.ctl = (gu32*)(args.ws + WS_CTL);
    for (int u = F.tid; u < (LDS_BYTES - LDSCTL_OFF) / 4; u += NWAVES * 64) ((LAS unsigned*)(F.lds + LDSCTL_OFF))[u] = 0u;
    __syncthreads();
    XcdBarrier bar; bar.bar = (unsigned*)(F.ctl + CW_BAR); bar.x = 0; bar.st = nullptr;
    if (MK_N_LAUNCHES == 1) bar = xcd_barrier_post((unsigned*)(F.ctl + CW_BAR), F.MISC + 8);
    const int lo = args.ph_lo, hi = args.ph_hi;
#define IN(k) (lo <= (k) && (k) < hi)
#define PHASE_FRAME() Frame P = F; { unsigned m1_ = ~0u; asm volatile("" : "+s"(m1_)); int t_ = F.wave * 64 + (int)__builtin_amdgcn_mbcnt_hi(m1_, __builtin_amdgcn_mbcnt_lo(m1_, 0u)); asm volatile("" : "+v"(t_)); P.tid = t_; P.lane = t_ & 63; P.out = (GAS float*)karg_ptr(24); P.ws = karg_ptr(25); }
#define SEAM(k) do { if (IN(k) && IN((k) + 1)) { if (MK_N_LAUNCHES == 1) { for (int rb_ = 0; rb_ < REP_BAR; ++rb_) { XcdBarrier b_ = bar; GAS unsigned* bp_ = (GAS unsigned*)bar.bar; asm volatile("" : "+s"(bp_)); b_.bar = (unsigned*)bp_; xcd_barrier(b_); } }     } } while (0)
#define HN ((bf16*)(P.ws + WS_HN))
#define XH ((bf16*)(P.ws + WS_XH))
#define A8 ((unsigned char*)(P.ws + WS_A8))
#define ACT ((bf16*)(P.ws + WS_ACT))
#define MERGED ((bf16*)(P.ws + WS_MERGED))
#define ring (F.lds + RING_OFF)
#define MODL(l_) ((const float*)(P.ws + WS_MOD) + (size_t)(l_) * NB * MODW)
#define NORMG(l_, s_) (in_ptr(I_NORMG) + ((size_t)(l_) * 3 + (s_)) * D)
#define SSQN(l_, s_) ((pg8::ssq_t*)(P.ws + WS_SSQN) + ((size_t)(l_) * 3 + (s_)) * M)
#define WSCP(l_, w_) ((const float*)(P.ws + WS_WSC) + ((size_t)(l_) * 2 + (w_)) * 2)
#define CBV(l_, s_) ((const int*)(P.ws + WS_CB) + ((size_t)(l_) * 3 + (s_)) * NB * CBW)

    if (EN(12) && IN(0)) { PHASE_FRAME(); p0_wscale(P); p0_mod(P); p0_weights(P, 2);
        for (int i = P.vcu * (NWAVES * 64) + P.tid; i < NL * 4 * M; i += P.G * (NWAVES * 64)) ((GAS pg8::ssq_t*)(P.ws + WS_SSQN))[i] = 0ull;
        SEAM(0); }
    if (EN(13) && IN(1)) { PHASE_FRAME(); if (P0P & 1) for (int rep_ = 0; rep_ < REP_PRO; ++rep_) { p0_weights(P, 1, rep_ + 1 < REP_PRO); __syncthreads(); } if (P0P & 2) operand0_phase(P, in_ptr(I_X), NORMG(0, 0), MODL(0) + 2048, HN, SSQN(0, 0), XH, (FP8_G1 & 1) ? A8 : nullptr); SEAM(1); }

    for (int l = 0; l < NL; ++l) {
        const int pb = 2 + PPL * l;
#define wl (P.ws + WS_W + (size_t)l * W_LAYER)
#define mod MODL(l)
#define xin0 ((l == 0) ? in_ptr(I_X) : (const float*)P.out)
#define ssq ((pg8::ssq_t*)(P.ws + WS_SSQ) + (size_t)l * M)
#define UP_CALL(F8IN, O8, Wp, SITE, SSQP) do { pg8::Gemm g{(F8IN) ? (const bf16*)A8 : (const bf16*)HN, (const bf16*)(Wp), M, 2 * DFF, (F8IN) ? D / 2 : D}; \
            pg8::EpiSwiglu<ACT_TILED, (O8), (F8IN)> E{ACT, DFF, SSQN(l, SITE), CBV(l, SITE), CBW, EPS, 1.0f, (SSQP), WSCP(l, 1)};     \
            pg8::gemm_phase<pg8::EpiSwiglu<ACT_TILED, (O8), (F8IN)>, pg8::StaticOrder, true, true, false, false, false, false, (F8IN)>(ring, g, S, E, P.wave); } while (0)
        if (EN(0) && IN(pb + 0)) { PHASE_FRAME(); pg8::StaticOrder S; S.init(M, 2 * DFF, P.G, (int)blockIdx.x);
            constexpr bool o0 = fp8_dn(0, 0), o1 = fp8_dn(1, 0);
            constexpr bool i0 = (FP8_G1 & 1) != 0, i1 = (FP8_G1 & 2) != 0;
            if (l == 0) UP_CALL(i0, o0, wl + WO_W13, 0, SSQN(0, 0)); else UP_CALL(i1, o1, wl + WO_W13, 0, SSQN(0, 2));
            SEAM(pb + 0); }
#define DN_SC(F8) ((F8) ? 1.0f / (64.0f * pg8::ACT8_SC) : 1.0f)
#define G2_CALL(F8) do { pg8::Gemm g{ACT, (const bf16*)(wl + WO_W2), M, D, (F8) ? DFF / 2 : DFF}; pg8::EpiResid<true, true> E{XH, mod + 4096, HN, NORMG(l, 1), mod + 8192, SSQN(l, 1), A8, MODW, 0.5f * DN_SC(F8), SSQN(l, 0)}; \
            pg8::gemm_phase<pg8::EpiResid<true, true>, pg8::PanelOrder, true, true, false, false, false, (F8)>(ring, g, S, E, P.wave); } while (0)
        if (EN(1) && IN(pb + 1)) { PHASE_FRAME(); pg8::PanelOrder S; S.init(P.G, (int)blockIdx.x);
            constexpr bool d0 = fp8_dn(0, 0), d1 = fp8_dn(1, 0);
            if (d0 == d1) G2_CALL(d0); else if (l == 0) G2_CALL(d0); else G2_CALL(d1);
            SEAM(pb + 1); }
        if (EN(2) && IN(pb + 2)) { PHASE_FRAME();
            if (G3P & 1) {
                pg8::Gemm g{(const bf16*)A8, (const bf16*)(wl + WO_WIN8), M, WINF_ROWS, D / 2}; pg8::StaticOrder S; S.init(M, WINF_ROWS, P.G, (int)blockIdx.x);
                pg8::EpiWin<(FP8_ALL ? 2 : 1), (bool)WIN_QF8> E{(bf16*)(P.ws + WS_LRUX), (bf16*)(P.ws + WS_LRUG), (bf16*)(P.ws + WS_SCB), (bf16*)(P.ws + WS_SCC), (bf16*)(P.ws + WS_SCX), (bf16*)(P.ws + WS_Q), (bf16*)(P.ws + WS_KVLAT), (bf16*)(P.ws + WS_GATES), (bf16*)(P.ws + WS_KPE), ssq, SSQN(l, 1), CBV(l, 1), CBW, EPS, SSQN(l, 0), WSCP(l, 0)};
                pg8::gemm_phase<pg8::EpiWin<(FP8_ALL ? 2 : 1), (bool)WIN_QF8>, pg8::StaticOrder, true, true, false, false, false, false, true>(ring, g, S, E, P.wave); }
            if ((G3P & 2) && !FP8_ALL) {
                pg8::Gemm g{HN, (const bf16*)(wl + WO_WIN), M, WINB_ROWS, D}; pg8::StaticOrder S; S.init(M, WINB_ROWS, P.G, (int)blockIdx.x);
                pg8::EpiWin<0, (bool)WIN_QF8> E{(bf16*)(P.ws + WS_LRUX), (bf16*)(P.ws + WS_LRUG), (bf16*)(P.ws + WS_SCB), (bf16*)(P.ws + WS_SCC), (bf16*)(P.ws + WS_SCX), (bf16*)(P.ws + WS_Q), (bf16*)(P.ws + WS_KVLAT), (bf16*)(P.ws + WS_GATES), (bf16*)(P.ws + WS_KPE), ssq, SSQN(l, 1), CBV(l, 1), CBW, EPS, nullptr, nullptr};
                pg8::gemm_phase<pg8::EpiWin<0, (bool)WIN_QF8>, pg8::StaticOrder, true, true>(ring, g, S, E, P.wave); }
            SEAM(pb + 2); }
        if (EN(3) && IN(pb + 3)) { PHASE_FRAME();
            for (int u = P.vcu; u < 128 * 8; u += P.G) lru_unit(P, l, u >> 3, u & 7);
            sc_phase(P, l);
            rope_phase(P);
            { pg8::Gemm g{(const bf16*)(P.ws + WS_KVLAT), (const bf16*)(wl + WO_UKV), M, 4096, KVR}; pg8::StaticOrder S; S.init(M, 4096, P.G, (int)blockIdx.x);
              pg8::EpiKV E{(bf16*)(P.ws + WS_KN), (bf16*)(P.ws + WS_V), ssq, EPS}; pg8::gemm_phase<pg8::EpiKV, pg8::StaticOrder, true, true>(ring, g, S, E, P.wave); }
            SEAM(pb + 3);
        }
        if (EN(4) && IN(pb + 4)) { PHASE_FRAME();
            for (int u = P.vcu; u < 128 * 2; u += P.G) lru_scan_unit(P, l, u >> 1, u & 1);
            for (int rep_ = 0; rep_ < REP_ATT; ++rep_)
            for (int item = P.vcu; item < 256; item += P.G) { const int bh = item >> 1, s = item & 1;
#pragma unroll 1
                for (int i = 0; i < 4; ++i) { const int base = 2 * s + (i >> 1), qb = (i & 1) ? 7 - base : base;
                    att::attn_unit(bh >> 4, bh & 15, qb, (const bf16*)(P.ws + WS_Q), (const bf16*)(P.ws + WS_KN), (const bf16*)(P.ws + WS_KPE), (const bf16*)(P.ws + WS_V), (bf16*)(P.ws + WS_ATT), (LAS char*)ring, P.wave); } }
            __syncthreads();
            SEAM(pb + 4);
        }
        if (EN(5) && IN(pb + 5)) { PHASE_FRAME();
            pg8::PanelOrder S; S.init(P.G, (int)blockIdx.x); const bf16* GT = (const bf16*)(P.ws + WS_GATES);
#ifndef MERGE3
#define MERGE3 1
#endif
            if (MERGE3) { pg8::Gemm g{(const bf16*)(P.ws + WS_YCAT), (const bf16*)(wl + WO_WCAT), M, D, YP}; pg8::EpiMerge3 E{MERGED, (const unsigned char*)GT, 6144}; static_assert(GATES_U8 && MERGE3, "the u8 gate store is read by the fused merge GEMM only"); pg8::gemm_phase<pg8::EpiMerge3, pg8::PanelOrder, true, true>(ring, g, S, E, P.wave); }
            else {
            { pg8::Gemm g{(const bf16*)(P.ws + WS_YLRU), (const bf16*)(wl + WO_LRUO), M, D, LW, YP}; pg8::EpiMerge<true> E{MERGED, GT, 6144}; pg8::gemm_phase<pg8::EpiMerge<true>, pg8::PanelOrder, true, true>(ring, g, S, E, P.wave); }
            { pg8::Gemm g{(const bf16*)(P.ws + WS_YSC), (const bf16*)(wl + WO_SCO), M, D, LW, YP}; pg8::EpiMerge<false> E{MERGED, GT + 2048, 6144}; pg8::gemm_phase<pg8::EpiMerge<false>, pg8::PanelOrder, true, true>(ring, g, S, E, P.wave); }
            { pg8::Gemm g{(const bf16*)(P.ws + WS_ATT), (const bf16*)(wl + WO_MLAO), M, D, D, YP}; pg8::EpiMerge<false> E{MERGED, GT + 4096, 6144}; pg8::gemm_phase<pg8::EpiMerge<false>, pg8::PanelOrder, true, true>(ring, g, S, E, P.wave); }
            }
            SEAM(pb + 5);
        }
        if (EN(6) && IN(pb + 6)) { PHASE_FRAME(); pg8::Gemm g{MERGED, (const bf16*)(wl + WO_WO), M, D, D}; pg8::PanelOrder S; S.init(P.G, (int)blockIdx.x);
            pg8::EpiResid<true, (FP8_G4 != 0)> E{XH, mod + 10240, HN, NORMG(l, 2), mod + 14336, SSQN(l, 2), A8, MODW, 1.0f, SSQN(l, 1)}; pg8::gemm_phase<pg8::EpiResid<true, (FP8_G4 != 0)>, pg8::PanelOrder, true, true>(ring, g, S, E, P.wave); SEAM(pb + 6); }
        if (EN(7) && IN(pb + 7)) { PHASE_FRAME(); pg8::StaticOrder S; S.init(M, 2 * DFF, P.G, (int)blockIdx.x);
            constexpr bool u0 = (FP8_G4 & 1) != 0, u1 = (FP8_G4 & 2) != 0, o0 = fp8_dn(0, 1), o1 = fp8_dn(1, 1);
            if (u0 == u1 && o0 == o1) UP_CALL(u0, o0, wl + WO_W13 + 44 * MiB, 2, SSQN(l, 1)); else if (l == 0) UP_CALL(u0, o0, wl + WO_W13 + 44 * MiB, 2, SSQN(l, 1)); else UP_CALL(u1, o1, wl + WO_W13 + 44 * MiB, 2, SSQN(l, 1));
            SEAM(pb + 7); }
        if (EN(8) && IN(pb + 8)) { PHASE_FRAME(); pg8::PanelOrder S; S.init(P.G, (int)blockIdx.x); static_assert(NL == 2, "per-layer fp8 flags are written out for two layers");
            if (l + 1 < NL) { constexpr bool f8 = fp8_dn(0, 1); pg8::Gemm g{ACT, (const bf16*)(wl + WO_W2 + 22 * MiB), M, D, f8 ? DFF / 2 : DFF};
                constexpr bool e8 = (FP8_G1 & 2) != 0; pg8::EpiResid<true, e8> E{XH, mod + 16384, HN, NORMG(l + 1, 0), MODL(l + 1) + 2048, SSQN(l + 1, 0), A8, MODW, 0.5f * DN_SC(f8), SSQN(l, 2)}; pg8::gemm_phase<pg8::EpiResid<true, e8>, pg8::PanelOrder, true, true, false, false, false, f8>(ring, g, S, E, P.wave); }
            else { constexpr bool f8 = fp8_dn(1, 1); pg8::Gemm g{ACT, (const bf16*)(wl + WO_W2 + 22 * MiB), M, D, f8 ? DFF / 2 : DFF};
                if (REP_G5 > 1) { pg8::EpiNull E0{(float*)(P.ws + WS_AGG)}; pg8::gemm_phase<pg8::EpiNull, pg8::PanelOrder, true, true, false, false, false, f8>(ring, g, S, E0, P.wave); }
                pg8::EpiResid<false> E{XH, mod + 16384, nullptr, nullptr, nullptr, nullptr, nullptr, MODW, 0.5f * DN_SC(f8), nullptr}; pg8::gemm_phase<pg8::EpiResid<false>, pg8::PanelOrder, true, true, false, false, false, f8>(ring, g, S, E, P.wave); }
            SEAM(pb + 8); }
    }
    if (EN(14) && IN(N_PHASES - 1)) { PHASE_FRAME(); final_norm_phase(P, XH, (float*)P.out, in_ptr(I_FING)); }
#undef IN
#undef SEAM
#undef HN
#undef XH
#undef A8
#undef ACT
#undef MERGED
#undef ring
#undef wl
#undef mod
#undef xin0
#undef ssq
}

extern "C" void kernel_launch(void* const* d_in, const int* in_sizes, int n_in, void* d_out, int out_size, void* d_ws, size_t ws_size, hipStream_t stream) {
    static int grid = 0;
    if (grid == 0) {
        if (n_in != 24 || in_sizes[0] != M * D || out_size != M * D || ws_size < WS_END) { fprintf(stderr, "kernel_launch: shape/workspace mismatch (n_in %d, in0 %d, out %d, ws %zu < %zu); nothing launched\n", n_in, n_in > 0 ? in_sizes[0] : -1, out_size, ws_size, (size_t)WS_END); grid = -1; return; }
        int dev = 0, cus = 0, per_cu = 0;
        if (hipGetDevice(&dev) != hipSuccess || hipDeviceGetAttribute(&cus, hipDeviceAttributeMultiprocessorCount, dev) != hipSuccess) { fprintf(stderr, "kernel_launch: device query failed\n"); grid = -1; return; }
        if (hipFuncSetAttribute((const void*)hybrid_fwd, hipFuncAttributeMaxDynamicSharedMemorySize, LDS_BYTES) != hipSuccess) { fprintf(stderr, "kernel_launch: hipFuncSetAttribute failed\n"); grid = -1; return; }
        if (hipOccupancyMaxActiveBlocksPerMultiprocessor(&per_cu, (const void*)hybrid_fwd, NWAVES * 64, LDS_BYTES) != hipSuccess || per_cu < 1) fprintf(stderr, "kernel_launch: note: occupancy query reports %d workgroups per CU\n", per_cu);
        (void)hipGetLastError();
        grid = cus;
    }
    if (grid < 0) return;
    if (hipMemsetAsync((char*)d_ws + WS_CTL, 0, CTL_ZERO_BYTES, stream) != hipSuccess) { fprintf(stderr, "kernel_launch: hipMemsetAsync failed\n"); return; }
    Args a{};
    for (int i = 0; i < 24; ++i) a.in[i] = (const float*)d_in[i];
    a.out = (float*)d_out; a.ws = (unsigned char*)d_ws;
#if MK_N_LAUNCHES == 1
    a.ph_lo = 0; a.ph_hi = N_PHASES;
    hipLaunchKernelGGL(hybrid_fwd, dim3(grid), dim3(NWAVES * 64), LDS_BYTES, stream, a);
#else
    for (int p = 0; p < N_PHASES; ++p) { a.ph_lo = p; a.ph_hi = p + 1; hipLaunchKernelGGL(hybrid_fwd, dim3(grid), dim3(NWAVES * 64), LDS_BYTES, stream, a); }
#endif
    const hipError_t le = hipPeekAtLastError();
    if (le != hipSuccess) fprintf(stderr, "kernel_launch: launch failed: %s\n", hipGetErrorName(le));
}
```

```cpp
#include <hip/hip_runtime.h>
#include <cstdio>
#include <cstdint>
#define MK_N_LAUNCHES 1
#ifndef G1_BF16
#define G1_BF16 0
#endif
#ifndef GATES_U8
#define GATES_U8 1
#endif
namespace pg8 {
#define PG8_LAS __attribute__((address_space(3)))
typedef unsigned short bf16_t;
typedef short bf16x8 __attribute__((ext_vector_type(8)));
typedef float f32x4 __attribute__((ext_vector_type(4)));
typedef unsigned u32x4 __attribute__((ext_vector_type(4)));
typedef int v4i_t __attribute__((ext_vector_type(4)));
typedef int v8i_t __attribute__((ext_vector_type(8)));
constexpr int BM = 256, BK = 64, HALF = 128, HTB = HALF * BK * 2  , STAGE_BYTES = 8 * HTB, NXCD = 8, WGM = 8;

__host__ __device__ __forceinline__ int lds_byte(int r, int c) { const int st = (r >> 4) * 2 + (c >> 5), rr = r & 15, cc = c & 31, ob = rr * 64 + cc * 2; return st * 1024 + (ob ^ (((ob >> 9) & 1) << 5)); }
__host__ __device__ __forceinline__ void stage_rc(int b, int& R, int& C) { const int st = b / 1024, sb = b % 1024, swz = sb ^ (((sb >> 9) & 1) << 5); R = (st >> 1) * 16 + swz / 64; C = (st & 1) * 32 + (swz % 64) / 2; }
__host__ __device__ __forceinline__ int perm32(int rho) { const int n = rho >> 4, i = rho & 15; return 8 * (i >> 2) + 4 * n + (i & 3); }

template <class E> struct has_mid { static constexpr bool value = false; };
struct Unit { int pm, pn; };
struct Gemm { const bf16_t* A; const bf16_t* Bt; int M, N, K; int ld = 0; };

struct StaticOrder {
    int nM, nN, nwg, G, c;
    __host__ __device__ void init(int M, int N, int G_, int c_) { nM = M / BM; nN = N / BM; nwg = nM * nN; G = G_; c = c_; }
    __host__ __device__ bool next(int i, Unit& u) const {
        const long L = (long)i * G + c; if (L >= nwg) return false;
        int wgid = (int)L; { const int q = nwg / NXCD, r = nwg % NXCD, xcd = wgid % NXCD, off = wgid / NXCD; wgid = (xcd < r ? xcd * (q + 1) : r * (q + 1) + (xcd - r) * q) + off; }
        const int nig = WGM * nN, gid = wgid / nig, fm = gid * WGM, gsz = (nM - fm) < WGM ? (nM - fm) : WGM;
        u.pm = fm + ((wgid % nig) % gsz); u.pn = (wgid % nig) / gsz; return true;
    }
    __device__ __forceinline__ void a_ready(const Unit&) const {}
    __device__ __forceinline__ void done(const Unit&) const {}
};

__device__ __forceinline__ unsigned cvt_pk_bf16(float lo, float hi) { unsigned r; asm volatile("v_cvt_pk_bf16_f32 %0, %1, %2" : "=v"(r) : "v"(lo), "v"(hi)); return r; }
typedef float f32x2 __attribute__((ext_vector_type(2)));
struct PanelOrder {
    int G, c;
    __host__ __device__ void init(int G_, int c_) { G = G_; c = c_; }
    __host__ __device__ bool next(int i, Unit& u) const { const long L = (long)i * G + c; if (L >= 512) return false; const int x = (int)(L & 7), j = (int)(L >> 3); u.pm = 8 * x + (j >> 3); u.pn = j & 7; return true; }
    __device__ __forceinline__ void a_ready(const Unit&) const {}
    __device__ __forceinline__ void done(const Unit&) const {}
};
typedef unsigned u32x2 __attribute__((ext_vector_type(2)));
__device__ __forceinline__ float fast_sigmoid(float x) { return __builtin_amdgcn_rcpf(1.0f + __builtin_amdgcn_exp2f(-1.4426950408889634f * x)); }
__device__ __forceinline__ float gelu_tanh(float x) { return x * fast_sigmoid(1.5957691216057308f * (x + 0.044715f * x * x * x)); }
__device__ __forceinline__ u32x4 pack8_bf16(const f32x4 a, const f32x4 b) { u32x4 w; w.x = cvt_pk_bf16(a[0], a[1]); w.y = cvt_pk_bf16(a[2], a[3]); w.z = cvt_pk_bf16(b[0], b[1]); w.w = cvt_pk_bf16(b[2], b[3]); return w; }
__device__ __forceinline__ void unpack8_bf16(const u32x4 w, f32x4& a, f32x4& b) {
    a[0] = __uint_as_float(w.x << 16); a[1] = __uint_as_float(w.x & 0xffff0000u); a[2] = __uint_as_float(w.y << 16); a[3] = __uint_as_float(w.y & 0xffff0000u);
    b[0] = __uint_as_float(w.z << 16); b[1] = __uint_as_float(w.z & 0xffff0000u); b[2] = __uint_as_float(w.w << 16); b[3] = __uint_as_float(w.w & 0xffff0000u); }

struct EpiNull {
    static constexpr bool PERM = true, AFTER_DRAIN = false; float* sink;
    __device__ __forceinline__ void operator()(f32x4 (&acc)[2][2][4][2], const Unit& u, int wr, int wc, int fr, int fq) const {
        float t = 0.f;
#pragma unroll
        for (int ai = 0; ai < 2; ++ai)
#pragma unroll
            for (int bj = 0; bj < 2; ++bj)
#pragma unroll
                for (int m = 0; m < 4; ++m)
#pragma unroll
                    for (int n = 0; n < 2; ++n) t += acc[ai][bj][m][n][0] + acc[ai][bj][m][n][3];
        if (t == 123456.75f) sink[0] = t; }
};
typedef unsigned long long ssq_t;
typedef int i32x4 __attribute__((ext_vector_type(4)));
__device__ __forceinline__ ssq_t ssq_enc(float t) { return (ssq_t)(t * 16777216.0f); }
__device__ __forceinline__ float ssq_dec(ssq_t v) { return (float)(unsigned)(v >> 32) * 256.0f + (float)(unsigned)v * (1.0f / 16777216.0f); }
__device__ __forceinline__ void ssq_add(ssq_t* p, float t) { atomicAdd(p, ssq_enc(t)); }
constexpr float CB_ENC = 1048576.0f, CB_DEC = 1.0f / 1048576.0f;
__device__ __forceinline__ f32x4 cb_ld4(const int* p) { return __builtin_convertvector(*(const i32x4*)p, f32x4) * CB_DEC; }
__device__ __forceinline__ float sat8(float x) { return __builtin_amdgcn_fmed3f(x, -448.0f, 448.0f); }
__device__ __forceinline__ u32x2 pack8_fp8(const f32x4 a, const f32x4 b) {
    unsigned w0 = 0, w1 = 0; w0 = __builtin_amdgcn_cvt_pk_fp8_f32(sat8(a[0]), sat8(a[1]), w0, false); w0 = __builtin_amdgcn_cvt_pk_fp8_f32(sat8(a[2]), sat8(a[3]), w0, true);
    w1 = __builtin_amdgcn_cvt_pk_fp8_f32(sat8(b[0]), sat8(b[1]), w1, false); w1 = __builtin_amdgcn_cvt_pk_fp8_f32(sat8(b[2]), sat8(b[3]), w1, true); return (u32x2){w0, w1}; }
#ifndef A8_CLIP_V
#define A8_CLIP_V 7.0f
#endif
constexpr float A8_CLIP = A8_CLIP_V;
__device__ __forceinline__ float a8_rms(ssq_t prev) { return __builtin_sqrtf(ssq_dec(prev) * (1.0f / 2048.0f) + 1e-20f); }
__device__ __forceinline__ float a8_scale(ssq_t prev) { return a8_rms(prev) * (A8_CLIP / 127.0f); }
__device__ __forceinline__ float a8_inv(ssq_t prev) { return (127.0f / A8_CLIP) * __builtin_amdgcn_rcpf(a8_rms(prev)); }
__device__ __forceinline__ unsigned pk4_i8(float a, float b, float c, float d) {
    unsigned w = 0u;
    w = __builtin_amdgcn_cvt_pk_u8_f32(__builtin_amdgcn_fmed3f(__builtin_rintf(a), -127.0f, 127.0f) + 128.0f, 0, w); w = __builtin_amdgcn_cvt_pk_u8_f32(__builtin_amdgcn_fmed3f(__builtin_rintf(b), -127.0f, 127.0f) + 128.0f, 1, w);
    w = __builtin_amdgcn_cvt_pk_u8_f32(__builtin_amdgcn_fmed3f(__builtin_rintf(c), -127.0f, 127.0f) + 128.0f, 2, w); w = __builtin_amdgcn_cvt_pk_u8_f32(__builtin_amdgcn_fmed3f(__builtin_rintf(d), -127.0f, 127.0f) + 128.0f, 3, w);
    return w ^ 0x80808080u; }
__device__ __forceinline__ u32x2 pack8_i8(const f32x4 a, const f32x4 b) { return (u32x2){pk4_i8(a[0], a[1], a[2], a[3]), pk4_i8(b[0], b[1], b[2], b[3])}; }
__device__ __forceinline__ f32x4 i2f(const f32x4 bits) { return __builtin_convertvector(__builtin_bit_cast(i32x4, bits), f32x4); }
constexpr float ACT8_SC = 8.0f;
template <bool TILED, bool O8 = false, bool I8IN = false> struct EpiSwiglu {
    static constexpr bool PERM = true, AFTER_DRAIN = false;
    bf16_t* O; int ldc; const ssq_t* ssq; const int* cb; int cbstride; float eps; float dsc; const ssq_t* ssqp; const float* wsc;
    __device__ __forceinline__ void operator()(f32x4 (&acc)[2][2][4][2], const Unit& u, int wr, int wc, int fr, int fq) const {
        const int row0 = u.pm * BM + wr * 64 + fr, lc = wc * 32 + 8 * fq, col0 = u.pn * HALF + lc;
        const int* cbp = cb + (size_t)(u.pm >> 3) * cbstride + u.pn * BM + lc;
        f32x4 cv[2][2];
#pragma unroll
        for (int bj = 0; bj < 2; ++bj)
#pragma unroll
            for (int n = 0; n < 2; ++n) cv[bj][n] = cb_ld4(cbp + bj * HALF + 4 * n);
#pragma unroll
        for (int ai = 0; ai < 2; ++ai)
#pragma unroll
            for (int m = 0; m < 4; ++m) { const int row = row0 + ai * HALF + m * 16;
                bf16_t* rowp = TILED ? O + ((size_t)u.pm * (ldc / 64) + 2 * u.pn + (wc >> 1)) * (BM * 64) + (size_t)(row - u.pm * BM) * 64 + (wc & 1) * 32 + 8 * fq
                                    : O + (size_t)row * ldc + col0;
                float ri = __builtin_amdgcn_rsqf(ssq_dec(ssq[row]) * (1.0f / 2048.0f) + eps) * dsc;
                if constexpr (I8IN) { ri *= a8_scale(ssqp[row]) * wsc[0];
#pragma unroll
                    for (int bj = 0; bj < 2; ++bj)
#pragma unroll
                        for (int n = 0; n < 2; ++n) acc[ai][bj][m][n] = i2f(acc[ai][bj][m][n]); }
                f32x4 r0, r1;
#pragma unroll
                for (int e = 0; e < 4; ++e) { const float g0 = acc[ai][0][m][0][e] * ri + cv[0][0][e], g1 = acc[ai][0][m][1][e] * ri + cv[0][1][e];
                    r0[e] = g0 * fast_sigmoid(g0) * (acc[ai][1][m][0][e] * ri + cv[1][0][e]); r1[e] = g1 * fast_sigmoid(g1) * (acc[ai][1][m][1][e] * ri + cv[1][1][e]); }
                if constexpr (O8) *(u32x2*)((unsigned char*)O + (size_t)row * ldc + col0) = pack8_fp8(r0 * ACT8_SC, r1 * ACT8_SC);
                else *(u32x4*)rowp = pack8_bf16(r0, r1); }
    }
};
typedef _Float16 f16_t;
__device__ __forceinline__ float h_lo(unsigned w) { return (float)__builtin_bit_cast(_Float16, (unsigned short)(w & 0xffffu)); }
__device__ __forceinline__ float h_hi(unsigned w) { return (float)__builtin_bit_cast(_Float16, (unsigned short)(w >> 16)); }
__device__ __forceinline__ void unpack8_f16(const u32x4 w, f32x4& a, f32x4& b) {
    const unsigned w0 = w[0], w1 = w[1], w2 = w[2], w3 = w[3];
    a[0] = h_lo(w0); a[1] = h_hi(w0); a[2] = h_lo(w1); a[3] = h_hi(w1); b[0] = h_lo(w2); b[1] = h_hi(w2); b[2] = h_lo(w3); b[3] = h_hi(w3); }
__device__ __forceinline__ unsigned pk2_f16(float lo, float hi) {
    const unsigned short l = __builtin_bit_cast(unsigned short, (_Float16)__builtin_fminf(__builtin_fmaxf(lo, -65504.f), 65504.f)), h = __builtin_bit_cast(unsigned short, (_Float16)__builtin_fminf(__builtin_fmaxf(hi, -65504.f), 65504.f));
    return (unsigned)l | ((unsigned)h << 16); }
__device__ __forceinline__ u32x4 pack8_f16(const f32x4 a, const f32x4 b) { u32x4 w; w[0] = pk2_f16(a[0], a[1]); w[1] = pk2_f16(a[2], a[3]); w[2] = pk2_f16(b[0], b[1]); w[3] = pk2_f16(b[2], b[3]); return w; }
template <bool NEXT, bool F8 = false> struct EpiResid {
    static constexpr bool PERM = true, AFTER_DRAIN = false;
    bf16_t* X; const float* gate; bf16_t* An; const float* gn; const float* scn; ssq_t* ssqn; unsigned char* A8; int gstride; float s; const ssq_t* ssqp;
    __device__ __forceinline__ void operator()(f32x4 (&acc)[2][2][4][2], const Unit& u, int wr, int wc, int fr, int fq) const {
        const int row0 = u.pm * BM + wr * 64 + fr, col0 = u.pn * BM + wc * 32 + 8 * fq;
        const unsigned cofs = (unsigned)((u.pm >> 3) * gstride + col0);
        const unsigned e0 = (unsigned)row0 * 2048u + (unsigned)col0;
#pragma unroll
        for (int ah = 0; ah < 4; ++ah) { const int ai = ah >> 1, mb = (ah & 1) * 2; u32x4 xw[2][2];
#pragma unroll
            for (int mm = 0; mm < 2; ++mm)
#pragma unroll
                for (int bj = 0; bj < 2; ++bj) xw[mm][bj] = *(const u32x4*)(X + (size_t)(e0 + (unsigned)(ai * HALF + (mb + mm) * 16) * 2048u + bj * HALF));
            float ss[2] = {0.f, 0.f}, qs[2] = {0.f, 0.f};
            if (NEXT && F8) {
#pragma unroll
                for (int mm = 0; mm < 2; ++mm) qs[mm] = a8_inv(ssqp[row0 + ai * HALF + (mb + mm) * 16]); }
#pragma unroll
            for (int bj = 0; bj < 2; ++bj) { f32x4 gv[2], nv[2];
#pragma unroll
                for (int n = 0; n < 2; ++n) { gv[n] = *(const f32x4*)(gate + (size_t)(cofs + bj * HALF + 4 * n)) * s;
                    if (NEXT) nv[n] = *(const f32x4*)(gn + (size_t)(unsigned)(col0 + bj * HALF + 4 * n)) * (*(const f32x4*)(scn + (size_t)(cofs + bj * HALF + 4 * n)) + 1.0f); }
#pragma unroll
                for (int mm = 0; mm < 2; ++mm) { const int m = mb + mm; const unsigned off = e0 + (unsigned)(ai * HALF + m * 16) * 2048u + bj * HALF;
                    f32x4 a, b; unpack8_f16(xw[mm][bj], a, b); a += gv[0] * acc[ai][bj][m][0]; b += gv[1] * acc[ai][bj][m][1];
                    *(u32x4*)(X + (size_t)off) = pack8_f16(a, b);
                    if (NEXT) { ss[mm] += ((a[0] * a[0] + a[1] * a[1]) + (a[2] * a[2] + a[3] * a[3])) + ((b[0] * b[0] + b[1] * b[1]) + (b[2] * b[2] + b[3] * b[3]));
                        const f32x4 an = a * nv[0], bn = b * nv[1]; if (An) *(u32x4*)(An + (size_t)off) = pack8_bf16(an, bn);
                        if (F8) *(u32x2*)(A8 + (size_t)off) = pack8_i8(an * qs[mm], bn * qs[mm]); } } }
            if (NEXT) {
#pragma unroll
                for (int mm = 0; mm < 2; ++mm) { float t = ss[mm]; t += __shfl_xor(t, 16); t += __shfl_xor(t, 32); if (fq == 0) ssq_add(ssqn + row0 + ai * HALF + (mb + mm) * 16, t); } }
            asm volatile("" ::: "memory"); }
    }
};
template <int MODE, bool QF8> struct EpiWin {
    static constexpr bool PERM = true, AFTER_DRAIN = false;
    bf16_t *LRUX, *LRUG, *SCB, *SCC, *SCX, *Q, *KVLAT, *GATES, *KPE; ssq_t* ssq; const ssq_t* ssqn; const int* cb; int cbstride; float eps; const ssq_t* ssqp; const float* wsc;
    __device__ __forceinline__ void operator()(f32x4 (&acc)[2][2][4][2], const Unit& u, int wr, int wc, int fr, int fq) const {
        const int t = u.pn; bf16_t* base; int pitch, cbs, act = 0;
        if (MODE == 0) { const int tq = QF8 ? 20 : 32;
            if (t < 4) { base = LRUX; pitch = 1024; cbs = 256 * t; }
            else if (t < 8) { base = LRUG; pitch = 1024; cbs = 256 * (t - 4); act = 1; }
            else if (t < 12) { base = SCB; pitch = 1024; cbs = 256 * (t - 8); }
            else if (t < 16) { base = SCC; pitch = 1024; cbs = 256 * (t - 12); }
            else if (t < 20) { base = SCX; pitch = 1024; cbs = 256 * (t - 16); }
            else if (t < tq) { base = Q; pitch = 3072; cbs = 256 * (t - 20); }
            else if (t < tq + 2) { base = KVLAT; pitch = 512; cbs = 256 * (t - tq); act = 3; }
            else if (!G1_BF16 || t == tq + 2) { base = KPE; pitch = 64; cbs = 0; act = 4; }
            else { base = GATES; pitch = 6144; cbs = 2048 + 256 * (t - (tq + 3)); act = 2; }
        } else if (MODE == 2) {
            if (t < 4) { base = LRUX; pitch = 1024; cbs = 256 * t; }
            else if (t < 8) { base = LRUG; pitch = 1024; cbs = 256 * (t - 4); act = 1; }
            else if (t < 12) { base = SCB; pitch = 1024; cbs = 256 * (t - 8); }
            else if (t < 16) { base = SCC; pitch = 1024; cbs = 256 * (t - 12); }
            else if (t < 20) { base = SCX; pitch = 1024; cbs = 256 * (t - 16); }
            else if (t < 32) { base = Q; pitch = 3072; cbs = 256 * (t - 20); }
            else if (t < 34) { base = KVLAT; pitch = 512; cbs = 256 * (t - 32); act = 3; }
            else if (t < 58) { base = GATES; pitch = 6144; cbs = 256 * (t - 34); act = 2; }
            else { base = KPE; pitch = 64; cbs = 0; act = 4; }
        } else { const int tg = QF8 ? 12 : 0;
            if (t < tg) { base = Q; pitch = 3072; cbs = 256 * t; }
            else { base = GATES; pitch = 6144; cbs = 256 * (t - tg) + ((G1_BF16 && t >= tg + 8) ? 2048 : 0); act = 2; }
        }
        const float dsc = MODE == 1 ? wsc[0] : (MODE == 2 ? (1.0f / 64.0f) : 1.0f);
        const int row0 = u.pm * BM + wr * 64 + fr;
        bf16_t* p0 = base + (size_t)row0 * pitch + cbs + wc * 32 + 8 * fq;
        const size_t rstep = (size_t)16 * pitch;
        const int* cbp = cb + (size_t)(u.pm >> 3) * cbstride + (MODE == 1 ? (QF8 ? (G1_BF16 ? 7936 : 5888) : 8960) : 0) + u.pn * BM + wc * 32 + 8 * fq;
        if (act == 4) {
            if (wc < 2) { f32x4 cv[1][2]; cv[0][0] = cb_ld4(cbp); cv[0][1] = cb_ld4(cbp + 4);
#pragma unroll
                for (int ai = 0; ai < 2; ++ai)
#pragma unroll
                    for (int m = 0; m < 4; ++m) { const float ri = __builtin_amdgcn_rsqf(ssq_dec(ssqn[row0 + ai * HALF + m * 16]) * (1.0f / 2048.0f) + eps) * dsc;
                        *(u32x4*)(p0 + (size_t)(ai * 8 + m) * rstep) = pack8_bf16(acc[ai][0][m][0] * ri + cv[0][0], acc[ai][0][m][1] * ri + cv[0][1]); }
            }
            return;
        }
        f32x4 cv[2][2];
#pragma unroll
        for (int bj = 0; bj < 2; ++bj)
#pragma unroll
            for (int n = 0; n < 2; ++n) cv[bj][n] = cb_ld4(cbp + bj * HALF + 4 * n);
#pragma unroll
        for (int ai = 0; ai < 2; ++ai)
#pragma unroll
            for (int m = 0; m < 4; ++m) { bf16_t* rowp = p0 + (size_t)(ai * 8 + m) * rstep;
                float ri = __builtin_amdgcn_rsqf(ssq_dec(ssqn[row0 + ai * HALF + m * 16]) * (1.0f / 2048.0f) + eps) * dsc;
                if (MODE == 1) { ri *= a8_scale(ssqp[row0 + ai * HALF + m * 16]);
#pragma unroll
                    for (int bj = 0; bj < 2; ++bj)
#pragma unroll
                        for (int n = 0; n < 2; ++n) acc[ai][bj][m][n] = i2f(acc[ai][bj][m][n]); }
                f32x4 v[2][2];
#pragma unroll
                for (int bj = 0; bj < 2; ++bj)
#pragma unroll
                    for (int n = 0; n < 2; ++n) v[bj][n] = acc[ai][bj][m][n] * ri + cv[bj][n];
                if (act == 1) {
#pragma unroll
                    for (int bj = 0; bj < 2; ++bj)
#pragma unroll
                        for (int n = 0; n < 2; ++n)
#pragma unroll
                            for (int e = 0; e < 4; ++e) v[bj][n][e] = gelu_tanh(v[bj][n][e]);
                } else if (act == 2) {
#pragma unroll
                    for (int bj = 0; bj < 2; ++bj)
#pragma unroll
                        for (int n = 0; n < 2; ++n)
#pragma unroll
                            for (int e = 0; e < 4; ++e) v[bj][n][e] = fast_sigmoid(v[bj][n][e]);
                } else if (act == 3) { float s = 0.f;
#pragma unroll
                    for (int bj = 0; bj < 2; ++bj)
#pragma unroll
                        for (int n = 0; n < 2; ++n) { const f32x4 x = v[bj][n]; s += (x[0] * x[0] + x[1] * x[1]) + (x[2] * x[2] + x[3] * x[3]); }
                    s += __shfl_xor(s, 16); s += __shfl_xor(s, 32);
                    if (fq == 0) ssq_add(ssq + row0 + ai * HALF + m * 16, s); }
                if (GATES_U8 && act == 2) { unsigned char* r8 = (unsigned char*)base + (size_t)(row0 + ai * HALF + m * 16) * pitch + cbs + wc * 32 + 8 * fq;
#pragma unroll
                    for (int bj = 0; bj < 2; ++bj) { unsigned w0 = 0u, w1 = 0u;
#pragma unroll
                        for (int e = 0; e < 4; ++e) { w0 = __builtin_amdgcn_cvt_pk_u8_f32(v[bj][0][e] * 255.0f, e, w0); w1 = __builtin_amdgcn_cvt_pk_u8_f32(v[bj][1][e] * 255.0f, e, w1); }
                        *(u32x2*)(r8 + bj * HALF) = (u32x2){w0, w1}; } }
                else { *(u32x4*)rowp = pack8_bf16(v[0][0], v[0][1]); *(u32x4*)(rowp + HALF) = pack8_bf16(v[1][0], v[1][1]); }
                asm volatile("" ::: "memory"); }
    }
};
struct EpiKV {
    static constexpr bool PERM = true, AFTER_DRAIN = false;
    bf16_t *KN, *V; const ssq_t* ssq; float eps;
    __device__ __forceinline__ void operator()(f32x4 (&acc)[2][2][4][2], const Unit& u, int wr, int wc, int fr, int fq) const {
        const int row0 = u.pm * BM + wr * 64 + fr, col0 = u.pn * HALF + wc * 32 + 8 * fq;
#pragma unroll
        for (int ai = 0; ai < 2; ++ai)
#pragma unroll
            for (int m = 0; m < 4; ++m) { const int row = row0 + ai * HALF + m * 16; const float ri = __builtin_amdgcn_rsqf(ssq_dec(ssq[row]) * (1.0f / 512.0f) + eps);
                *(u32x4*)(KN + (size_t)row * 2048 + col0) = pack8_bf16(acc[ai][0][m][0] * ri, acc[ai][0][m][1] * ri);
                *(u32x4*)(V + (size_t)row * 2048 + col0) = pack8_bf16(acc[ai][1][m][0] * ri, acc[ai][1][m][1] * ri); }
    }
};
struct EpiMerge3 {
    static constexpr bool PERM = true, AFTER_DRAIN = false;
    bf16_t* Mg; const unsigned char* G; int gp;
    static __device__ __forceinline__ void un8(const u32x2 w, f32x4& a, f32x4& b) {
        a[0] = __builtin_fmaxf((float)(w[0] & 0xffu), 0.00390625f); a[1] = __builtin_fmaxf((float)((w[0] >> 8) & 0xffu), 0.00390625f); a[2] = __builtin_fmaxf((float)((w[0] >> 16) & 0xffu), 0.00390625f); a[3] = __builtin_fmaxf((float)(w[0] >> 24), 0.00390625f);
        b[0] = __builtin_fmaxf((float)(w[1] & 0xffu), 0.00390625f); b[1] = __builtin_fmaxf((float)((w[1] >> 8) & 0xffu), 0.00390625f); b[2] = __builtin_fmaxf((float)((w[1] >> 16) & 0xffu), 0.00390625f); b[3] = __builtin_fmaxf((float)(w[1] >> 24), 0.00390625f); }
    static __device__ __forceinline__ f32x4 rcp4(f32x4 g) { f32x4 r; r[0] = __builtin_amdgcn_rcpf(g[0]); r[1] = __builtin_amdgcn_rcpf(g[1]); r[2] = __builtin_amdgcn_rcpf(g[2]); r[3] = __builtin_amdgcn_rcpf(g[3]); return r; }
    __device__ __forceinline__ bool mid_at(int t) const { return t == 16 || t == 32; }
    __device__ __forceinline__ void mid(f32x4 (&acc)[2][2][4][2], const Unit& u, int wr, int wc, int fr, int fq, int t) const {
        const int row0 = u.pm * BM + wr * 64 + fr, col0 = u.pn * BM + wc * 32 + 8 * fq + (t == 16 ? 0 : 2048);
        const unsigned char* g0p = G + (size_t)row0 * gp + col0;
#pragma unroll
        for (int ai = 0; ai < 2; ++ai) { u32x2 nw[4][2], dw[4][2];
#pragma unroll
            for (int m = 0; m < 4; ++m)
#pragma unroll
                for (int bj = 0; bj < 2; ++bj) { const size_t ro = (size_t)(ai * HALF + m * 16);
                    nw[m][bj] = *(const u32x2*)(g0p + ro * gp + bj * HALF); dw[m][bj] = *(const u32x2*)(g0p + ro * gp + bj * HALF + 2048); }
#pragma unroll
            for (int m = 0; m < 4; ++m)
#pragma unroll
                for (int bj = 0; bj < 2; ++bj) { f32x4 n0, n1, d0, d1; un8(nw[m][bj], n0, n1); un8(dw[m][bj], d0, d1);
                    acc[ai][bj][m][0] *= n0 * rcp4(d0); acc[ai][bj][m][1] *= n1 * rcp4(d1); }
            asm volatile("" ::: "memory"); }
    }
    __device__ __forceinline__ void operator()(f32x4 (&acc)[2][2][4][2], const Unit& u, int wr, int wc, int fr, int fq) const {
        const int row0 = u.pm * BM + wr * 64 + fr, col0 = u.pn * BM + wc * 32 + 8 * fq;
        const unsigned char* g0p = G + (size_t)row0 * gp + col0 + 4096; bf16_t* m0p = Mg + (size_t)row0 * 2048 + col0;
#pragma unroll
        for (int ai = 0; ai < 2; ++ai) { u32x2 gw[4][2];
#pragma unroll
            for (int m = 0; m < 4; ++m)
#pragma unroll
                for (int bj = 0; bj < 2; ++bj) gw[m][bj] = *(const u32x2*)(g0p + (size_t)(ai * HALF + m * 16) * gp + bj * HALF);
#pragma unroll
            for (int m = 0; m < 4; ++m)
#pragma unroll
                for (int bj = 0; bj < 2; ++bj) { f32x4 g0, g1; un8(gw[m][bj], g0, g1);
                    *(u32x4*)(m0p + (size_t)(ai * HALF + m * 16) * 2048 + bj * HALF) = pack8_bf16(acc[ai][bj][m][0] * (g0 * (1.0f / 255.0f)), acc[ai][bj][m][1] * (g1 * (1.0f / 255.0f))); }
            asm volatile("" ::: "memory"); }
    }
};
template <> struct has_mid<EpiMerge3> { static constexpr bool value = true; };
template <bool FIRST> struct EpiMerge {
    static constexpr bool PERM = true, AFTER_DRAIN = false;
    bf16_t* Mg; const bf16_t* G; int gp;
    __device__ __forceinline__ void operator()(f32x4 (&acc)[2][2][4][2], const Unit& u, int wr, int wc, int fr, int fq) const {
        const int row0 = u.pm * BM + wr * 64 + fr, col0 = u.pn * BM + wc * 32 + 8 * fq;
        const bf16_t* g0p = G + (size_t)row0 * gp + col0; bf16_t* m0p = Mg + (size_t)row0 * 2048 + col0;
#pragma unroll
        for (int ai = 0; ai < 2; ++ai) { u32x4 gw[4][2], mw[4][2];
#pragma unroll
            for (int m = 0; m < 4; ++m)
#pragma unroll
                for (int bj = 0; bj < 2; ++bj) { const size_t ro = (size_t)(ai * HALF + m * 16);
                    gw[m][bj] = *(const u32x4*)(g0p + ro * gp + bj * HALF); if (!FIRST) mw[m][bj] = *(const u32x4*)(m0p + ro * 2048 + bj * HALF); }
#pragma unroll
            for (int m = 0; m < 4; ++m)
#pragma unroll
                for (int bj = 0; bj < 2; ++bj) { const size_t ro = (size_t)(ai * HALF + m * 16);
                    f32x4 g0, g1; unpack8_bf16(gw[m][bj], g0, g1); f32x4 v0 = acc[ai][bj][m][0] * g0, v1 = acc[ai][bj][m][1] * g1;
                    if (!FIRST) { f32x4 m0, m1; unpack8_bf16(mw[m][bj], m0, m1); v0 += m0; v1 += m1; }
                    *(u32x4*)(m0p + ro * 2048 + bj * HALF) = pack8_bf16(v0, v1); }
            asm volatile("" ::: "memory"); }
    }
};
template <bool F> struct FragA_ { bf16x8 v[4][2]; }; template <> struct FragA_<true> { v8i_t v[4]; };
template <bool F> struct FragB_ { bf16x8 v[2][2]; }; template <> struct FragB_<true> { v8i_t v[2]; };
template <class Epi, class Sched, bool ALIGN_EPI = false, bool SP2 = false, bool REVK = false, bool ATILED = false, bool BTILED = false, bool FP8 = false, bool I8 = false>
__device__ __forceinline__ void gemm_phase(PG8_LAS unsigned char* lds, const Gemm g, const Sched S, const Epi E, int wave_id) {
    unsigned m1_ = ~0u; asm volatile("" : "+s"(m1_)); int tid_ = wave_id * 64 + (int)__builtin_amdgcn_mbcnt_hi(m1_, __builtin_amdgcn_mbcnt_lo(m1_, 0u)); asm volatile("" : "+v"(tid_));
    const int tid = tid_, wid = __builtin_amdgcn_readfirstlane(tid >> 6), lane = tid & 63, wr = wid >> 2, wc = wid & 3, fr = lane & 15, fq = lane >> 4;
    const int K = g.K, nt = K / BK, LD = g.ld ? g.ld : K;
    unsigned voffA[2], voffB[2];
#pragma unroll
    for (int i = 0; i < 2; ++i) { int R, C; stage_rc(tid * 16 + i * 8192, R, C); const int Rb = Epi::PERM ? ((R & ~31) + perm32(R & 31)) : R;
        voffA[i] = ATILED ? (unsigned)(R * BK + C) * 2u : (unsigned)(R * LD + C) * 2u; voffB[i] = BTILED ? (unsigned)(Rb * BK + C) * 2u : (unsigned)(Rb * LD + C) * 2u; }
    const size_t kstep = REVK ? (size_t)0 - (size_t)(BK * 2) : (size_t)(BK * 2), kbase = REVK ? (size_t)(K - BK) * 2 : (size_t)0;
    const size_t hstep = (size_t)HALF * LD * 2;
    const size_t kstepB = BTILED ? (size_t)(BM * BK * 2) : kstep, hstepB = BTILED ? (size_t)(HALF * BK * 2) : hstep;
    const size_t kstepA = ATILED ? (size_t)(BM * BK * 2) : kstep, hstepA = ATILED ? (size_t)(HALF * BK * 2) : hstep;
    const size_t tstep = 2 * hstep;
    const unsigned ldsw = (unsigned)wid * 1024u;
    const int aoff = lds_byte(wr * 64 + fr, fq * 8), boff = lds_byte(wc * 32 + fr, fq * 8);
#define PG8_SA(b, h) (((b) * 2 + (h)) * HTB)
#define PG8_SB(b, h) ((4 + (b) * 2 + (h)) * HTB)
#define PG8_STAGE(bufoff, gbase, voff) do { _Pragma("unroll") for (int _i = 0; _i < 2; ++_i) \
        __builtin_amdgcn_global_load_lds((const unsigned*)((const char*)(gbase) + (voff)[_i]), (PG8_LAS unsigned*)(lds + (bufoff) + ldsw + _i * 8192), 16, 0, 0); } while (0)
#define PG8_LDA(dst, b, h) do { if constexpr (FP8) { _Pragma("unroll") for (int m = 0; m < 4; ++m) { const v4i_t lo_ = *(const PG8_LAS v4i_t*)(lds + PG8_SA(b, h) + aoff + m * 2048), hi_ = *(const PG8_LAS v4i_t*)(lds + PG8_SA(b, h) + aoff + m * 2048 + 1024); dst.v[m] = __builtin_shufflevector(lo_, hi_, 0, 1, 2, 3, 4, 5, 6, 7); } } \
        else { _Pragma("unroll") for (int m = 0; m < 4; ++m) _Pragma("unroll") for (int k = 0; k < 2; ++k) dst.v[m][k] = *(const PG8_LAS bf16x8*)(lds + PG8_SA(b, h) + aoff + m * 2048 + k * 1024); } } while (0)
#define PG8_LDB(dst, b, h) do { if constexpr (FP8) { _Pragma("unroll") for (int n = 0; n < 2; ++n) { const v4i_t lo_ = *(const PG8_LAS v4i_t*)(lds + PG8_SB(b, h) + boff + n * 2048), hi_ = *(const PG8_LAS v4i_t*)(lds + PG8_SB(b, h) + boff + n * 2048 + 1024); dst.v[n] = __builtin_shufflevector(lo_, hi_, 0, 1, 2, 3, 4, 5, 6, 7); } } \
        else { _Pragma("unroll") for (int n = 0; n < 2; ++n) _Pragma("unroll") for (int k = 0; k < 2; ++k) dst.v[n][k] = *(const PG8_LAS bf16x8*)(lds + PG8_SB(b, h) + boff + n * 2048 + k * 1024); } } while (0)
#define PG8_MMA(ai, bj, At, Bt) do { __builtin_amdgcn_s_setprio(1); \
        if constexpr (FP8) { _Pragma("unroll") for (int m = 0; m < 4; ++m) _Pragma("unroll") for (int n = 0; n < 2; ++n) \
            asm volatile("v_mfma_scale_f32_16x16x128_f8f6f4 %0, %1, %2, %0, %3, %3 op_sel_hi:[0,0,0]" : "+v"(acc[ai][bj][m][n]) : "v"(Bt.v[n]), "v"(At.v[m]), "v"(sc_one)); } \
        else { _Pragma("unroll") for (int m = 0; m < 4; ++m) _Pragma("unroll") for (int n = 0; n < 2; ++n) _Pragma("unroll") for (int k = 0; k < 2; ++k) \
            { if constexpr (I8) acc[ai][bj][m][n] = __builtin_bit_cast(f32x4, __builtin_amdgcn_mfma_i32_16x16x64_i8(__builtin_bit_cast(v4i_t, Bt.v[n][k]), __builtin_bit_cast(v4i_t, At.v[m][k]), __builtin_bit_cast(v4i_t, acc[ai][bj][m][n]), 0, 0, 0)); \
              else acc[ai][bj][m][n] = __builtin_amdgcn_mfma_f32_16x16x32_bf16(Bt.v[n][k], At.v[m][k], acc[ai][bj][m][n], 0, 0, 0); } } \
        __builtin_amdgcn_s_setprio(0); } while (0)
#define PG8_WAIT_V(n) asm volatile("s_waitcnt vmcnt(" #n ")" ::: "memory")
#define PG8_WAIT_L(n) asm volatile("s_waitcnt lgkmcnt(" #n ")" ::: "memory")
#define PG8_BAR __builtin_amdgcn_s_barrier()
#define PG8_SCHED __builtin_amdgcn_sched_barrier(0)
    Unit cur, nxt; int ui = 0;
    if (!S.next(0, cur)) return;
    f32x4 acc[2][2][4][2];
#pragma unroll
    for (int a = 0; a < 2; ++a)
#pragma unroll
        for (int b = 0; b < 2; ++b)
#pragma unroll
            for (int m = 0; m < 4; ++m)
#pragma unroll
                for (int n = 0; n < 2; ++n) acc[a][b][m][n] = (f32x4){0.f, 0.f, 0.f, 0.f};
    int sc_one = 0x7f7f7f7f; asm volatile("" : "+v"(sc_one));
    FragA_<FP8> At; FragB_<FP8> B0, B1;
    const char* cA = (const char*)g.A + (size_t)cur.pm * tstep + kbase; const char* cB = (const char*)g.Bt + (size_t)cur.pn * tstep + kbase;
    S.a_ready(cur);
    if constexpr (SP2) {
        PG8_STAGE(PG8_SB(0, 0), cB, voffB); PG8_STAGE(PG8_SB(0, 1), cB + hstepB, voffB); PG8_STAGE(PG8_SA(0, 0), cA, voffA); PG8_STAGE(PG8_SA(0, 1), cA + hstepA, voffA);
        if (wr == 1) PG8_BAR;
        PG8_WAIT_V(2); PG8_BAR;
        PG8_STAGE(PG8_SB(1, 0), cB + kstepB, voffB); PG8_STAGE(PG8_SA(1, 0), cA + kstepA, voffA); PG8_STAGE(PG8_SB(1, 1), cB + hstepB + kstepB, voffB);
        PG8_WAIT_V(6); PG8_BAR;
    } else {
        PG8_STAGE(PG8_SB(0, 0), cB, voffB); PG8_STAGE(PG8_SA(0, 0), cA, voffA); PG8_STAGE(PG8_SB(0, 1), cB + hstepB, voffB); PG8_STAGE(PG8_SA(0, 1), cA + hstepA, voffA);
        if (wr == 1) PG8_BAR;
        PG8_WAIT_V(4); PG8_BAR;
        PG8_STAGE(PG8_SB(1, 0), cB + kstepB, voffB); PG8_STAGE(PG8_SA(1, 0), cA + kstepA, voffA); PG8_STAGE(PG8_SB(1, 1), cB + hstepB + kstepB, voffB);
        PG8_WAIT_V(6); PG8_BAR;
    }
    for (;;) {
        const bool has_next = S.next(ui + 1, nxt);
        const char* nA = has_next ? (const char*)g.A + (size_t)nxt.pm * tstep + kbase : cA; const char* nB = has_next ? (const char*)g.Bt + (size_t)nxt.pn * tstep + kbase : cB;
        for (int t = 0; t < nt; t += 2) {
            if constexpr (has_mid<Epi>::value) { if (E.mid_at(t)) { int fr_m = fr, fq_m = fq; asm volatile("" : "+v"(fr_m), "+v"(fq_m)); E.mid(acc, cur, wr, wc, fr_m, fq_m, t); } }
            const bool last = (t == nt - 2);
            const char* a1 = cA + (size_t)(t + 1) * kstepA;
            const char* a2 = last ? nA : cA + (size_t)(t + 2) * kstepA; const char* b2 = last ? nB : cB + (size_t)(t + 2) * kstepB;
            const char* a3 = a2 + kstepA; const char* b3 = b2 + kstepB;
            if (last && has_next) S.a_ready(nxt);
            if constexpr (SP2) {
            PG8_LDB(B0, 0, 0); PG8_LDB(B1, 0, 1); PG8_SCHED; PG8_LDA(At, 0, 0); PG8_STAGE(PG8_SA(1, 1), a1 + hstepA, voffA);
            PG8_WAIT_V(8); PG8_WAIT_L(0); PG8_BAR; PG8_MMA(0, 0, At, B0); PG8_MMA(0, 1, At, B1); PG8_BAR; PG8_SCHED;
            PG8_LDA(At, 0, 1); PG8_STAGE(PG8_SB(0, 0), b2, voffB); PG8_STAGE(PG8_SB(0, 1), b2 + hstepB, voffB); PG8_STAGE(PG8_SA(0, 0), a2, voffA);
            PG8_WAIT_V(8); PG8_WAIT_L(0); PG8_BAR; PG8_MMA(1, 0, At, B0); PG8_MMA(1, 1, At, B1); PG8_BAR; PG8_SCHED;
            PG8_LDB(B0, 1, 0); PG8_LDB(B1, 1, 1); PG8_SCHED; PG8_LDA(At, 1, 0); PG8_STAGE(PG8_SA(0, 1), a2 + hstepA, voffA);
            PG8_WAIT_V(8); PG8_WAIT_L(0); PG8_BAR; PG8_MMA(0, 0, At, B0); PG8_MMA(0, 1, At, B1); PG8_BAR; PG8_SCHED;
            PG8_LDA(At, 1, 1); PG8_STAGE(PG8_SB(1, 0), b3, voffB); PG8_STAGE(PG8_SB(1, 1), b3 + hstepB, voffB); PG8_STAGE(PG8_SA(1, 0), a3, voffA);
            PG8_WAIT_V(8); PG8_WAIT_L(0); PG8_BAR; PG8_MMA(1, 0, At, B0); PG8_MMA(1, 1, At, B1); PG8_BAR; PG8_SCHED;
            } else {
            PG8_LDB(B0, 0, 0); PG8_SCHED; PG8_LDA(At, 0, 0); PG8_STAGE(PG8_SA(1, 1), a1 + hstepA, voffA);
            PG8_WAIT_L(8); PG8_BAR; PG8_WAIT_L(0); PG8_MMA(0, 0, At, B0); PG8_BAR; PG8_SCHED;
            PG8_LDB(B1, 0, 1); PG8_STAGE(PG8_SB(0, 0), b2, voffB);
            PG8_BAR; PG8_WAIT_L(0); PG8_MMA(0, 1, At, B1); PG8_BAR;
            PG8_LDA(At, 0, 1); PG8_STAGE(PG8_SA(0, 0), a2, voffA);
            PG8_BAR; PG8_WAIT_L(0); PG8_MMA(1, 0, At, B0); PG8_BAR; PG8_SCHED;
            PG8_STAGE(PG8_SB(0, 1), b2 + hstepB, voffB);
            PG8_WAIT_V(6); PG8_BAR; PG8_MMA(1, 1, At, B1); PG8_BAR;
            PG8_LDB(B0, 1, 0); PG8_SCHED; PG8_LDA(At, 1, 0); PG8_STAGE(PG8_SA(0, 1), a2 + hstepA, voffA);
            PG8_WAIT_L(8); PG8_BAR; PG8_WAIT_L(0); PG8_MMA(0, 0, At, B0); PG8_BAR; PG8_SCHED;
            PG8_LDB(B1, 1, 1); PG8_STAGE(PG8_SB(1, 0), b3, voffB);
            PG8_BAR; PG8_WAIT_L(0); PG8_MMA(0, 1, At, B1); PG8_BAR;
            PG8_LDA(At, 1, 1); PG8_STAGE(PG8_SA(1, 0), a3, voffA);
            PG8_BAR; PG8_WAIT_L(0); PG8_MMA(1, 0, At, B0); PG8_BAR; PG8_SCHED;
            PG8_STAGE(PG8_SB(1, 1), b3 + hstepB, voffB);
            PG8_WAIT_V(6); PG8_BAR; PG8_MMA(1, 1, At, B1); PG8_BAR;
            }
        }
        if constexpr (FP8) { asm volatile("s_nop 15\n\ts_nop 15\n\ts_nop 15\n\ts_nop 15\n\ts_nop 15" ::: "memory"); }
        if constexpr (ALIGN_EPI) { if (wr == 0) PG8_BAR; }
        if constexpr (!Epi::AFTER_DRAIN) { int fr_e = fr, fq_e = fq; asm volatile("" : "+v"(fr_e), "+v"(fq_e));
            E(acc, cur, wr, wc, fr_e, fq_e); S.done(cur); }
        if (!has_next) break;
#pragma unroll
        for (int a = 0; a < 2; ++a)
#pragma unroll
            for (int b = 0; b < 2; ++b)
#pragma unroll
                for (int m = 0; m < 4; ++m)
#pragma unroll
                    for (int n = 0; n < 2; ++n) acc[a][b][m][n] = (f32x4){0.f, 0.f, 0.f, 0.f};
        cur = nxt; cA = nA; cB = nB; ++ui;
        if constexpr (ALIGN_EPI) { if (wr == 1) PG8_BAR; }
    }
    PG8_WAIT_V(0);
    if constexpr (!ALIGN_EPI) { if (wr == 0) PG8_BAR; }
    PG8_BAR;
    if constexpr (Epi::AFTER_DRAIN) { E.fused(acc, cur, wr, wc, fr, fq, lds, wid, lane); S.done(cur); }
#undef PG8_SA
#undef PG8_SB
#undef PG8_STAGE
#undef PG8_LDA
#undef PG8_LDB
#undef PG8_MMA
#undef PG8_WAIT_V
#undef PG8_WAIT_L
#undef PG8_BAR
#undef PG8_SCHED
}
}
namespace att {
#define ATT_LAS __attribute__((address_space(3)))
typedef unsigned short bf16;
typedef short bf16x8 __attribute__((ext_vector_type(8)));
typedef short s16x4 __attribute__((ext_vector_type(4)));
typedef float f32x16 __attribute__((ext_vector_type(16)));
typedef float f32x4 __attribute__((ext_vector_type(4)));
typedef unsigned u32x4 __attribute__((ext_vector_type(4)));
constexpr int NW = 8, QBLK = 32, KVBLK = 64, QB = NW * QBLK;
constexpr int SEQ = 2048, NH = 16, QPITCH = 3072, KPITCH = 2048, PEPITCH = 64, OPITCH = 4096  , QHEAD = 192;
constexpr float SCALE = 0.07216878364870322f;
constexpr float THR = 8.f;
constexpr int SHM_V = 16384, SHM_KN = 16384, SHM_KP = 8192;
constexpr int OFF_V = 0, OFF_KN = 3 * SHM_V, OFF_KP = OFF_KN + 2 * SHM_KN, OFF_WS = OFF_KP + 2 * SHM_KP, LDS_BYTES = OFF_WS + NW * 64 * 4;
#define ATT_KSWZ(row, colB) ((row) * 256 + ((colB) ^ (((row) & 7) << 4)))
#define ATT_KPSWZ(row, ch) ((row) * 128 + ((((ch) ^ (((row) >> 1) & 7))) << 4))
#define ATT_SBAR() __builtin_amdgcn_sched_barrier(0)
__device__ __forceinline__ int v_st(int k, int c) { const int kk = (k & ~0xC) | ((k & 4) << 1) | ((k & 8) >> 1); return ((kk >> 3) * 4 + (c >> 5)) * 512 + ((kk & 7) * 32 + (c & 31)) * 2; }
__device__ __forceinline__ int v_rd_base(int lane) { return ((lane & 3) << 3) | (((lane >> 2) & 3) << 6) | (((lane >> 4) & 1) << 5) | (((lane >> 5) & 1) << 8); }
constexpr int v_rd_off(int d0, int ks, int half) { return d0 * 512 + ks * 4096 + half * 2048; }
__device__ __forceinline__ int crow(int r, int hi) { return (r & 3) + 8 * (r >> 2) + 4 * hi; }
__device__ __forceinline__ unsigned cvtpk(float lo, float hi) { unsigned r; asm volatile("v_cvt_pk_bf16_f32 %0, %1, %2" : "=v"(r) : "v"(lo), "v"(hi)); return r; }
__device__ __forceinline__ void mask_tile(f32x16& p0, f32x16& p1, int dq) {
    const float NEG = -__builtin_inff();
#pragma unroll
    for (int r = 0; r < 16; ++r) { const int c = (r & 3) + 8 * (r >> 2); if (dq - c < 0) p0[r] = NEG; if (dq - c - 32 < 0) p1[r] = NEG; }
}
__device__ __forceinline__ void partialSM(f32x16& p0, f32x16& p1, float& m_reg, float& mn, float& alpha) {
    float pmax = p0[0];
#pragma unroll
    for (int r = 1; r < 16; ++r) pmax = fmaxf(pmax, p0[r]);
#pragma unroll
    for (int r = 0; r < 16; ++r) pmax = fmaxf(pmax, p1[r]);
    { auto rr = __builtin_amdgcn_permlane32_swap(__float_as_uint(pmax), __float_as_uint(pmax), false, false); pmax = fmaxf(__uint_as_float(rr[0]), __uint_as_float(rr[1])); }
    constexpr float C2 = 1.4426950408889634f * SCALE;
    if (__builtin_expect(__all((pmax - m_reg) * SCALE <= THR), 1)) { mn = m_reg; alpha = 1.f; }
    else { mn = fmaxf(m_reg, pmax); alpha = __builtin_amdgcn_exp2f((m_reg - mn) * C2); m_reg = mn; }
    const float mnL = -mn * C2;
#pragma unroll
    for (int r = 0; r < 16; ++r) p0[r] = fmaf(p0[r], C2, mnL);
#pragma unroll
    for (int r = 0; r < 16; ++r) p1[r] = fmaf(p1[r], C2, mnL);
#pragma unroll
    for (int r = 0; r < 16; ++r) p0[r] = __builtin_amdgcn_exp2f(p0[r]);
}
__device__ __forceinline__ void finishSM(f32x16& p0, f32x16& p1, float alpha, float& l_reg, bf16x8& pa0, bf16x8& pa1, bf16x8& pa2, bf16x8& pa3) {
#pragma unroll
    for (int r = 0; r < 16; ++r) p1[r] = __builtin_amdgcn_exp2f(p1[r]);
    float ps = 0;
#pragma unroll
    for (int r = 0; r < 16; ++r) ps += p0[r];
#pragma unroll
    for (int r = 0; r < 16; ++r) ps += p1[r];
    { auto rr = __builtin_amdgcn_permlane32_swap(__float_as_uint(ps), __float_as_uint(ps), false, false); ps = __uint_as_float(rr[0]) + __uint_as_float(rr[1]); }
    l_reg = l_reg * alpha + ps;
#define ATT_PK4(P, B_, OUT) do { unsigned a0 = cvtpk(P[B_+0], P[B_+1]), a1 = cvtpk(P[B_+2], P[B_+3]);                          \
        unsigned b0 = cvtpk(P[B_+4], P[B_+5]), b1 = cvtpk(P[B_+6], P[B_+7]);                                             \
        auto r0 = __builtin_amdgcn_permlane32_swap(a0, b0, false, false); auto r1 = __builtin_amdgcn_permlane32_swap(a1, b1, false, false); \
        u32x4 w = {r0[0], r1[0], r0[1], r1[1]}; OUT = __builtin_bit_cast(bf16x8, w); } while (0)
    ATT_PK4(p0, 0, pa0); ATT_PK4(p0, 8, pa1); ATT_PK4(p1, 0, pa2); ATT_PK4(p1, 8, pa3);
#undef ATT_PK4
}
__device__ __forceinline__ void qkt(f32x16& p0, f32x16& p1, ATT_LAS const char* lds, int kbuf, int r32, int hi, const bf16x8* qr) {
    p0 = f32x16{}; p1 = f32x16{};
    ATT_LAS const char* kb[4];
#pragma unroll
    for (int dd = 0; dd < 4; ++dd) kb[dd] = lds + OFF_KN + kbuf * SHM_KN + ATT_KSWZ(r32, (dd * 16 + hi * 8) * 2);
#pragma unroll
    for (int d0 = 0; d0 < 8; ++d0) { ATT_LAS const char* a = kb[d0 & 3] + (d0 >> 2) * 128;
        const bf16x8 b0 = *(ATT_LAS const bf16x8*)a;
        const bf16x8 b1 = *(ATT_LAS const bf16x8*)(a + 32 * 256);
        p0 = __builtin_amdgcn_mfma_f32_32x32x16_bf16(b0, qr[d0], p0, 0, 0, 0);
        p1 = __builtin_amdgcn_mfma_f32_32x32x16_bf16(b1, qr[d0], p1, 0, 0, 0); }
#pragma unroll
    for (int d1 = 0; d1 < 4; ++d1) { ATT_LAS const char* a = lds + OFF_KP + kbuf * SHM_KP + ATT_KPSWZ(r32, 2 * d1 + hi);
        const bf16x8 b0 = *(ATT_LAS const bf16x8*)a;
        const bf16x8 b1 = *(ATT_LAS const bf16x8*)(a + 32 * 128);
        p0 = __builtin_amdgcn_mfma_f32_32x32x16_bf16(b0, qr[8 + d1], p0, 0, 0, 0);
        p1 = __builtin_amdgcn_mfma_f32_32x32x16_bf16(b1, qr[8 + d1], p1, 0, 0, 0); }
}
__device__ __forceinline__ void pv_tile(f32x16* o, int vb0, bf16x8 pa0, bf16x8 pa1, bf16x8 pa2, bf16x8 pa3) {
#define ATT_TRRD(dst, off) asm volatile("ds_read_b64_tr_b16 %0, %1 offset:%2" : "=&v"(dst) : "v"(vb0), "i"(off) : "memory")
#define ATT_PV_RD(S, d0) do { constexpr int b_ = OFF_V + v_rd_off(d0, 0, 0); \
        ATT_TRRD(S##l0, b_); ATT_TRRD(S##h0, b_ + 2048); ATT_TRRD(S##l1, b_ + 4096); ATT_TRRD(S##h1, b_ + 6144); ATT_TRRD(S##l2, b_ + 8192); ATT_TRRD(S##h2, b_ + 10240); ATT_TRRD(S##l3, b_ + 12288); ATT_TRRD(S##h3, b_ + 14336); } while (0)
#define ATT_PV_MM(S, d0) do { \
        o[d0] = __builtin_amdgcn_mfma_f32_32x32x16_bf16(pa0, (bf16x8){S##l0[0], S##l0[1], S##l0[2], S##l0[3], S##h0[0], S##h0[1], S##h0[2], S##h0[3]}, o[d0], 0, 0, 0);   \
        o[d0] = __builtin_amdgcn_mfma_f32_32x32x16_bf16(pa1, (bf16x8){S##l1[0], S##l1[1], S##l1[2], S##l1[3], S##h1[0], S##h1[1], S##h1[2], S##h1[3]}, o[d0], 0, 0, 0);   \
        o[d0] = __builtin_amdgcn_mfma_f32_32x32x16_bf16(pa2, (bf16x8){S##l2[0], S##l2[1], S##l2[2], S##l2[3], S##h2[0], S##h2[1], S##h2[2], S##h2[3]}, o[d0], 0, 0, 0);   \
        o[d0] = __builtin_amdgcn_mfma_f32_32x32x16_bf16(pa3, (bf16x8){S##l3[0], S##l3[1], S##l3[2], S##l3[3], S##h3[0], S##h3[1], S##h3[2], S##h3[3]}, o[d0], 0, 0, 0); } while (0)
#define ATT_LGK(n) do { asm volatile("s_waitcnt lgkmcnt(" #n ")" ::: "memory"); ATT_SBAR(); } while (0)
    s16x4 Al0, Al1, Al2, Al3, Ah0, Ah1, Ah2, Ah3, Bl0, Bl1, Bl2, Bl3, Bh0, Bh1, Bh2, Bh3;
    ATT_PV_RD(A, 0);
    ATT_PV_RD(B, 1); ATT_LGK(8); ATT_PV_MM(A, 0); ATT_SBAR();
    ATT_PV_RD(A, 2); ATT_LGK(8); ATT_PV_MM(B, 1); ATT_SBAR();
    ATT_PV_RD(B, 3); ATT_LGK(8); ATT_PV_MM(A, 2); ATT_SBAR();
    ATT_LGK(0); ATT_PV_MM(B, 3);
#undef ATT_LGK
#undef ATT_PV_MM
#undef ATT_PV_RD
#undef ATT_TRRD
}
__device__ __forceinline__ void attn_unit(int b, int h, int qb, const bf16* __restrict__ Q, const bf16* __restrict__ KN, const bf16* __restrict__ KPE, const bf16* __restrict__ V, bf16* __restrict__ O, ATT_LAS char* lds, int wave_id) {
    unsigned m1_ = ~0u; asm volatile("" : "+s"(m1_)); int tid_ = wave_id * 64 + (int)__builtin_amdgcn_mbcnt_hi(m1_, __builtin_amdgcn_mbcnt_lo(m1_, 0u)); asm volatile("" : "+v"(tid_));
    const int tid = tid_, wid = __builtin_amdgcn_readfirstlane(tid >> 6), lane = tid & 63, r32 = lane & 31, hi = lane >> 5;
    const size_t rowbase = (size_t)b * SEQ; const int q0 = qb * QB, NT = (q0 + QB) / KVBLK;
    const int qlo = q0 + wid * QBLK, qm = qlo + r32 - 4 * hi;
    ATT_LAS float* ws = (ATT_LAS float*)(lds + OFF_WS) + wid * 64; ATT_LAS float* li_l = ws; ATT_LAS float* al_l = ws + 32;
    const int sr = tid >> 4, sc = (tid & 15) * 8, vst0 = v_st(sr, sc), vst1 = v_st(32 + sr, sc), kws = ATT_KSWZ(sr, sc * 2);
    const int pr = tid >> 3, pc = tid & 7, kpw = ATT_KPSWZ(pr, pc);
    const bf16* gK = KN + (rowbase + sr) * KPITCH + h * 128 + sc;
    const bf16* gV = V + (rowbase + sr) * KPITCH + h * 128 + sc;
    const bf16* gP = KPE + (rowbase + pr) * PEPITCH + pc * 8;
    const int vb0 = (int)(uintptr_t)lds + v_rd_base(lane);
    bf16x8 st_k0, st_k1, st_v0, st_v1, st_p;
#define ATT_SLOAD(t) do { const size_t ko_ = (size_t)(t) * KVBLK; st_v0 = *(const bf16x8*)(gV + ko_ * KPITCH); st_v1 = *(const bf16x8*)(gV + (ko_ + 32) * KPITCH); \
        st_k0 = *(const bf16x8*)(gK + ko_ * KPITCH); st_k1 = *(const bf16x8*)(gK + (ko_ + 32) * KPITCH); st_p = *(const bf16x8*)(gP + ko_ * PEPITCH); } while (0)
#define ATT_SWRITE(kbf, vbf) do { *(ATT_LAS bf16x8*)(lds + OFF_V + (vbf) * SHM_V + vst0) = st_v0; *(ATT_LAS bf16x8*)(lds + OFF_V + (vbf) * SHM_V + vst1) = st_v1; \
        *(ATT_LAS bf16x8*)(lds + OFF_KN + (kbf) * SHM_KN + kws) = st_k0; *(ATT_LAS bf16x8*)(lds + OFF_KN + (kbf) * SHM_KN + kws + 32 * 256) = st_k1; \
        *(ATT_LAS bf16x8*)(lds + OFF_KP + (kbf) * SHM_KP + kpw) = st_p; } while (0)
#define ATT_VMW() asm volatile("s_waitcnt vmcnt(0)" ::: "memory")
    bf16x8 qr[12];
    { const bf16* Qw = Q + (rowbase + qlo + r32) * QPITCH + h * QHEAD + hi * 8;
#pragma unroll
      for (int d0 = 0; d0 < 12; ++d0) qr[d0] = *(const bf16x8*)(Qw + d0 * 16); }
    ATT_SLOAD(0); ATT_VMW(); ATT_SWRITE(0, 0); __syncthreads();
    float m_reg = -1e30f, l_reg = 0.f; f32x16 o[4] = {};
#define ATT_RESC(a) do { if (__any((a) < 1.f)) { if (hi == 0) al_l[r32] = (a); asm volatile("s_waitcnt lgkmcnt(0)" ::: "memory");              \
        _Pragma("unroll") for (int d_ = 0; d_ < 4; ++d_) _Pragma("unroll") for (int r = 0; r < 16; ++r) o[d_][r] *= al_l[crow(r, hi)]; } } while (0)
    const bool grpB = wid >= 4;
    bf16x8 pa0 = {}, pa1 = {}, pa2 = {}, pa3 = {};
    bool act_prev = false; int kbuf = 0, vbuf = 0, vprev = 0;
    for (int t = 0; t < NT; ++t) {
        const int vnext = (vbuf == 2) ? 0 : vbuf + 1;
        if (t + 1 < NT) ATT_SLOAD(t + 1);
        ATT_SBAR();
        const int kb_ = t * KVBLK; const bool act = kb_ <= qlo + QBLK - 1;
        if (grpB && act_prev) { pv_tile(o, vb0 + vprev * SHM_V, pa0, pa1, pa2, pa3); ATT_SBAR(); }
        if (act) {
            f32x16 p0, p1; qkt(p0, p1, lds, kbuf, r32, hi, qr);
            if (kb_ + KVBLK - 1 > qlo) mask_tile(p0, p1, qm - kb_);
            float mn, alpha; partialSM(p0, p1, m_reg, mn, alpha);
            ATT_RESC(alpha);
            finishSM(p0, p1, alpha, l_reg, pa0, pa1, pa2, pa3); ATT_SBAR();
            if (!grpB) pv_tile(o, vb0 + vbuf * SHM_V, pa0, pa1, pa2, pa3); }
        ATT_SBAR();
        if (t + 1 < NT) { ATT_VMW(); ATT_SWRITE(kbuf ^ 1, vnext); }
        __syncthreads();
        act_prev = act; vprev = vbuf; vbuf = vnext; kbuf ^= 1;
    }
    if (grpB && act_prev) pv_tile(o, vb0 + vprev * SHM_V, pa0, pa1, pa2, pa3);
    if (hi == 0) li_l[r32] = l_reg; asm volatile("s_waitcnt lgkmcnt(0)" ::: "memory");
    float rli[16];
#pragma unroll
    for (int r = 0; r < 16; ++r) rli[r] = __builtin_amdgcn_rcpf(li_l[crow(r, hi)]);
    bf16* Ow = O + (rowbase + qlo) * OPITCH + h * 128;
#pragma unroll
    for (int r = 0; r < 16; ++r) { const int orow = crow(r, hi);
#pragma unroll
        for (int d0 = 0; d0 < 4; ++d0) { const float v = o[d0][r] * rli[r]; const float vn = __shfl_xor(v, 1);
            if ((r32 & 1) == 0) *(unsigned*)(Ow + (size_t)orow * OPITCH + d0 * 32 + r32) = cvtpk(v, vn); } }
    __syncthreads();
#undef ATT_SLOAD
#undef ATT_SWRITE
#undef ATT_VMW
#undef ATT_RESC
}
}
#ifndef MK_N_LAUNCHES
#define MK_N_LAUNCHES 1
#endif
constexpr int NWAVES = 8;
constexpr int NB = 8, SEQ = 2048, M = NB * SEQ, D = 2048, DFF = 5632, LW = 1024, NHD = 16, KVR = 512, INW = 14912, INWP = 15104, MODW = 9 * 2048, NL = 2;
constexpr float EPS = 1e-6f;
constexpr int PPL = 9, N_PHASES = 3 + PPL * NL;
constexpr int CBW = 15104;
constexpr size_t MiB = 1u << 20;
constexpr size_t WS_CTL = 0, CTL_ZERO_BYTES = 4 * MiB;
constexpr size_t WS_SSQ = 12 * MiB + 768 * 1024;
constexpr size_t WS_SSQN = 12 * MiB;
constexpr size_t WS_WSC = 32768;
constexpr size_t WS_CB = 1 * MiB;
constexpr size_t WS_MOD = 4 * MiB;
constexpr size_t WS_COS = 6 * MiB, WS_SIN = 8 * MiB;
constexpr size_t WS_AGG = 10 * MiB;
constexpr size_t WS_WAX = 11 * MiB;
constexpr size_t WS_W = 16 * MiB, W_LAYER = 219 * MiB;
#ifndef FP8_Q
#define FP8_Q 1
#endif
#ifndef FP8_ALL
#define FP8_ALL 0
#endif
#ifndef FP8_DN
#define FP8_DN 14
#endif
constexpr bool fp8_dn(int l, int f) { return ((FP8_DN >> (2 * l + f)) & 1) != 0; }
#ifndef FP8_G1
#define FP8_G1 3
#endif
#ifndef FP8_G4
#define FP8_G4 3
#endif
#ifndef G1_BF16
#define G1_BF16 0
#endif
constexpr int WIN_QF8 = FP8_Q, WINB_REAL = FP8_ALL ? 0 : (WIN_QF8 ? 5696 : 8768), WINB_PADEND = FP8_ALL ? 0 : (WIN_QF8 ? 5888 : 8960), WINB_ROWS = G1_BF16 ? 7936 : WINB_PADEND, WINF_ROWS = FP8_ALL ? 15104 : (WIN_QF8 ? (G1_BF16 ? 7168 : 9216) : 6144);
static_assert(!G1_BF16 || (FP8_Q && !FP8_ALL), "G1_BF16 needs the q + gates fp8 split");
constexpr size_t WO_WIN8 = FP8_ALL ? 132 * MiB : 168 * MiB;
constexpr size_t WO_W13 = 0, WO_W2 = 88 * MiB, WO_WIN = 132 * MiB, WO_WCAT = 191 * MiB  , WO_LRUO = WO_WCAT, WO_SCO = WO_WCAT + 1024 * 2, WO_MLAO = WO_WCAT + 2048 * 2, WO_UKV = 207 * MiB, WO_WO = 211 * MiB;
constexpr int YP = 4096;
constexpr size_t WS_HN = 456 * MiB;
constexpr size_t WS_LRUX = 520 * MiB, WS_LRUG = 552 * MiB, WS_SCB = 584 * MiB, WS_SCC = 616 * MiB, WS_SCX = 648 * MiB, WS_Q = 680 * MiB, WS_KVLAT = 776 * MiB, WS_GATES = 792 * MiB, WS_KPE = 984 * MiB;
constexpr size_t WS_ACT = 520 * MiB;
constexpr size_t WS_KN = 986 * MiB, WS_V = 1050 * MiB;
constexpr size_t WS_R = 456 * MiB, WS_GX = 488 * MiB;
constexpr size_t WS_YCAT = 1114 * MiB, WS_YLRU = WS_YCAT, WS_YSC = WS_YCAT + 1024 * 2, WS_ATT = WS_YCAT + 2048 * 2;
constexpr size_t WS_MERGED = 520 * MiB;
constexpr size_t WS_XH = 1242 * MiB;
constexpr size_t WS_A8 = 1306 * MiB;
constexpr size_t WS_END = 1338 * MiB;
static_assert(WS_W + NL * W_LAYER <= WS_HN && WS_ACT + (size_t)M * DFF * 2 <= WS_KN && WS_KPE + (size_t)M * 64 * 2 <= WS_KN && WS_YCAT + (size_t)M * YP * 2 <= WS_XH && WS_GX + (size_t)M * LW * 2 <= WS_LRUX && WS_XH + (size_t)M * D * 2 <= WS_A8 && WS_A8 + (size_t)M * D <= WS_END, "d_ws map");
static_assert(WS_SSQN + (size_t)NL * 3 * M * 8 <= WS_SSQ && WS_SSQ + (size_t)NL * M * 8 <= WS_W && WS_WAX + (size_t)NL * 2 * 8 * 16384 * 2 <= WS_SSQN && WS_CB + (size_t)NL * 3 * NB * CBW * 4 <= CTL_ZERO_BYTES && WS_MOD + (size_t)NL * NB * MODW * 4 <= WS_COS, "zeroed region map");
constexpr int CW_TMO = 0, CW_CODE = 1, CW_BAR = 4096;
constexpr int RING_OFF = 0, RING_BYTES = 131072;
constexpr int LDSCTL_OFF = RING_BYTES, MISC_OFF = LDSCTL_OFF + 320;
constexpr int LDS_BYTES = 147456;
#define GAS __attribute__((address_space(1)))
#define LAS __attribute__((address_space(3)))
typedef unsigned short bf16;
typedef unsigned v4u __attribute__((ext_vector_type(4)));
typedef unsigned v2u __attribute__((ext_vector_type(2)));
typedef float f32x4 __attribute__((ext_vector_type(4)));
typedef short bf16x8 __attribute__((ext_vector_type(8)));
typedef GAS unsigned gu32;
#define RLX_AGENT __ATOMIC_RELAXED, __HIP_MEMORY_SCOPE_AGENT
#define LDS_WAIT() asm volatile("s_waitcnt lgkmcnt(0)" ::: "memory")
#define VM_WAIT() asm volatile("s_waitcnt vmcnt(0)" ::: "memory")
__device__ __forceinline__ unsigned f2bf(float f) { unsigned u = __builtin_bit_cast(unsigned, f); return (u + 0x7fffu + ((u >> 16) & 1u)) >> 16; }
__device__ __forceinline__ unsigned pk2(float lo, float hi) { return f2bf(lo) | (f2bf(hi) << 16); }
__device__ __forceinline__ float bf2f(unsigned short b) { return __uint_as_float((unsigned)b << 16); }
__device__ __forceinline__ void unpack8(const v4u w, float (&f)[8]) {
    f[0] = __uint_as_float(w.x << 16); f[1] = __uint_as_float(w.x & 0xffff0000u); f[2] = __uint_as_float(w.y << 16); f[3] = __uint_as_float(w.y & 0xffff0000u);
    f[4] = __uint_as_float(w.z << 16); f[5] = __uint_as_float(w.z & 0xffff0000u); f[6] = __uint_as_float(w.w << 16); f[7] = __uint_as_float(w.w & 0xffff0000u); }
__device__ __forceinline__ v4u pack8(const float (&f)[8]) { v4u w; w.x = pk2(f[0], f[1]); w.y = pk2(f[2], f[3]); w.z = pk2(f[4], f[5]); w.w = pk2(f[6], f[7]); return w; }

#define XB_TMO      128
#define XB_XCNT(j)  (256  + 64 * (j))
#define XB_XSUB(j)  (1280 + 64 * (j))
#define XB_XGEN(j)  (2304 + 64 * (j))
#define XB_TOP      3328
#define XB_TOPGEN   3392
#define XCD_BAR_WORDS 3456
#define XB_SPIN_CAP (1u << 18)

__device__ __forceinline__ unsigned xb_ld(unsigned* p)              { return __hip_atomic_load(p, __ATOMIC_RELAXED, __HIP_MEMORY_SCOPE_AGENT); }
__device__ __forceinline__ unsigned xb_add(unsigned* p, unsigned v) { return __hip_atomic_fetch_add(p, v, __ATOMIC_RELAXED, __HIP_MEMORY_SCOPE_AGENT); }
__device__ __forceinline__ unsigned xb_xcc_id() { return (unsigned)__builtin_amdgcn_s_getreg((3 << 11) | 20) & 0xFu; }
#define XB_SPIN(cond, bar) do { unsigned _sp = 0; while (cond) { __builtin_amdgcn_s_sleep(1); \
    if ((++_sp & 255u) == 0u) { if (xb_ld(&(bar)[XB_TMO])) break; if (_sp > XB_SPIN_CAP) { atomicAdd(&(bar)[XB_TMO], 1u); break; } } } } while (0)

struct XcdBarrier {
    unsigned* bar; unsigned x;
    volatile LAS unsigned* st;
};

__device__ __forceinline__ XcdBarrier xcd_barrier_post(unsigned* bar, volatile LAS unsigned* st) {
    XcdBarrier b; b.bar = bar; b.x = xb_xcc_id(); b.st = st;
    if (threadIdx.x == 0) (void)xb_add(&bar[XB_XCNT(b.x)], 1u);
    return b;
}
__device__ __forceinline__ void xcd_barrier_complete(unsigned* bar, unsigned x, unsigned& nloc, unsigned& nx) {
    const unsigned G = gridDim.x * gridDim.y * gridDim.z;
    unsigned sum, cnt, mine, sp = 0u;
    for (;;) {
        sum = 0u; cnt = 0u; mine = 0u;
#pragma unroll
        for (unsigned j = 0; j < 16; ++j) { const unsigned c = xb_ld(&bar[XB_XCNT(j)]); sum += c; cnt += (c > 0u) ? 1u : 0u; mine = (j == x) ? c : mine; }
        if (sum == G) break;
        __builtin_amdgcn_s_sleep(1);
        if ((++sp & 255u) == 0u) { if (xb_ld(&bar[XB_TMO])) break; if (sp > XB_SPIN_CAP) { atomicAdd(&bar[XB_TMO], 1u); break; } }
    }
    nloc = mine > 0u ? mine : 1u; nx = cnt > 0u ? cnt : 1u;
}

__device__ __forceinline__ void xcd_barrier(const XcdBarrier& b) {
    asm volatile("s_waitcnt vmcnt(0)" ::: "memory");
    __syncthreads();
    if (threadIdx.x == 0) {
        unsigned* bar = b.bar;
        __builtin_amdgcn_s_waitcnt(0);
        unsigned nloc = b.st[0], nx = b.st[1];
        if (nloc == 0u) { xcd_barrier_complete(bar, b.x, nloc, nx); b.st[0] = nloc; b.st[1] = nx; }
        const unsigned old = xb_add(&bar[XB_XSUB(b.x)], 1u);
        const unsigned gen = old / nloc;
        if (old + 1u == (gen + 1u) * nloc) {
            __builtin_amdgcn_fence(__ATOMIC_RELEASE, "agent");
            asm volatile("s_waitcnt vmcnt(0)" ::: "memory");
            const unsigned og = xb_add(&bar[XB_TOP], 1u);
            const unsigned tg = og / nx;
            if (og + 1u == (tg + 1u) * nx) xb_add(&bar[XB_TOPGEN], 1u);
            else XB_SPIN(xb_ld(&bar[XB_TOPGEN]) == tg, bar);
            __builtin_amdgcn_fence(__ATOMIC_ACQUIRE, "agent");
            xb_add(&bar[XB_XGEN(b.x)], 1u);
            asm volatile("s_waitcnt vmcnt(0)" ::: "memory");
        } else {
            XB_SPIN(xb_ld(&bar[XB_XGEN(b.x)]) == gen, bar);
            __builtin_amdgcn_fence(__ATOMIC_ACQUIRE, "agent");
            asm volatile("s_waitcnt vmcnt(0)" ::: "memory");
        }
    }
    __syncthreads();
}
struct Frame {
    LAS unsigned char* lds; volatile LAS unsigned* MISC; gu32* ctl;
    int tid, lane, wave, vcu, G;
    GAS float* out; GAS unsigned char* ws;
};
typedef __attribute__((address_space(4))) const char* kaddr_t;
__device__ __forceinline__ const float* in_ptr(int i) { kaddr_t ka = (kaddr_t)__builtin_amdgcn_kernarg_segment_ptr(); asm volatile("" : "+s"(ka)); typedef GAS const float* cfp_t; typedef __attribute__((address_space(4))) const cfp_t* kpp_t; return (const float*)(*(kpp_t)(ka + 8 * i)); }
__device__ __forceinline__ GAS unsigned char* karg_ptr(int i) { kaddr_t ka = (kaddr_t)__builtin_amdgcn_kernarg_segment_ptr(); asm volatile("" : "+s"(ka)); typedef GAS unsigned char* gp_t; typedef __attribute__((address_space(4))) const gp_t* kpp_t; return *(kpp_t)(ka + 8 * i); }
enum { I_X = 0, I_C = 1, I_POS = 2, I_ADAW = 3, I_ADAB = 4, I_NORMG = 5, I_W13 = 6, I_W2 = 7, I_WIN = 8, I_LCW = 9, I_LCB = 10, I_LWA = 11, I_LBA = 12, I_LWX = 13, I_LBX = 14, I_LAM = 15,
       I_LOUT = 16, I_SCW = 17, I_SCOUT = 18, I_KVG = 19, I_UKV = 20, I_MLAO = 21, I_WO = 22, I_FING = 23 };
__device__ __forceinline__ float wave_sum(float v) {
#pragma unroll
    for (int o = 1; o < 64; o <<= 1) v += __shfl_xor(v, o);
    return v;
}
template <bool CB, bool F8 = false>
__device__ __forceinline__ void transpose_item(const float* W, int K, int N, bf16* WT, int dst_row0, int k0, int n0, const float* ks, LAS float* scr, int lane, const float* shp, float (&cbacc)[8], bool tiled = false, int ldk = 0) {
    float v[32];
    const GAS float* wp = (const GAS float*)W + (size_t)(k0 + (lane >> 5)) * N + n0 + (lane & 31);
#pragma unroll
    for (int i = 0; i < 32; ++i) { v[i] = *wp; wp += 2 * (size_t)N; asm volatile("" : "+v"(wp)); }
    if (CB) {
        LAS float* sht = scr + 64 * 33;
        float sv[8];
#pragma unroll
        for (int b = 0; b < 8; ++b) sv[b] = ((const GAS float*)shp)[(size_t)b * MODW + k0 + lane];
#pragma unroll
        for (int b = 0; b < 8; ++b) sht[(b * 2 + (lane & 1)) * 32 + (lane >> 1)] = sv[b];
        LDS_WAIT(); asm volatile("" ::: "memory");
#pragma unroll
        for (int b = 0; b < 8; ++b) { float a = 0.f;
#pragma unroll
            for (int i = 0; i < 32; ++i) a += sht[(b * 2 + (lane >> 5)) * 32 + i] * v[i];
            cbacc[b] += a; asm volatile("" ::: "memory"); }
    }
    if (ks) {
#pragma unroll
        for (int i = 0; i < 32; ++i) v[i] *= ks[k0 + 2 * i + (lane >> 5)]; }
#pragma unroll
    for (int i = 0; i < 32; ++i) scr[(2 * i + (lane >> 5)) * 33 + (lane & 31)] = v[i];
    LDS_WAIT(); asm volatile("" ::: "memory");
    const int c = lane & 7;
#pragma unroll
    for (int j = 0; j < 4; ++j) { const int n = (lane >> 3) + 8 * j; const LAS float* s = scr + (8 * c) * 33 + n;
        v4u o; o.x = pk2(s[0 * 33], s[1 * 33]); o.y = pk2(s[2 * 33], s[3 * 33]); o.z = pk2(s[4 * 33], s[5 * 33]); o.w = pk2(s[6 * 33], s[7 * 33]);
        const int rr = dst_row0 + n;
        if constexpr (F8) { unsigned w0 = 0, w1 = 0;
            w0 = __builtin_amdgcn_cvt_pk_fp8_f32(pg8::sat8(s[0 * 33] * 64.f), pg8::sat8(s[1 * 33] * 64.f), w0, false); w0 = __builtin_amdgcn_cvt_pk_fp8_f32(pg8::sat8(s[2 * 33] * 64.f), pg8::sat8(s[3 * 33] * 64.f), w0, true);
            w1 = __builtin_amdgcn_cvt_pk_fp8_f32(pg8::sat8(s[4 * 33] * 64.f), pg8::sat8(s[5 * 33] * 64.f), w1, false); w1 = __builtin_amdgcn_cvt_pk_fp8_f32(pg8::sat8(s[6 * 33] * 64.f), pg8::sat8(s[7 * 33] * 64.f), w1, true);
            *(GAS v2u*)((GAS unsigned char*)WT + (size_t)rr * (ldk ? ldk : K) + k0 + 8 * c) = (v2u){w0, w1}; } else {
        const size_t eo = tiled ? ((size_t)(rr >> 8) * (K >> 6) + (k0 >> 6)) * 16384 + (size_t)(rr & 255) * 64 + 8 * c : (size_t)rr * (ldk ? ldk : K) + k0 + 8 * c;
        *(GAS v4u*)(WT + eo) = o; } }
    LDS_WAIT(); asm volatile("" ::: "memory");
}
typedef float p0_f32x16 __attribute__((ext_vector_type(16)));
template <bool F8>
__device__ __forceinline__ void transpose_item_cb(const float* W, int K, int N, bf16* WT, int dst_row0, int k0, int n0, LAS unsigned* scr, int lane, const float* shp, p0_f32x16& acc, float isw = 0.f) {
    const int h = lane >> 5, n = lane & 31;
    float v[32];
    const GAS float* wp = (const GAS float*)W + (size_t)(k0 + 32 * h) * N + n0 + n;
#pragma unroll
    for (int i = 0; i < 32; ++i) { v[i] = *wp; wp += (size_t)N; asm volatile("" : "+v"(wp)); }
    const GAS float* sp = (const GAS float*)shp + (size_t)(n & 7) * MODW + k0 + 32 * h;
    f32x4 sa[8];
#pragma unroll
    for (int j = 0; j < 8; ++j) sa[j] = *(const GAS f32x4*)(sp + 4 * j);
    const float msk = n < 8 ? 1.0f : 0.0f;
    unsigned w[16];
#pragma unroll
    for (int t = 0; t < 16; ++t) w[t] = pg8::cvt_pk_bf16(v[2 * t], v[2 * t + 1]);
#pragma unroll
    for (int j = 0; j < 4; ++j) { const f32x4 s0 = sa[2 * j] * msk, s1 = sa[2 * j + 1] * msk;
        v4u a; a.x = pg8::cvt_pk_bf16(s0[0], s0[1]); a.y = pg8::cvt_pk_bf16(s0[2], s0[3]); a.z = pg8::cvt_pk_bf16(s1[0], s1[1]); a.w = pg8::cvt_pk_bf16(s1[2], s1[3]);
        v4u b; b.x = w[4 * j]; b.y = w[4 * j + 1]; b.z = w[4 * j + 2]; b.w = w[4 * j + 3];
        acc = __builtin_amdgcn_mfma_f32_32x32x16_bf16(__builtin_bit_cast(bf16x8, a), __builtin_bit_cast(bf16x8, b), acc, 0, 0, 0); }
    if constexpr (F8) {
#pragma unroll
        for (int t = 0; t < 8; ++t) scr[(8 * h + t) * 33 + n] = pg8::pk4_i8(v[4 * t] * isw, v[4 * t + 1] * isw, v[4 * t + 2] * isw, v[4 * t + 3] * isw);
        LDS_WAIT(); asm volatile("" ::: "memory");
        const int c = lane & 3;
#pragma unroll
        for (int jj = 0; jj < 2; ++jj) { const int nn = (lane >> 2) + 16 * jj; const LAS unsigned* s = scr + (4 * c) * 33 + nn;
            v4u o; o.x = s[0]; o.y = s[33]; o.z = s[66]; o.w = s[99];
            *(GAS v4u*)((GAS unsigned char*)WT + (size_t)(dst_row0 + nn) * K + k0 + 16 * c) = o; }
    } else {
#pragma unroll
        for (int t = 0; t < 16; ++t) scr[(16 * h + t) * 33 + n] = w[t];
        LDS_WAIT(); asm volatile("" ::: "memory");
        const int c = lane & 7;
#pragma unroll
        for (int jj = 0; jj < 4; ++jj) { const int nn = (lane >> 3) + 8 * jj; const LAS unsigned* s = scr + (4 * c) * 33 + nn;
            v4u o; o.x = s[0]; o.y = s[33]; o.z = s[66]; o.w = s[99];
            *(GAS v4u*)(WT + (size_t)(dst_row0 + nn) * K + k0 + 8 * c) = o; }
    }
    LDS_WAIT(); asm volatile("" ::: "memory");
}
#ifndef W2_TILED
#define W2_TILED false
#endif
constexpr int TI_W13 = (D / 64) * (2 * DFF / 32), TI_W2 = (DFF / 64) * (D / 32), TI_WIN = (D / 64) * (INW / 32), TI_LRUO = (LW / 64) * (D / 32), TI_UKV = (KVR / 64) * (4096 / 32), TI_DD = (D / 64) * (D / 32), TI_WAX = 8 * 2 * 4;
constexpr int TH_W13 = TI_W13 / 4, TH_WIN = TI_WIN / 4, TH_LAYER = 2 * TH_W13 + TH_WIN;
constexpr int TL_LAYER = 2 * TI_W2 + 2 * TI_LRUO + TI_UKV + 2 * TI_DD + 2 * TI_WAX, TU_LAYER = TH_LAYER + TL_LAYER;
__device__ __forceinline__ void p0_weights(const Frame& F, int parts, bool dummy_cb = false) {
    LAS float* scr = (LAS float*)(F.lds + RING_OFF + F.wave * 16384);
    const int gw = F.vcu * NWAVES + F.wave, NGW = F.G * NWAVES;
    if (parts & 1)
    for (int it = gw; it < NL * TH_LAYER; it += NGW) {
        const int l = it / TH_LAYER; int r = it - l * TH_LAYER;
        GAS unsigned char* wl = F.ws + WS_W + (size_t)l * W_LAYER;
        const float* W; bf16* WT; int N, mode, site;
        if (r < 2 * TH_W13) { const int f = r / TH_W13; r -= f * TH_W13; W = in_ptr(I_W13) + (size_t)(l * 2 + f) * D * 2 * DFF; N = 2 * DFF; WT = (bf16*)(wl + WO_W13 + (size_t)f * 44 * MiB); mode = 1; site = f ? 2 : 0; }
        else { r -= 2 * TH_W13; W = in_ptr(I_WIN) + (size_t)l * D * INW; N = INW; WT = (bf16*)(wl + WO_WIN); mode = 2; site = 1; }
        bool f8 = (mode == 1) && ((site == 2 && ((FP8_G4 >> l) & 1)) || (site == 0 && ((FP8_G1 >> l) & 1))); int cbi;
        const int nblk = N / 32, kq = r / nblk, nb = r - kq * nblk, n0 = 32 * nb; int dst = n0;
        if (mode == 1) { const int bj = n0 >= DFF ? 1 : 0, j = n0 - bj * DFF; dst = 256 * (j >> 7) + 128 * bj + (j & 127); }
        else {
            if (FP8_ALL) { dst = n0 < 8704 ? n0 : (n0 < 8768 ? 14848 + (n0 - 8704) : 8704 + (n0 - 8768)); f8 = true; }
            else if (WIN_QF8) { if (n0 < 5120) dst = n0; else if (n0 < 8192) { dst = n0 - 5120; f8 = true; } else if (n0 < 8704) dst = 5120 + (n0 - 8192); else if (n0 < 8768) dst = 5632 + (n0 - 8704); else if (G1_BF16 && n0 >= 8768 + 2048 && n0 < 8768 + 4096) dst = WINB_PADEND + (n0 - 8768 - 2048); else if (G1_BF16 && n0 >= 8768 + 4096) { dst = 5120 + (n0 - 8768 - 4096); f8 = true; } else { dst = 3072 + (n0 - 8768); f8 = true; } }
            else { if (n0 < 8768) dst = n0; else { dst = n0 - 8768; f8 = true; } }
            if (f8) WT = (bf16*)(wl + WO_WIN8); }
        cbi = (mode == 2 && f8) ? WINB_ROWS + dst : dst;
        const float* shp = (const float*)(F.ws + WS_MOD) + (size_t)l * NB * MODW + (site == 0 ? 0 : site == 1 ? 6144 : 12288);
        p0_f32x16 cbacc;
#pragma unroll
        for (int r4 = 0; r4 < 16; ++r4) cbacc[r4] = 0.f;
        if (f8) {
#pragma unroll 1
            for (int j = 0; j < 4; ++j) transpose_item_cb<true>(W, D, N, WT, dst, 64 * (4 * kq + j), n0, (LAS unsigned*)scr, F.lane, shp, cbacc, ((const GAS float*)(F.ws + WS_WSC))[(l * 2 + (mode == 1 ? 1 : 0)) * 2 + 1]);
        } else {
#pragma unroll 1
            for (int j = 0; j < 4; ++j) transpose_item_cb<false>(W, D, N, WT, dst, 64 * (4 * kq + j), n0, (LAS unsigned*)scr, F.lane, shp, cbacc); }
        int* cbp = (int*)(F.ws + (dummy_cb ? WS_KN : WS_CB)) + (size_t)((l * 3 + site) * NB + 4 * (F.lane >> 5)) * CBW + cbi + (F.lane & 31);
#pragma unroll
        for (int r4 = 0; r4 < 4; ++r4) atomicAdd(cbp + (size_t)r4 * CBW, (int)__builtin_rintf(cbacc[r4] * pg8::CB_ENC));
    }
    if (parts & 2)
    for (int it = gw; it < NL * TL_LAYER; it += NGW) {
        const int l = it / TL_LAYER; int r = it - l * TL_LAYER;
        GAS unsigned char* wl = F.ws + WS_W + (size_t)l * W_LAYER;
        const float* W; bf16* WT; const float* ks = nullptr; int K, N, ldk = 0; float dummy[8]; bool tiled = false;
        bool f8w = false;
        if (r < 2 * TI_W2) { tiled = W2_TILED; const int f = r / TI_W2; r -= f * TI_W2; W = in_ptr(I_W2) + (size_t)(l * 2 + f) * DFF * D; K = DFF; N = D; WT = (bf16*)(wl + WO_W2 + (size_t)f * 22 * MiB); f8w = ((FP8_DN >> (2 * l + f)) & 1) != 0; }
        else if ((r -= 2 * TI_W2) < TI_LRUO) { W = in_ptr(I_LOUT) + (size_t)l * LW * D; K = LW; N = D; WT = (bf16*)(wl + WO_LRUO); ldk = YP; }
        else if ((r -= TI_LRUO) < TI_LRUO) { W = in_ptr(I_SCOUT) + (size_t)l * LW * D; K = LW; N = D; WT = (bf16*)(wl + WO_SCO); ldk = YP; }
        else if ((r -= TI_LRUO) < TI_UKV) { W = in_ptr(I_UKV) + (size_t)l * KVR * 4096; K = KVR; N = 4096; WT = (bf16*)(wl + WO_UKV); ks = in_ptr(I_KVG) + l * KVR; }
        else if ((r -= TI_UKV) < TI_DD) { W = in_ptr(I_MLAO) + (size_t)l * D * D; K = D; N = D; WT = (bf16*)(wl + WO_MLAO); ldk = YP; }
        else if ((r -= TI_DD) < TI_DD) { W = in_ptr(I_WO) + (size_t)l * D * D; K = D; N = D; WT = (bf16*)(wl + WO_WO); }
        else { r -= TI_DD; const int which = r / TI_WAX; r -= which * TI_WAX; const int g = r >> 3; r &= 7;
               W = in_ptr(which ? I_LWX : I_LWA) + ((size_t)l * 8 + g) * 16384; K = 128; N = 128; WT = (bf16*)(F.ws + WS_WAX) + ((size_t)(l * 2 + which) * 8 + g) * 16384; }
        const int nblk = N / 32, kb = r / nblk, nb = r - kb * nblk, n0 = 32 * nb;
        if (FP8_DN != 0 && f8w) transpose_item<false, true>(W, K, N, WT, n0, 64 * kb, n0, nullptr, scr, F.lane, nullptr, dummy);
        else transpose_item<false>(W, K, N, WT, n0, 64 * kb, n0, ks, scr, F.lane, nullptr, dummy, tiled, ldk);
    }
    if (parts & 2) { const int gt = (F.vcu * NWAVES + F.wave) * 64 + F.lane, NT = F.G * NWAVES * 64; constexpr int per = FP8_ALL ? 192 * D / 16 : (WINB_PADEND - WINB_REAL) * D * 2 / 16; constexpr size_t pbase = FP8_ALL ? WO_WIN8 + (size_t)14912 * D : WO_WIN + (size_t)WINB_REAL * D * 2;
      for (int i = gt; i < NL * per; i += NT) { const int l = i / per, j = i - l * per; *(GAS v4u*)(F.ws + WS_W + (size_t)l * W_LAYER + pbase + (size_t)j * 16) = (v4u){0u, 0u, 0u, 0u}; } }
    if (parts & 2) { const int gt = (F.vcu * NWAVES + F.wave) * 64 + F.lane, NT = F.G * NWAVES * 64; const int* pos = (const int*)in_ptr(I_POS); float* COS = (float*)(F.ws + WS_COS); float* SIN = (float*)(F.ws + WS_SIN);
      for (int i = gt; i < M * 32; i += NT) { const int row = i >> 5, j = i & 31; const float inv = __builtin_amdgcn_exp2f(-(float)j * (13.287712379549449f / 32.0f)); const float ang = (float)pos[row] * inv;
          const double t = (double)ang * 0.15915494309189535; const float fr = (float)(t - __builtin_rint(t)); COS[i] = __builtin_amdgcn_cosf(fr); SIN[i] = __builtin_amdgcn_sinf(fr); } }
}
__device__ __forceinline__ void p0_wscale(const Frame& F) {
    if ((int)blockIdx.x < NL * 2 && F.wave == 0) { const int l = (int)blockIdx.x >> 1, which = (int)blockIdx.x & 1;
        const float* W = which ? in_ptr(I_W13) + (size_t)(l * 2 + 1) * D * 2 * DFF : in_ptr(I_WIN) + (size_t)l * D * INW;
        float s = 0.f;
#pragma unroll 8
        for (int i = 0; i < 64; ++i) { const float w = W[i * 64 + F.lane]; s += w * w; }
        s = wave_sum(s);
        if (F.lane == 0) { const float sw = 4.0f * sqrtf(s * (1.0f / 4096.0f) + 1e-30f) * (1.0f / 127.0f); GAS float* o = (GAS float*)(F.ws + WS_WSC) + ((size_t)l * 2 + which) * 2; o[0] = sw; o[1] = 1.0f / sw; } }
}
__device__ __forceinline__ void p0_mod(const Frame& F) {
    LAS float* sc = (LAS float*)(F.lds + RING_OFF); LAS float* red = (LAS float*)(F.lds + RING_OFF + 65536);
    for (int i = F.tid; i < NB * D; i += NWAVES * 64) { const float c = in_ptr(I_C)[i]; sc[i] = c / (1.0f + __expf(-c)); }
    __syncthreads();
    float* MOD = (float*)(F.ws + WS_MOD);
    for (int task = blockIdx.x; task < NL * (MODW / 64); task += F.G) {
        const int l = task / (MODW / 64), cg = task - l * (MODW / 64);
        const float* Wp = in_ptr(I_ADAW) + ((size_t)l * D + 256 * F.wave) * MODW + 64 * cg + F.lane;
        float acc[8];
#pragma unroll
        for (int b = 0; b < 8; ++b) acc[b] = 0.f;
#pragma unroll 4
        for (int k4 = 0; k4 < 256; k4 += 4) {
            const float w0 = Wp[(size_t)(k4 + 0) * MODW], w1 = Wp[(size_t)(k4 + 1) * MODW], w2 = Wp[(size_t)(k4 + 2) * MODW], w3 = Wp[(size_t)(k4 + 3) * MODW];
#pragma unroll
            for (int b = 0; b < 8; ++b) { const f32x4 s4 = *(const LAS f32x4*)(sc + b * D + 256 * F.wave + k4); acc[b] += (s4[0] * w0 + s4[1] * w1) + (s4[2] * w2 + s4[3] * w3); }
        }
#pragma unroll
        for (int b = 0; b < 8; ++b) red[(F.wave * 8 + b) * 64 + F.lane] = acc[b];
        __syncthreads();
        { const int b = F.wave; float s = 0.f;
#pragma unroll
          for (int w = 0; w < 8; ++w) s += red[(w * 8 + b) * 64 + F.lane];
          MOD[((size_t)l * NB + b) * MODW + 64 * cg + F.lane] = s + in_ptr(I_ADAB)[(size_t)l * MODW + 64 * cg + F.lane]; }
        __syncthreads();
    }
}
__device__ __forceinline__ unsigned pk2h(float lo, float hi) { return pg8::pk2_f16(lo, hi); }
__device__ __forceinline__ void operand0_phase(const Frame& F, const float* xin, const float* g, const float* scale, bf16* out, pg8::ssq_t* ssq, bf16* xh, unsigned char* a8) {
    const int gw = F.vcu * NWAVES + F.wave, NGW = F.G * NWAVES, rpw = (M + NGW - 1) / NGW;
    const int r0 = gw * rpw, r1 = (r0 + rpw < M) ? r0 + rpw : M;
    int curb = -1; f32x4 gp[8];
    for (int row = r0; row < r1; ++row) {
        const int b = row >> 11;
        if (b != curb) { curb = b;
#pragma unroll
            for (int j = 0; j < 8; ++j) { const f32x4 g4 = ((const f32x4*)g)[F.lane + 64 * j]; const f32x4 s4 = ((const f32x4*)(scale + (size_t)b * MODW))[F.lane + 64 * j]; gp[j] = g4 * (s4 + 1.0f); } }
        const f32x4* xr = (const f32x4*)(xin + (size_t)row * D) + F.lane;
        f32x4 v[8]; float ss = 0.f;
#pragma unroll
        for (int j = 0; j < 8; ++j) { v[j] = xr[64 * j]; ss += (v[j][0] * v[j][0] + v[j][1] * v[j][1]) + (v[j][2] * v[j][2] + v[j][3] * v[j][3]); }
        ss = wave_sum(ss); if (F.lane == 0) ssq[row] = pg8::ssq_enc(ss);
        const float qs = pg8::a8_inv(pg8::ssq_enc(ss));
        unsigned long long* o8 = (unsigned long long*)(out + (size_t)row * D) + F.lane; unsigned long long* h8 = (unsigned long long*)(xh + (size_t)row * D) + F.lane;
#pragma unroll
        for (int j = 0; j < 8; ++j) { const f32x4 o = v[j] * gp[j]; if (out) o8[64 * j] = (unsigned long long)pk2(o[0], o[1]) | ((unsigned long long)pk2(o[2], o[3]) << 32);
            h8[64 * j] = (unsigned long long)pk2h(v[j][0], v[j][1]) | ((unsigned long long)pk2h(v[j][2], v[j][3]) << 32);
            if (a8) ((GAS unsigned*)(a8 + (size_t)row * D))[F.lane + 64 * j] = pg8::pk4_i8(o[0] * qs, o[1] * qs, o[2] * qs, o[3] * qs); }
    }
}
__device__ __forceinline__ void final_norm_phase(const Frame& F, const bf16* xh, float* out, const float* g) {
    const int gw = F.vcu * NWAVES + F.wave, NGW = F.G * NWAVES;
    f32x4 g4[8];
#pragma unroll
    for (int j = 0; j < 8; ++j) g4[j] = ((const f32x4*)g)[F.lane + 64 * j];
    for (int row = gw; row < M; row += NGW) {
        const unsigned long long* xr = (const unsigned long long*)(xh + (size_t)row * D) + F.lane; f32x4* orow = (f32x4*)(out + (size_t)row * D) + F.lane;
        f32x4 v[8]; float ss = 0.f;
#pragma unroll
        for (int j = 0; j < 8; ++j) { const unsigned long long hv = xr[64 * j]; const unsigned w0 = (unsigned)hv, w1 = (unsigned)(hv >> 32); v[j] = (f32x4){pg8::h_lo(w0), pg8::h_hi(w0), pg8::h_lo(w1), pg8::h_hi(w1)};
            ss += (v[j][0] * v[j][0] + v[j][1] * v[j][1]) + (v[j][2] * v[j][2] + v[j][3] * v[j][3]); }
        const float rinv = 1.0f / sqrtf(wave_sum(ss) * (1.0f / D) + EPS);
#pragma unroll
        for (int j = 0; j < 8; ++j) orow[64 * j] = v[j] * rinv * g4[j];
    }
}
__device__ __forceinline__ float softplus_f(float z) {
    const float zn = z > 0.f ? -z : z; const float x = __expf(zn); const float u = 1.0f + x; const float l1p = (u == 1.0f) ? x : __logf(u) * (x / (u - 1.0f));
    return (z > 0.f ? z : 0.f) + l1p; }
__device__ __forceinline__ void lru_unit(const Frame& F, int l, int gck, int g) {
    LAS unsigned char* xr = F.lds + RING_OFF;
    const bf16* X = (const bf16*)(F.ws + WS_LRUX);
    const size_t row0 = (size_t)gck * 128; const int ck = gck & 15;
    {
        const int c8 = F.tid & 15, tq = F.tid >> 4, ch0 = 128 * g + 8 * c8;
        float w[4][8], bias[8];
#pragma unroll
        for (int k = 0; k < 4; ++k) { const f32x4 a = *(const f32x4*)(in_ptr(I_LCW) + ((size_t)l * 4 + k) * LW + ch0), b = *(const f32x4*)(in_ptr(I_LCW) + ((size_t)l * 4 + k) * LW + ch0 + 4);
            w[k][0] = a[0]; w[k][1] = a[1]; w[k][2] = a[2]; w[k][3] = a[3]; w[k][4] = b[0]; w[k][5] = b[1]; w[k][6] = b[2]; w[k][7] = b[3]; }
        { const f32x4 a = *(const f32x4*)(in_ptr(I_LCB) + (size_t)l * LW + ch0), b = *(const f32x4*)(in_ptr(I_LCB) + (size_t)l * LW + ch0 + 4);
          bias[0] = a[0]; bias[1] = a[1]; bias[2] = a[2]; bias[3] = a[3]; bias[4] = b[0]; bias[5] = b[1]; bias[6] = b[2]; bias[7] = b[3]; }
        float xin[7][8];
#pragma unroll
        for (int i = 0; i < 7; ++i) { const int trow = 4 * tq + i - 3;
            if (128 * ck + trow >= 0) { const v4u raw = *(const GAS v4u*)(X + (size_t)((long)row0 + trow) * LW + ch0); unpack8(raw, xin[i]); }
            else {
#pragma unroll
                for (int e = 0; e < 8; ++e) xin[i][e] = 0.f; } }
#pragma unroll
        for (int j = 0; j < 4; ++j) { float o[8];
#pragma unroll
            for (int e = 0; e < 8; ++e) o[e] = bias[e] + (w[0][e] * xin[j][e] + w[1][e] * xin[j + 1][e]) + (w[2][e] * xin[j + 2][e] + w[3][e] * xin[j + 3][e]);
            *(LAS v4u*)(xr + (4 * tq + j) * 272 + 16 * c8) = pack8(o); }
    }
    __syncthreads();
    const int fr = F.lane & 15, fq = F.lane >> 4, ch = 16 * F.wave + fr, cg = 128 * g + ch;
    bf16x8 bwa[4], bwx[4];
    { const bf16* WA = (const bf16*)(F.ws + WS_WAX) + ((size_t)(l * 2 + 0) * 8 + g) * 16384 + (size_t)ch * 128 + 8 * fq;
      const bf16* WX = (const bf16*)(F.ws + WS_WAX) + ((size_t)(l * 2 + 1) * 8 + g) * 16384 + (size_t)ch * 128 + 8 * fq;
#pragma unroll
      for (int ks = 0; ks < 4; ++ks) { bwa[ks] = *(const bf16x8*)(WA + 32 * ks); bwx[ks] = *(const bf16x8*)(WX + 32 * ks); } }
    f32x4 accr[8], acci[8];
#pragma unroll
    for (int mt = 0; mt < 8; ++mt) { accr[mt] = (f32x4){0.f, 0.f, 0.f, 0.f}; acci[mt] = (f32x4){0.f, 0.f, 0.f, 0.f};
#pragma unroll
        for (int ks = 0; ks < 4; ++ks) { const bf16x8 a = *(const LAS bf16x8*)(xr + (16 * mt + fr) * 272 + (32 * ks + 8 * fq) * 2);
            accr[mt] = __builtin_amdgcn_mfma_f32_16x16x32_bf16(a, bwa[ks], accr[mt], 0, 0, 0);
            acci[mt] = __builtin_amdgcn_mfma_f32_16x16x32_bf16(a, bwx[ks], acci[mt], 0, 0, 0); } }
    const float ba = in_ptr(I_LBA)[(size_t)l * LW + cg], bx = in_ptr(I_LBX)[(size_t)l * LW + cg];
    const float Lc2 = -8.0f * 1.4426950408889634f * softplus_f(-in_ptr(I_LAM)[(size_t)l * LW + cg]);
    bf16* R = (bf16*)(F.ws + WS_R); bf16* GX = (bf16*)(F.ws + WS_GX);
    float At = 1.f, Bt = 0.f;
#pragma unroll
    for (int mt = 0; mt < 8; ++mt) { float A4 = 1.f, B4 = 0.f;
#pragma unroll
        for (int e = 0; e < 4; ++e) { const int tl = 16 * mt + 4 * fq + e;
            const float r = pg8::fast_sigmoid(accr[mt][e] + ba), ii = pg8::fast_sigmoid(acci[mt][e] + bx);
            const float xv = bf2f(*(const LAS unsigned short*)(xr + tl * 272 + ch * 2));
            const unsigned short rb = (unsigned short)f2bf(r), gb = (unsigned short)f2bf(ii * xv);
            R[(row0 + tl) * LW + cg] = rb; GX[(row0 + tl) * LW + cg] = gb;
            const float a = __builtin_amdgcn_exp2f(Lc2 * bf2f(rb)); const float bb = sqrtf(fmaxf(1.0f - a * a, 0.f)) * bf2f(gb);
            A4 = a * A4; B4 = a * B4 + bb; }
#pragma unroll
        for (int q = 0; q < 4; ++q) { const float Aq = __shfl(A4, fr + 16 * q), Bq = __shfl(B4, fr + 16 * q); Bt = Aq * Bt + Bq; At = Aq * At; } }
    if (fq == 0) { float* AGG = (float*)(F.ws + WS_AGG) + ((size_t)gck * LW + cg) * 2; AGG[0] = At; AGG[1] = Bt; }
    __syncthreads();
}
__device__ __forceinline__ void lru_scan_unit(const Frame& F, int l, int gck, int hf) {
    const int c = 512 * hf + F.tid, b = gck >> 4, ck = gck & 15;
    const float* AGG = (const float*)(F.ws + WS_AGG);
    float h = 0.f;
    for (int j = 0; j < ck; ++j) { const float2 ab = *(const float2*)(AGG + ((size_t)(b * 16 + j) * LW + c) * 2); h = ab.x * h + ab.y; }
    const float Lc2 = -8.0f * 1.4426950408889634f * softplus_f(-in_ptr(I_LAM)[(size_t)l * LW + c]);
    const bf16* R = (const bf16*)(F.ws + WS_R) + (size_t)gck * 128 * LW + c; const bf16* GX = (const bf16*)(F.ws + WS_GX) + (size_t)gck * 128 * LW + c;
    const bf16* GT = (const bf16*)(F.ws + WS_LRUG) + (size_t)gck * 128 * LW + c; bf16* Y = (bf16*)(F.ws + WS_YLRU) + (size_t)gck * 128 * YP + c;
    for (int t0 = 0; t0 < 128; t0 += 8) { unsigned short rr[8], gg[8], tt[8];
#pragma unroll
        for (int i = 0; i < 8; ++i) { rr[i] = R[(size_t)(t0 + i) * LW]; gg[i] = GX[(size_t)(t0 + i) * LW]; tt[i] = GT[(size_t)(t0 + i) * LW]; }
#pragma unroll
        for (int i = 0; i < 8; ++i) { const float a = __builtin_amdgcn_exp2f(Lc2 * bf2f(rr[i])); const float bb = sqrtf(fmaxf(1.0f - a * a, 0.f)) * bf2f(gg[i]); h = a * h + bb;
            Y[(size_t)(t0 + i) * YP] = (unsigned short)f2bf(h * bf2f(tt[i])); } }
}
__device__ __forceinline__ void sc_phase(const Frame& F, int l) {
    const int gt = (F.vcu * NWAVES + F.wave) * 64 + F.lane, NT = F.G * NWAVES * 64;
    const bf16* SB = (const bf16*)(F.ws + WS_SCB); const bf16* SC = (const bf16*)(F.ws + WS_SCC); const bf16* SX = (const bf16*)(F.ws + WS_SCX); bf16* Y = (bf16*)(F.ws + WS_YSC);
    for (int idx = gt; idx < (M / 8) * (LW / 8); idx += NT) {
        const int c8 = idx & 127, tg = idx >> 7, row0 = 8 * tg, s0 = row0 & (SEQ - 1), ch0 = 8 * c8;
        float w[3][8];
#pragma unroll
        for (int k = 0; k < 3; ++k) { const f32x4 a = *(const f32x4*)(in_ptr(I_SCW) + ((size_t)l * 3 + k) * LW + ch0), b = *(const f32x4*)(in_ptr(I_SCW) + ((size_t)l * 3 + k) * LW + ch0 + 4);
            w[k][0] = a[0]; w[k][1] = a[1]; w[k][2] = a[2]; w[k][3] = a[3]; w[k][4] = b[0]; w[k][5] = b[1]; w[k][6] = b[2]; w[k][7] = b[3]; }
        float cx[10][8];
#pragma unroll
        for (int i = 0; i < 10; ++i) {
            if (s0 + i - 2 >= 0) { float a[8], b[8]; unpack8(*(const GAS v4u*)(SC + (size_t)(row0 + i - 2) * LW + ch0), a); unpack8(*(const GAS v4u*)(SX + (size_t)(row0 + i - 2) * LW + ch0), b);
#pragma unroll
                for (int e = 0; e < 8; ++e) cx[i][e] = a[e] * b[e]; }
            else {
#pragma unroll
                for (int e = 0; e < 8; ++e) cx[i][e] = 0.f; } }
#pragma unroll
        for (int j = 0; j < 8; ++j) { float bb[8], o[8]; unpack8(*(const GAS v4u*)(SB + (size_t)(row0 + j) * LW + ch0), bb);
#pragma unroll
            for (int e = 0; e < 8; ++e) o[e] = bb[e] * ((w[0][e] * cx[j][e] + w[1][e] * cx[j + 1][e]) + w[2][e] * cx[j + 2][e]);
            *(GAS v4u*)(Y + (size_t)(row0 + j) * YP + ch0) = pack8(o); }
    }
}
__device__ __forceinline__ void rope8(bf16* p, const float* cs, const float* sn) {
    float x1[8], x2[8], o1[8], o2[8]; unpack8(*(const GAS v4u*)p, x1); unpack8(*(const GAS v4u*)(p + 32), x2);
    const f32x4 c0 = *(const f32x4*)cs, c1 = *(const f32x4*)(cs + 4), s0 = *(const f32x4*)sn, s1 = *(const f32x4*)(sn + 4);
#pragma unroll
    for (int e = 0; e < 8; ++e) { const float c = e < 4 ? c0[e & 3] : c1[e & 3], s = e < 4 ? s0[e & 3] : s1[e & 3]; o1[e] = x1[e] * c - x2[e] * s; o2[e] = x2[e] * c + x1[e] * s; }
    *(GAS v4u*)p = pack8(o1); *(GAS v4u*)(p + 32) = pack8(o2);
}
__device__ __forceinline__ void rope_phase(const Frame& F) {
    const int gt = (F.vcu * NWAVES + F.wave) * 64 + F.lane, NT = F.G * NWAVES * 64;
    const float* COS = (const float*)(F.ws + WS_COS); const float* SIN = (const float*)(F.ws + WS_SIN);
    bf16* Q = (bf16*)(F.ws + WS_Q); bf16* KP = (bf16*)(F.ws + WS_KPE);
    for (int idx = gt; idx < M * 16 * 4; idx += NT) { const int row = idx >> 6, hh = (idx >> 2) & 15, j = idx & 3;
        rope8(Q + (size_t)row * 3072 + hh * 192 + 128 + 8 * j, COS + (size_t)row * 32 + 8 * j, SIN + (size_t)row * 32 + 8 * j); }
    for (int idx = gt; idx < M * 4; idx += NT) { const int row = idx >> 2, j = idx & 3;
        rope8(KP + (size_t)row * 64 + 8 * j, COS + (size_t)row * 32 + 8 * j, SIN + (size_t)row * 32 + 8 * j); }
}
struct Args { const float* in[24]; float* out; unsigned char* ws; int ph_lo, ph_hi; };
#ifndef P0P
#define P0P 3
#endif
#ifndef REP_G2
#define REP_G2 1
#endif
#ifndef REP_G5
#define REP_G5 1
#endif
#ifndef REP_PRO
#define REP_PRO 1
#endif
#ifndef REVK_FFN
#define REVK_FFN false
#endif
#ifndef ACT_TILED
#define ACT_TILED false
#endif
#ifndef G3P
#define G3P 3
#endif
#ifndef REP_ATT
#define REP_ATT 1
#endif
#ifndef REP_BAR
#define REP_BAR 1
#endif
#ifndef PH_MASK
#define PH_MASK 0xFFFFu
#endif
#define EN(j) (((PH_MASK) >> (j)) & 1u)
__global__ void __launch_bounds__(NWAVES * 64, 2) hybrid_fwd(Args args) {
    extern __shared__ __attribute__((aligned(16))) unsigned char lds[];
    Frame F;
    F.lds = (LAS unsigned char*)lds;
    F.MISC = (volatile LAS unsigned*)(F.lds + MISC_OFF);
    F.tid = threadIdx.x; F.lane = F.tid & 63; F.wave = __builtin_amdgcn_readfirstlane(F.tid >> 6);
    F.G = gridDim.x; { const int bx = blockIdx.x; F.vcu = (F.G % 8 == 0) ? (bx % 8) * (F.G / 8) + bx / 8 : bx; }
    F.out = nullptr; F.ws = nullptr; F.ctl = (gu32*)(args.ws + WS_CTL);
    for (int u = F.tid; u < (LDS_BYTES - LDSCTL_OFF) / 4; u += NWAVES * 64) ((LAS unsigned*)(F.lds + LDSCTL_OFF))[u] = 0u;
    __syncthreads();
    XcdBarrier bar; bar.bar = (unsigned*)(F.ctl + CW_BAR); bar.x = 0; bar.st = nullptr;
    if (MK_N_LAUNCHES == 1) bar = xcd_barrier_post((unsigned*)(F.ctl + CW_BAR), F.MISC + 8);
    const int lo = args.ph_lo, hi = args.ph_hi;
#define IN(k) (lo <= (k) && (k) < hi)
#define PHASE_FRAME() Frame P = F; { unsigned m1_ = ~0u; asm volatile("" : "+s"(m1_)); int t_ = F.wave * 64 + (int)__builtin_amdgcn_mbcnt_hi(m1_, __builtin_amdgcn_mbcnt_lo(m1_, 0u)); asm volatile("" : "+v"(t_)); P.tid = t_; P.lane = t_ & 63; P.out = (GAS float*)karg_ptr(24); P.ws = karg_ptr(25); }
#define SEAM(k) do { if (IN(k) && IN((k) + 1)) { if (MK_N_LAUNCHES == 1) { for (int rb_ = 0; rb_ < REP_BAR; ++rb_) { XcdBarrier b_ = bar; GAS unsigned* bp_ = (GAS unsigned*)bar.bar; asm volatile("" : "+s"(bp_)); b_.bar = (unsigned*)bp_; xcd_barrier(b_); } }     } } while (0)
#define HN ((bf16*)(P.ws + WS_HN))
#define XH ((bf16*)(P.ws + WS_XH))
#define A8 ((unsigned char*)(P.ws + WS_A8))
#define ACT ((bf16*)(P.ws + WS_ACT))
#define MERGED ((bf16*)(P.ws + WS_MERGED))
#define ring (F.lds + RING_OFF)
#define MODL(l_) ((const float*)(P.ws + WS_MOD) + (size_t)(l_) * NB * MODW)
#define NORMG(l_, s_) (in_ptr(I_NORMG) + ((size_t)(l_) * 3 + (s_)) * D)
#define SSQN(l_, s_) ((pg8::ssq_t*)(P.ws + WS_SSQN) + ((size_t)(l_) * 3 + (s_)) * M)
#define WSCP(l_, w_) ((const float*)(P.ws + WS_WSC) + ((size_t)(l_) * 2 + (w_)) * 2)
#define CBV(l_, s_) ((const int*)(P.ws + WS_CB) + ((size_t)(l_) * 3 + (s_)) * NB * CBW)

    if (EN(12) && IN(0)) { PHASE_FRAME(); p0_wscale(P); p0_mod(P); p0_weights(P, 2);
        for (int i = P.vcu * (NWAVES * 64) + P.tid; i < NL * 4 * M; i += P.G * (NWAVES * 64)) ((GAS pg8::ssq_t*)(P.ws + WS_SSQN))[i] = 0ull;
        SEAM(0); }
    if (EN(13) && IN(1)) { PHASE_FRAME(); if (P0P & 1) for (int rep_ = 0; rep_ < REP_PRO; ++rep_) { p0_weights(P, 1, rep_ + 1 < REP_PRO); __syncthreads(); } if (P0P & 2) operand0_phase(P, in_ptr(I_X), NORMG(0, 0), MODL(0) + 2048, (FP8_G1 & 1) ? (bf16*)nullptr : HN, SSQN(0, 0), XH, (FP8_G1 & 1) ? A8 : nullptr); SEAM(1); }

    for (int l = 0; l < NL; ++l) {
        const int pb = 2 + PPL * l;
#define wl (P.ws + WS_W + (size_t)l * W_LAYER)
#define mod MODL(l)
#define xin0 ((l == 0) ? in_ptr(I_X) : (const float*)P.out)
#define ssq ((pg8::ssq_t*)(P.ws + WS_SSQ) + (size_t)l * M)
#define UP_CALL(F8IN, O8, Wp, SITE, SSQP) do { pg8::Gemm g{(F8IN) ? (const bf16*)A8 : (const bf16*)HN, (const bf16*)(Wp), M, 2 * DFF, (F8IN) ? D / 2 : D}; \
            pg8::EpiSwiglu<ACT_TILED, (O8), (F8IN)> E{ACT, DFF, SSQN(l, SITE), CBV(l, SITE), CBW, EPS, 1.0f, (SSQP), WSCP(l, 1)};     \
            pg8::gemm_phase<pg8::EpiSwiglu<ACT_TILED, (O8), (F8IN)>, pg8::StaticOrder, true, true, false, false, false, false, (F8IN)>(ring, g, S, E, P.wave); } while (0)
        if (EN(0) && IN(pb + 0)) { PHASE_FRAME(); pg8::StaticOrder S; S.init(M, 2 * DFF, P.G, (int)blockIdx.x);
            constexpr bool o0 = fp8_dn(0, 0), o1 = fp8_dn(1, 0);
            constexpr bool i0 = (FP8_G1 & 1) != 0, i1 = (FP8_G1 & 2) != 0;
            if (l == 0) UP_CALL(i0, o0, wl + WO_W13, 0, SSQN(0, 0)); else UP_CALL(i1, o1, wl + WO_W13, 0, SSQN(0, 2));
            SEAM(pb + 0); }
#define DN_SC(F8) ((F8) ? 1.0f / (64.0f * pg8::ACT8_SC) : 1.0f)
#define G2_CALL(F8) do { pg8::Gemm g{ACT, (const bf16*)(wl + WO_W2), M, D, (F8) ? DFF / 2 : DFF}; pg8::EpiResid<true, true> E{XH, mod + 4096, HN, NORMG(l, 1), mod + 8192, SSQN(l, 1), A8, MODW, 0.5f * DN_SC(F8), SSQN(l, 0)}; \
            pg8::gemm_phase<pg8::EpiResid<true, true>, pg8::PanelOrder, true, true, false, false, false, (F8)>(ring, g, S, E, P.wave); } while (0)
        if (EN(1) && IN(pb + 1)) { PHASE_FRAME(); pg8::PanelOrder S; S.init(P.G, (int)blockIdx.x);
            constexpr bool d0 = fp8_dn(0, 0), d1 = fp8_dn(1, 0);
            if (d0 == d1) G2_CALL(d0); else if (l == 0) G2_CALL(d0); else G2_CALL(d1);
            SEAM(pb + 1); }
        if (EN(2) && IN(pb + 2)) { PHASE_FRAME();
            if (G3P & 1) {
                pg8::Gemm g{(const bf16*)A8, (const bf16*)(wl + WO_WIN8), M, WINF_ROWS, D / 2}; pg8::StaticOrder S; S.init(M, WINF_ROWS, P.G, (int)blockIdx.x);
                pg8::EpiWin<(FP8_ALL ? 2 : 1), (bool)WIN_QF8> E{(bf16*)(P.ws + WS_LRUX), (bf16*)(P.ws + WS_LRUG), (bf16*)(P.ws + WS_SCB), (bf16*)(P.ws + WS_SCC), (bf16*)(P.ws + WS_SCX), (bf16*)(P.ws + WS_Q), (bf16*)(P.ws + WS_KVLAT), (bf16*)(P.ws + WS_GATES), (bf16*)(P.ws + WS_KPE), ssq, SSQN(l, 1), CBV(l, 1), CBW, EPS, SSQN(l, 0), WSCP(l, 0)};
                pg8::gemm_phase<pg8::EpiWin<(FP8_ALL ? 2 : 1), (bool)WIN_QF8>, pg8::StaticOrder, true, true, false, false, false, false, true>(ring, g, S, E, P.wave); }
            if ((G3P & 2) && !FP8_ALL) {
                pg8::Gemm g{HN, (const bf16*)(wl + WO_WIN), M, WINB_ROWS, D}; pg8::StaticOrder S; S.init(M, WINB_ROWS, P.G, (int)blockIdx.x);
                pg8::EpiWin<0, (bool)WIN_QF8> E{(bf16*)(P.ws + WS_LRUX), (bf16*)(P.ws + WS_LRUG), (bf16*)(P.ws + WS_SCB), (bf16*)(P.ws + WS_SCC), (bf16*)(P.ws + WS_SCX), (bf16*)(P.ws + WS_Q), (bf16*)(P.ws + WS_KVLAT), (bf16*)(P.ws + WS_GATES), (bf16*)(P.ws + WS_KPE), ssq, SSQN(l, 1), CBV(l, 1), CBW, EPS, nullptr, nullptr};
                pg8::gemm_phase<pg8::EpiWin<0, (bool)WIN_QF8>, pg8::StaticOrder, true, true>(ring, g, S, E, P.wave); }
            SEAM(pb + 2); }
        if (EN(3) && IN(pb + 3)) { PHASE_FRAME();
            for (int u = P.vcu; u < 128 * 8; u += P.G) lru_unit(P, l, u >> 3, u & 7);
            sc_phase(P, l);
            rope_phase(P);
            { pg8::Gemm g{(const bf16*)(P.ws + WS_KVLAT), (const bf16*)(wl + WO_UKV), M, 4096, KVR}; pg8::StaticOrder S; S.init(M, 4096, P.G, (int)blockIdx.x);
              pg8::EpiKV E{(bf16*)(P.ws + WS_KN), (bf16*)(P.ws + WS_V), ssq, EPS}; pg8::gemm_phase<pg8::EpiKV, pg8::StaticOrder, true, true>(ring, g, S, E, P.wave); }
            SEAM(pb + 3);
        }
        if (EN(4) && IN(pb + 4)) { PHASE_FRAME();
            for (int u = P.vcu; u < 128 * 2; u += P.G) lru_scan_unit(P, l, u >> 1, u & 1);
            for (int rep_ = 0; rep_ < REP_ATT; ++rep_)
            for (int item = P.vcu; item < 256; item += P.G) { const int bh = item >> 1, s = item & 1;
#pragma unroll 1
                for (int i = 0; i < 4; ++i) { const int base = 2 * s + (i >> 1), qb = (i & 1) ? 7 - base : base;
                    att::attn_unit(bh >> 4, bh & 15, qb, (const bf16*)(P.ws + WS_Q), (const bf16*)(P.ws + WS_KN), (const bf16*)(P.ws + WS_KPE), (const bf16*)(P.ws + WS_V), (bf16*)(P.ws + WS_ATT), (LAS char*)ring, P.wave); } }
            __syncthreads();
            SEAM(pb + 4);
        }
        if (EN(5) && IN(pb + 5)) { PHASE_FRAME();
            pg8::PanelOrder S; S.init(P.G, (int)blockIdx.x); const bf16* GT = (const bf16*)(P.ws + WS_GATES);
#ifndef MERGE3
#define MERGE3 1
#endif
            if (MERGE3) { pg8::Gemm g{(const bf16*)(P.ws + WS_YCAT), (const bf16*)(wl + WO_WCAT), M, D, YP}; pg8::EpiMerge3 E{MERGED, (const unsigned char*)GT, 6144}; static_assert(GATES_U8 && MERGE3, "the u8 gate store is read by the fused merge GEMM only"); pg8::gemm_phase<pg8::EpiMerge3, pg8::PanelOrder, true, true>(ring, g, S, E, P.wave); }
            else {
            { pg8::Gemm g{(const bf16*)(P.ws + WS_YLRU), (const bf16*)(wl + WO_LRUO), M, D, LW, YP}; pg8::EpiMerge<true> E{MERGED, GT, 6144}; pg8::gemm_phase<pg8::EpiMerge<true>, pg8::PanelOrder, true, true>(ring, g, S, E, P.wave); }
            { pg8::Gemm g{(const bf16*)(P.ws + WS_YSC), (const bf16*)(wl + WO_SCO), M, D, LW, YP}; pg8::EpiMerge<false> E{MERGED, GT + 2048, 6144}; pg8::gemm_phase<pg8::EpiMerge<false>, pg8::PanelOrder, true, true>(ring, g, S, E, P.wave); }
            { pg8::Gemm g{(const bf16*)(P.ws + WS_ATT), (const bf16*)(wl + WO_MLAO), M, D, D, YP}; pg8::EpiMerge<false> E{MERGED, GT + 4096, 6144}; pg8::gemm_phase<pg8::EpiMerge<false>, pg8::PanelOrder, true, true>(ring, g, S, E, P.wave); }
            }
            SEAM(pb + 5);
        }
        if (EN(6) && IN(pb + 6)) { PHASE_FRAME(); pg8::Gemm g{MERGED, (const bf16*)(wl + WO_WO), M, D, D}; pg8::PanelOrder S; S.init(P.G, (int)blockIdx.x);
            pg8::EpiResid<true, (FP8_G4 != 0)> E{XH, mod + 10240, (FP8_G4 == 3) ? (bf16*)nullptr : HN, NORMG(l, 2), mod + 14336, SSQN(l, 2), A8, MODW, 1.0f, SSQN(l, 1)}; pg8::gemm_phase<pg8::EpiResid<true, (FP8_G4 != 0)>, pg8::PanelOrder, true, true>(ring, g, S, E, P.wave); SEAM(pb + 6); }
        if (EN(7) && IN(pb + 7)) { PHASE_FRAME(); pg8::StaticOrder S; S.init(M, 2 * DFF, P.G, (int)blockIdx.x);
            constexpr bool u0 = (FP8_G4 & 1) != 0, u1 = (FP8_G4 & 2) != 0, o0 = fp8_dn(0, 1), o1 = fp8_dn(1, 1);
            if (u0 == u1 && o0 == o1) UP_CALL(u0, o0, wl + WO_W13 + 44 * MiB, 2, SSQN(l, 1)); else if (l == 0) UP_CALL(u0, o0, wl + WO_W13 + 44 * MiB, 2, SSQN(l, 1)); else UP_CALL(u1, o1, wl + WO_W13 + 44 * MiB, 2, SSQN(l, 1));
            SEAM(pb + 7); }
        if (EN(8) && IN(pb + 8)) { PHASE_FRAME(); pg8::PanelOrder S; S.init(P.G, (int)blockIdx.x); static_assert(NL == 2, "per-layer fp8 flags are written out for two layers");
            if (l + 1 < NL) { constexpr bool f8 = fp8_dn(0, 1); pg8::Gemm g{ACT, (const bf16*)(wl + WO_W2 + 22 * MiB), M, D, f8 ? DFF / 2 : DFF};
                constexpr bool e8 = (FP8_G1 & 2) != 0; pg8::EpiResid<true, e8> E{XH, mod + 16384, e8 ? (bf16*)nullptr : HN, NORMG(l + 1, 0), MODL(l + 1) + 2048, SSQN(l + 1, 0), A8, MODW, 0.5f * DN_SC(f8), SSQN(l, 2)}; pg8::gemm_phase<pg8::EpiResid<true, e8>, pg8::PanelOrder, true, true, false, false, false, f8>(ring, g, S, E, P.wave); }
            else { constexpr bool f8 = fp8_dn(1, 1); pg8::Gemm g{ACT, (const bf16*)(wl + WO_W2 + 22 * MiB), M, D, f8 ? DFF / 2 : DFF};
                if (REP_G5 > 1) { pg8::EpiNull E0{(float*)(P.ws + WS_AGG)}; pg8::gemm_phase<pg8::EpiNull, pg8::PanelOrder, true, true, false, false, false, f8>(ring, g, S, E0, P.wave); }
                pg8::EpiResid<false> E{XH, mod + 16384, nullptr, nullptr, nullptr, nullptr, nullptr, MODW, 0.5f * DN_SC(f8), nullptr}; pg8::gemm_phase<pg8::EpiResid<false>, pg8::PanelOrder, true, true, false, false, false, f8>(ring, g, S, E, P.wave); }
            SEAM(pb + 8); }
    }
    if (EN(14) && IN(N_PHASES - 1)) { PHASE_FRAME(); final_norm_phase(P, XH, (float*)P.out, in_ptr(I_FING)); }
#undef IN
#undef SEAM
#undef HN
#undef XH
#undef A8
#undef ACT
#undef MERGED
#undef ring
#undef wl
#undef mod
#undef xin0
#undef ssq
}

extern "C" void kernel_launch(void* const* d_in, const int* in_sizes, int n_in, void* d_out, int out_size, void* d_ws, size_t ws_size, hipStream_t stream) {
    static int grid = 0;
    if (grid == 0) {
        if (n_in != 24 || in_sizes[0] != M * D || out_size != M * D || ws_size < WS_END) { fprintf(stderr, "kernel_launch: shape/workspace mismatch (n_in %d, in0 %d, out %d, ws %zu < %zu); nothing launched\n", n_in, n_in > 0 ? in_sizes[0] : -1, out_size, ws_size, (size_t)WS_END); grid = -1; return; }
        int dev = 0, cus = 0, per_cu = 0;
        if (hipGetDevice(&dev) != hipSuccess || hipDeviceGetAttribute(&cus, hipDeviceAttributeMultiprocessorCount, dev) != hipSuccess) { fprintf(stderr, "kernel_launch: device query failed\n"); grid = -1; return; }
        if (hipFuncSetAttribute((const void*)hybrid_fwd, hipFuncAttributeMaxDynamicSharedMemorySize, LDS_BYTES) != hipSuccess) { fprintf(stderr, "kernel_launch: hipFuncSetAttribute failed\n"); grid = -1; return; }
        if (hipOccupancyMaxActiveBlocksPerMultiprocessor(&per_cu, (const void*)hybrid_fwd, NWAVES * 64, LDS_BYTES) != hipSuccess || per_cu < 1) fprintf(stderr, "kernel_launch: note: occupancy query reports %d workgroups per CU\n", per_cu);
        (void)hipGetLastError();
        grid = cus;
    }
    if (grid < 0) return;
    if (hipMemsetAsync((char*)d_ws + WS_CTL, 0, CTL_ZERO_BYTES, stream) != hipSuccess) { fprintf(stderr, "kernel_launch: hipMemsetAsync failed\n"); return; }
    Args a{};
    for (int i = 0; i < 24; ++i) a.in[i] = (const float*)d_in[i];
    a.out = (float*)d_out; a.ws = (unsigned char*)d_ws;
#if MK_N_LAUNCHES == 1
    a.ph_lo = 0; a.ph_hi = N_PHASES;
    hipLaunchKernelGGL(hybrid_fwd, dim3(grid), dim3(NWAVES * 64), LDS_BYTES, stream, a);
#else
    for (int p = 0; p < N_PHASES; ++p) { a.ph_lo = p; a.ph_hi = p + 1; hipLaunchKernelGGL(hybrid_fwd, dim3(grid), dim3(NWAVES * 64), LDS_BYTES, stream, a); }
#endif
    const hipError_t le = hipPeekAtLastError();
    if (le != hipSuccess) fprintf(stderr, "kernel_launch: launch failed: %s\n", hipGetErrorName(le));
}
```
